# Optimizing an MI355X kernel written in HIP

```python
import math
import jax, jax.numpy as jnp
from jax import lax
import numpy as np

D_MODEL = 1024
BATCH = 1
SEQ = 16384
DEPTH = 1

CHUNK = 64
Q_BLOCK = 128
EPS = 1e-6

DA_HEADS = 4
DA_HEAD_DIM = 64
DA_V_DIM = 2 * DA_HEAD_DIM
DA_WIDTH = DA_HEADS * DA_V_DIM
ALIBI_MAX = 8.0

RET_HEADS = 4
RET_QK_DIM = 64
RET_V_DIM = 128
RET_WIDTH = RET_HEADS * RET_V_DIM

MIX_WIDTH = DA_WIDTH + RET_WIDTH

DA_Q_COLS = DA_HEADS * 2 * DA_HEAD_DIM
DA_K_COLS = DA_HEADS * 2 * DA_HEAD_DIM
DA_V_COLS = DA_WIDTH
RET_Q_COLS = RET_HEADS * RET_QK_DIM
RET_K_COLS = RET_HEADS * RET_QK_DIM
RET_V_COLS = RET_WIDTH
RET_G_COLS = RET_WIDTH
IN_COLS = DA_Q_COLS + DA_K_COLS + DA_V_COLS + RET_Q_COLS + RET_K_COLS + RET_V_COLS + RET_G_COLS
IN_SPLITS = (DA_Q_COLS,
             DA_Q_COLS + DA_K_COLS,
             DA_Q_COLS + DA_K_COLS + DA_V_COLS,
             DA_Q_COLS + DA_K_COLS + DA_V_COLS + RET_Q_COLS,
             DA_Q_COLS + DA_K_COLS + DA_V_COLS + RET_Q_COLS + RET_K_COLS,
             DA_Q_COLS + DA_K_COLS + DA_V_COLS + RET_Q_COLS + RET_K_COLS + RET_V_COLS)

MOE_GROUPS = 4
MOE_EXPERTS_PER_GROUP = 8
MOE_EXPERTS = MOE_GROUPS * MOE_EXPERTS_PER_GROUP
MOE_TOP_K = 2
MOE_HIDDEN = 512
MOE_BLOCK = 128

kernel_name = "hybrid_diffattn_retention_hmoe"


def rmsnorm(x, g):
    xf = x.astype(jnp.float32)
    y = xf * lax.rsqrt(jnp.mean(xf * xf, axis=-1, keepdims=True) + EPS)
    return (y * g.astype(jnp.float32)).astype(x.dtype)


def head_rmsnorm(x):
    xf = x.astype(jnp.float32)
    return xf * lax.rsqrt(jnp.mean(xf * xf, axis=-1, keepdims=True) + EPS)


def alibi_slopes(n_heads):
    return jnp.exp2(-ALIBI_MAX * jnp.arange(1, n_heads + 1, dtype=jnp.float32) / n_heads)


def diff_attention(q, k, v, lam, subln_g, lambda_init):
    B, S = q.shape[0], q.shape[1]
    nb = S // Q_BLOCK
    scale = DA_HEAD_DIM ** -0.5
    slopes = alibi_slopes(DA_HEADS)
    k_pos = jnp.arange(S)
    k_chunk = k_pos // CHUNK
    qb = q.reshape(B, nb, Q_BLOCK, DA_HEADS, 2, DA_HEAD_DIM).transpose(1, 0, 2, 3, 4, 5)

    def one_block(args):
        i, q_blk = args
        q_pos = i * Q_BLOCK + jnp.arange(Q_BLOCK)
        s = jnp.einsum('bqhmd,bkhmd->bhmqk', q_blk, k,
                       preferred_element_type=jnp.float32) * scale
        dist = jnp.abs(q_pos[:, None] - k_pos[None, :]).astype(jnp.float32)
        bias = -slopes[:, None, None, None] * dist[None, None]
        allowed = k_chunk[None, :] <= (q_pos // CHUNK)[:, None]
        s = jnp.where(allowed, s + bias, -jnp.inf)
        p = jax.nn.softmax(s, axis=-1)
        a = p[:, :, 0] - lam * p[:, :, 1]
        return jnp.einsum('bhqk,bkhe->bqhe', a.astype(v.dtype), v)

    o = lax.map(one_block, (jnp.arange(nb), qb))
    o = o.transpose(1, 0, 2, 3, 4).reshape(B, S, DA_HEADS, DA_V_DIM)
    o = rmsnorm(o, subln_g) * (1.0 - lambda_init)
    return o.reshape(B, S, DA_WIDTH)


def retention(q, k, v, g):
    B, S = q.shape[0], q.shape[1]
    nc = S // CHUNK
    f32 = jnp.float32
    log_gamma = jnp.log1p(-jnp.exp2(-5.0 - jnp.arange(RET_HEADS, dtype=f32)))
    qc = q.astype(f32).reshape(B, nc, CHUNK, RET_HEADS, RET_QK_DIM)
    kc = (k.astype(f32) * RET_QK_DIM ** -0.5).reshape(B, nc, CHUNK, RET_HEADS, RET_QK_DIM)
    vc = v.astype(f32).reshape(B, nc, CHUNK, RET_HEADS, RET_V_DIM)
    pos = jnp.arange(CHUNK, dtype=f32)
    rel = pos[:, None] - pos[None, :]
    intra_decay = jnp.where(rel >= 0, jnp.exp(log_gamma[:, None, None] * jnp.maximum(rel, 0.0)), 0.0)
    s = jnp.einsum('bnchd,bnshd->bnhcs', qc, kc) * intra_decay
    intra = jnp.einsum('bnhcs,bnshe->bnche', s, vc)
    k_decay = jnp.exp(log_gamma[:, None] * (CHUNK - 1 - pos)[None, :])
    kv = jnp.einsum('bnshd,hs,bnshe->bnhde', kc, k_decay, vc)
    chunk_decay = jnp.exp(log_gamma * CHUNK)[:, None, None]

    def step(state, kv_n):
        return state * chunk_decay + kv_n, state

    init = jnp.zeros((B, RET_HEADS, RET_QK_DIM, RET_V_DIM), f32)
    _, prev = lax.scan(step, init, kv.transpose(1, 0, 2, 3, 4))
    prev = prev.transpose(1, 0, 2, 3, 4)
    q_decay = jnp.exp(log_gamma[:, None] * (pos + 1.0)[None, :])
    cross = jnp.einsum('bnchd,hc,bnhde->bnche', qc, q_decay, prev)
    o = head_rmsnorm((intra + cross).reshape(B, S, RET_HEADS, RET_V_DIM))
    o = jax.nn.silu(g.astype(f32)) * o
    return o.reshape(B, S, RET_WIDTH).astype(q.dtype)


def hier_moe(xn, wg, bg, we, be, w_gate, w_up, w_down):
    B, S, D = xn.shape
    T = B * S
    f32 = jnp.float32
    xt = xn.reshape(T, D)
    g_prob = jax.nn.softmax((xt @ wg + bg).astype(f32), axis=-1)
    g_top_p, g_top_i = lax.top_k(g_prob, 1)
    grp = g_top_i[:, 0]
    e_logits = (xt @ we + be).astype(f32).reshape(T, MOE_GROUPS, MOE_EXPERTS_PER_GROUP)
    idx = jnp.broadcast_to(grp[:, None, None], (T, 1, MOE_EXPERTS_PER_GROUP))
    e_logits = jnp.take_along_axis(e_logits, idx, axis=1)[:, 0]
    top_val, top_idx = lax.top_k(e_logits, MOE_TOP_K)
    weights = g_top_p * jax.nn.softmax(top_val, axis=-1)
    expert_id = grp[:, None] * MOE_EXPERTS_PER_GROUP + top_idx

    N = T * MOE_TOP_K
    e_flat = expert_id.reshape(N).astype(jnp.int32)
    w_flat = weights.reshape(N)
    tok_flat = jnp.repeat(jnp.arange(T, dtype=jnp.int32), MOE_TOP_K)
    order = jnp.argsort(e_flat)
    sorted_e = e_flat[order]
    counts = jnp.zeros((MOE_EXPERTS,), jnp.int32).at[e_flat].add(1)
    start = jnp.cumsum(counts) - counts
    padded = (counts + MOE_BLOCK - 1) // MOE_BLOCK * MOE_BLOCK
    pad_end = jnp.cumsum(padded)
    pad_start = pad_end - padded
    dest = pad_start[sorted_e] + jnp.arange(N, dtype=jnp.int32) - start[sorted_e]
    n_blocks = (N + MOE_BLOCK - 1) // MOE_BLOCK + MOE_EXPERTS
    nbuf = n_blocks * MOE_BLOCK
    buf_tok = jnp.full((nbuf,), T, jnp.int32).at[dest].set(tok_flat[order])
    buf_w = jnp.zeros((nbuf,), f32).at[dest].set(w_flat[order])
    block_e = jnp.minimum(jnp.searchsorted(pad_end, jnp.arange(n_blocks, dtype=jnp.int32) * MOE_BLOCK,
                                           side='right'), MOE_EXPERTS - 1)
    x_pad = jnp.concatenate([xt, jnp.zeros((1, D), xt.dtype)], axis=0)
    xb = x_pad[buf_tok].reshape(n_blocks, MOE_BLOCK, D)

    def expert_block(args):
        xblk, e = args
        h = jax.nn.silu(xblk @ w_gate[e]) * (xblk @ w_up[e])
        return h @ w_down[e]

    yb = lax.map(expert_block, (xb, block_e)).reshape(nbuf, D)
    y = jnp.zeros((T + 1, D), f32).at[buf_tok].add(yb.astype(f32) * buf_w[:, None])[:T]
    return y.reshape(B, S, D).astype(xn.dtype)


def setup_inputs(seed: int = 0) -> dict:
    key = jax.random.key(seed)
    ks = jax.random.split(key, 20)
    f32 = jnp.float32
    L, D = DEPTH, D_MODEL

    def nrm(k, shape, scale):
        return jax.random.normal(k, shape, f32) * scale

    return {
        "x": nrm(ks[0], (BATCH, SEQ, D), 1.0),
        "attn_norm_g": 1.0 + nrm(ks[1], (L, D), 0.02),
        "w_in": nrm(ks[2], (L, D, IN_COLS), D ** -0.5),
        "da_lambda_q1": nrm(ks[3], (L, DA_HEAD_DIM), 0.1),
        "da_lambda_k1": nrm(ks[4], (L, DA_HEAD_DIM), 0.1),
        "da_lambda_q2": nrm(ks[5], (L, DA_HEAD_DIM), 0.1),
        "da_lambda_k2": nrm(ks[6], (L, DA_HEAD_DIM), 0.1),
        "da_subln_g": 1.0 + nrm(ks[7], (L, DA_V_DIM), 0.02),
        "w_out": nrm(ks[8], (L, MIX_WIDTH, D), MIX_WIDTH ** -0.5),
        "ffn_norm_g": 1.0 + nrm(ks[9], (L, D), 0.02),
        "router_group_w": nrm(ks[10], (L, D, MOE_GROUPS), D ** -0.5),
        "router_group_b": nrm(ks[11], (L, MOE_GROUPS), 0.01),
        "router_expert_w": nrm(ks[12], (L, D, MOE_EXPERTS), D ** -0.5),
        "router_expert_b": nrm(ks[13], (L, MOE_EXPERTS), 0.01),
        "expert_w_gate": nrm(ks[14], (L, MOE_EXPERTS, D, MOE_HIDDEN), D ** -0.5),
        "expert_w_up": nrm(ks[15], (L, MOE_EXPERTS, D, MOE_HIDDEN), D ** -0.5),
        "expert_w_down": nrm(ks[16], (L, MOE_EXPERTS, MOE_HIDDEN, D), MOE_HIDDEN ** -0.5),
        "final_norm_g": 1.0 + nrm(ks[17], (D,), 0.02),
    }


def reference(x, attn_norm_g, w_in, da_lambda_q1, da_lambda_k1, da_lambda_q2, da_lambda_k2,
              da_subln_g, w_out, ffn_norm_g, router_group_w, router_group_b, router_expert_w,
              router_expert_b, expert_w_gate, expert_w_up, expert_w_down, final_norm_g):
    B, S, _ = x.shape
    h = x
    for l in range(DEPTH):
        xn = rmsnorm(h, attn_norm_g[l])
        proj = xn @ w_in[l]
        q_da, k_da, v_da, q_r, k_r, v_r, g_r = jnp.split(proj, IN_SPLITS, axis=-1)
        lambda_init = 0.8 - 0.6 * math.exp(-0.3 * l)
        lam = (jnp.exp(jnp.sum(da_lambda_q1[l].astype(jnp.float32) * da_lambda_k1[l].astype(jnp.float32)))
               - jnp.exp(jnp.sum(da_lambda_q2[l].astype(jnp.float32) * da_lambda_k2[l].astype(jnp.float32)))
               + lambda_init)
        o_da = diff_attention(q_da.reshape(B, S, DA_HEADS, 2, DA_HEAD_DIM),
                              k_da.reshape(B, S, DA_HEADS, 2, DA_HEAD_DIM),
                              v_da.reshape(B, S, DA_HEADS, DA_V_DIM),
                              lam, da_subln_g[l], lambda_init)
        o_r = retention(q_r.reshape(B, S, RET_HEADS, RET_QK_DIM),
                        k_r.reshape(B, S, RET_HEADS, RET_QK_DIM),
                        v_r.reshape(B, S, RET_HEADS, RET_V_DIM),
                        g_r.reshape(B, S, RET_HEADS, RET_V_DIM))
        mix = jnp.concatenate([o_da.astype(h.dtype), o_r.astype(h.dtype)], axis=-1)
        h = h + mix @ w_out[l]
        xn = rmsnorm(h, ffn_norm_g[l])
        h = h + hier_moe(xn, router_group_w[l], router_group_b[l], router_expert_w[l],
                         router_expert_b[l], expert_w_gate[l], expert_w_up[l], expert_w_down[l])
    return rmsnorm(h, final_norm_g)
```

```cpp
#include <hip/hip_runtime.h>
#include <cstdio>
#include <cstdint>

#ifndef MK_ONE_LAUNCH
#define MK_ONE_LAUNCH 0
#endif

constexpr int T = 16384, D = 1024, NIN = 3072;
constexpr int C_QDA = 0, C_KDA = 512, C_VDA = 1024, C_QR = 1536, C_KR = 1792, C_VR = 2048, C_GR = 2560;
constexpr int NE = 32, HIDN = 512, NSLOT = 2 * T, MAXTILES = NSLOT / 256 + NE, NPAD = MAXTILES * 256;
constexpr int NRT = 36;
constexpr float EPS = 1e-6f;
constexpr float LOG2E = 1.4426950408889634f;
constexpr float C2 = 0.125f * LOG2E;
constexpr float LAMBDA_INIT = 0.2f;
constexpr int NPHASE = 11;

constexpr size_t MiB = 1u << 20;
constexpr size_t WS_CTL = 0, CTL_ZERO_BYTES = 1 * MiB;
constexpr size_t WS_WRT = 1 * MiB;
constexpr size_t WS_WIN = 2 * MiB;
constexpr size_t WS_WOUT = 8 * MiB;
constexpr size_t WS_WGU = 10 * MiB;
constexpr size_t WS_WD = 74 * MiB;
constexpr size_t WS_A = 106 * MiB;
constexpr size_t WS_PROJ = 146 * MiB;
constexpr size_t WS_TOK = 242 * MiB;
constexpr size_t WS_END = 244 * MiB;
constexpr int CW_BAR = 4096;
constexpr int CW_CNT = 1024;
constexpr size_t TK_E = 0, TK_POS = 128 * 1024, TK_W = 256 * 1024, TK_STOK = 384 * 1024, TK_SW = 384 * 1024 + 160 * 1024;

constexpr int RING_BYTES = 131072;
constexpr int LDSCTL_OFF = RING_BYTES, MISC_OFF = LDSCTL_OFF + 320, TILEE_OFF = LDSCTL_OFF + 1024;
constexpr int LDS_BYTES = 147456;
constexpr int NWAVES = 8;

#define GAS __attribute__((address_space(1)))
#define LAS __attribute__((address_space(3)))
typedef unsigned short bf16;
typedef unsigned v4u __attribute__((ext_vector_type(4)));
typedef unsigned v2u __attribute__((ext_vector_type(2)));
typedef float f32x4 __attribute__((ext_vector_type(4)));
#define RLX_AGENT __ATOMIC_RELAXED, __HIP_MEMORY_SCOPE_AGENT
#define LDS_WAIT() asm volatile("s_waitcnt lgkmcnt(0)" ::: "memory")

__device__ __forceinline__ unsigned f2bf(float f) { unsigned u = __builtin_bit_cast(unsigned, f); return (u + 0x7fffu + ((u >> 16) & 1u)) >> 16; }
__device__ __forceinline__ unsigned pk2(float lo, float hi) { return f2bf(lo) | (f2bf(hi) << 16); }
__device__ __forceinline__ float bflo(unsigned w) { return __builtin_bit_cast(float, w << 16); }
__device__ __forceinline__ float bfhi(unsigned w) { return __builtin_bit_cast(float, w & 0xffff0000u); }
__device__ __forceinline__ float bf2f(bf16 b) { return __builtin_bit_cast(float, (unsigned)b << 16); }
__device__ __forceinline__ float wave_sum(float v) {
#pragma unroll
    for (int o = 1; o < 64; o <<= 1) v += __shfl_xor(v, o);
    return v;
}
__device__ __forceinline__ float silu_f(float v) { return v / (1.f + __expf(-v)); }

#define XB_TMO      128
#define XB_XCNT(j)  (256  + 64 * (j))
#define XB_XSUB(j)  (1280 + 64 * (j))
#define XB_XGEN(j)  (2304 + 64 * (j))
#define XB_TOP      3328
#define XB_TOPGEN   3392
#define XCD_BAR_WORDS 3456
#define XB_SPIN_CAP (1u << 18)
__device__ __forceinline__ unsigned xb_ld(unsigned* p)              { return __hip_atomic_load(p, __ATOMIC_RELAXED, __HIP_MEMORY_SCOPE_AGENT); }
__device__ __forceinline__ unsigned xb_add(unsigned* p, unsigned v) { return __hip_atomic_fetch_add(p, v, __ATOMIC_RELAXED, __HIP_MEMORY_SCOPE_AGENT); }
__device__ __forceinline__ unsigned xb_xcc_id() { return (unsigned)__builtin_amdgcn_s_getreg((3 << 11) | 20) & 0xFu; }
#define XB_SPIN(cond, bar) do { unsigned _sp = 0; while (cond) { __builtin_amdgcn_s_sleep(1); \
    if ((++_sp & 255u) == 0u) { if (xb_ld(&(bar)[XB_TMO])) break; if (_sp > XB_SPIN_CAP) { atomicAdd(&(bar)[XB_TMO], 1u); break; } } } } while (0)
struct XcdBarrier { unsigned* bar; unsigned x; volatile LAS unsigned* st; };
__device__ __forceinline__ XcdBarrier xcd_barrier_post(unsigned* bar, volatile LAS unsigned* st) {
    XcdBarrier b; b.bar = bar; b.x = xb_xcc_id(); b.st = st;
    if (threadIdx.x == 0) (void)xb_add(&bar[XB_XCNT(b.x)], 1u);
    return b;
}
__device__ __forceinline__ void xcd_barrier_complete(unsigned* bar, unsigned x, unsigned& nloc, unsigned& nx) {
    const unsigned G = gridDim.x * gridDim.y * gridDim.z;
    unsigned sum, cnt, mine, sp = 0u;
    for (;;) {
        sum = 0u; cnt = 0u; mine = 0u;
#pragma unroll
        for (unsigned j = 0; j < 16; ++j) { const unsigned c = xb_ld(&bar[XB_XCNT(j)]); sum += c; cnt += (c > 0u) ? 1u : 0u; mine = (j == x) ? c : mine; }
        if (sum == G) break;
        __builtin_amdgcn_s_sleep(1);
        if ((++sp & 255u) == 0u) { if (xb_ld(&bar[XB_TMO])) break; if (sp > XB_SPIN_CAP) { atomicAdd(&bar[XB_TMO], 1u); break; } }
    }
    nloc = mine > 0u ? mine : 1u; nx = cnt > 0u ? cnt : 1u;
}
__device__ __forceinline__ void xcd_barrier(const XcdBarrier& b) {
    asm volatile("s_waitcnt vmcnt(0)" ::: "memory");
    __syncthreads();
    if (threadIdx.x == 0) {
        unsigned* bar = b.bar;
        __builtin_amdgcn_s_waitcnt(0);
        unsigned nloc = b.st[0], nx = b.st[1];
        if (nloc == 0u) { xcd_barrier_complete(bar, b.x, nloc, nx); b.st[0] = nloc; b.st[1] = nx; }
        const unsigned old = xb_add(&bar[XB_XSUB(b.x)], 1u);
        const unsigned gen = old / nloc;
        if (old + 1u == (gen + 1u) * nloc) {
            __builtin_amdgcn_fence(__ATOMIC_RELEASE, "agent");
            asm volatile("s_waitcnt vmcnt(0)" ::: "memory");
            const unsigned og = xb_add(&bar[XB_TOP], 1u);
            const unsigned tg = og / nx;
            if (og + 1u == (tg + 1u) * nx) xb_add(&bar[XB_TOPGEN], 1u);
            else XB_SPIN(xb_ld(&bar[XB_TOPGEN]) == tg, bar);
            __builtin_amdgcn_fence(__ATOMIC_ACQUIRE, "agent");
            xb_add(&bar[XB_XGEN(b.x)], 1u);
            asm volatile("s_waitcnt vmcnt(0)" ::: "memory");
        } else {
            XB_SPIN(xb_ld(&bar[XB_XGEN(b.x)]) == gen, bar);
            __builtin_amdgcn_fence(__ATOMIC_ACQUIRE, "agent");
            asm volatile("s_waitcnt vmcnt(0)" ::: "memory");
        }
    }
    __syncthreads();
}

struct Frame {
    unsigned char* lds;
    unsigned* ctl;
    int tid, lane, wave, G, bid;
    const float *x, *g1, *w_in, *lq1, *lk1, *lq2, *lk2, *subg, *w_out, *g2, *wrg, *brg, *wre, *bre, *wg, *wu, *wd, *gf;
    float* out;
    unsigned char* ws;
};
struct Unit { int pm, pn, pb; };

struct DenseOrder {
    int nM, nN, G, c;
    __device__ __forceinline__ bool next(int i, Unit& u) const { const int L = i * G + c; if (L >= nM * nN) return false; u.pm = L / nN; u.pn = L % nN; u.pb = u.pn; return true; }
};
struct GroupedOrder {
    const int* tile_e; int ntiles, nN, G, c;
    __device__ __forceinline__ bool next(int i, Unit& u) const { const int L = i * G + c; if (L >= ntiles * nN) return false; u.pm = L / nN; u.pn = L % nN; u.pb = tile_e[u.pm] * nN + u.pn; return true; }
};

template <bool DUAL, class Sched, class Epi>
__device__ __forceinline__ void naive_gemm(Frame& F, const bf16* A, const bf16* Bt, int K, const Sched& S, const Epi& E) {
    float* As = (float*)F.lds; float* Bs = As + 32 * 68; float* Bs2 = Bs + 32 * 68;
    const int tid = F.tid, ty = tid >> 4, tx = tid & 15, lr = tid >> 3, lk = (tid & 7) * 4;
    Unit u;
    for (int i = 0; S.next(i, u); ++i) {
        for (int sm = 0; sm < 4; ++sm)
            for (int sn = 0; sn < (DUAL ? 2 : 4); ++sn) {
                float acc[2][4], acc2[2][4];
#pragma unroll
                for (int a = 0; a < 2; ++a)
#pragma unroll
                    for (int b = 0; b < 4; ++b) { acc[a][b] = 0.f; acc2[a][b] = 0.f; }
                const bf16* ap = A + (size_t)(256 * u.pm + 64 * sm + lr) * K + lk;
                const bf16* bp = Bt + (size_t)(256 * u.pb + 64 * sn + lr) * K + lk;
                for (int k0 = 0; k0 < K; k0 += 32) {
                    __syncthreads();
                    { const v2u w = *(const v2u*)(ap + k0); As[(lk + 0) * 68 + lr] = bflo(w.x); As[(lk + 1) * 68 + lr] = bfhi(w.x); As[(lk + 2) * 68 + lr] = bflo(w.y); As[(lk + 3) * 68 + lr] = bfhi(w.y); }
                    { const v2u w = *(const v2u*)(bp + k0); Bs[(lk + 0) * 68 + lr] = bflo(w.x); Bs[(lk + 1) * 68 + lr] = bfhi(w.x); Bs[(lk + 2) * 68 + lr] = bflo(w.y); Bs[(lk + 3) * 68 + lr] = bfhi(w.y); }
                    if (DUAL) { const v2u w = *(const v2u*)(bp + (size_t)128 * K + k0); Bs2[(lk + 0) * 68 + lr] = bflo(w.x); Bs2[(lk + 1) * 68 + lr] = bfhi(w.x); Bs2[(lk + 2) * 68 + lr] = bflo(w.y); Bs2[(lk + 3) * 68 + lr] = bfhi(w.y); }
                    __syncthreads();
#pragma unroll 8
                    for (int k = 0; k < 32; ++k) {
                        const float a0 = As[k * 68 + 2 * ty], a1 = As[k * 68 + 2 * ty + 1];
                        const f32x4 b = *(const f32x4*)(Bs + k * 68 + 4 * tx);
#pragma unroll
                        for (int j = 0; j < 4; ++j) { acc[0][j] += a0 * b[j]; acc[1][j] += a1 * b[j]; }
                        if (DUAL) { const f32x4 b2 = *(const f32x4*)(Bs2 + k * 68 + 4 * tx);
#pragma unroll
                            for (int j = 0; j < 4; ++j) { acc2[0][j] += a0 * b2[j]; acc2[1][j] += a1 * b2[j]; } }
                    }
                }
#pragma unroll
                for (int a = 0; a < 2; ++a)
#pragma unroll
                    for (int j = 0; j < 4; ++j) {
                        const int row = 256 * u.pm + 64 * sm + 2 * ty + a;
                        if (DUAL) E.elem(row, 128 * u.pn + 64 * sn + 4 * tx + j, silu_f(acc[a][j]) * acc2[a][j]);
                        else E.elem(row, 256 * u.pn + 64 * sn + 4 * tx + j, acc[a][j]);
                    }
            }
    }
    __syncthreads();
}
struct NEpiBf16 { bf16* O; int ldc; __device__ __forceinline__ void elem(int row, int col, float v) const { O[(size_t)row * ldc + col] = (bf16)f2bf(v); } };
struct NEpiResF32 { const float* base; float* O; int ldc; __device__ __forceinline__ void elem(int row, int col, float v) const { const size_t o = (size_t)row * ldc + col; O[o] = base[o] + v; } };
struct NEpiScatter { const int* stok; const float* sw; bf16* Y; __device__ __forceinline__ void elem(int row, int col, float v) const { const int tk = stok[row]; if (tk >= 0) Y[(size_t)tk * D + col] = (bf16)f2bf(v * sw[row]); } };

__device__ __forceinline__ void p0_transpose_item(const float* W, int K, int N, bf16* WT, int k0, int n0, int dstrow0, float scale, float* scr, int lane) {
#pragma unroll 8
    for (int i = 0; i < 32; ++i) { const int kk = 2 * i + (lane >> 5); scr[kk * 33 + (lane & 31)] = W[(size_t)(k0 + kk) * N + n0 + (lane & 31)] * scale; }
    LDS_WAIT(); asm volatile("" ::: "memory");
    const int c = lane & 7;
#pragma unroll
    for (int j = 0; j < 4; ++j) { const int n = (lane >> 3) + 8 * j; const float* s = scr + (8 * c) * 33 + n;
        v4u o; o.x = pk2(s[0 * 33], s[1 * 33]); o.y = pk2(s[2 * 33], s[3 * 33]); o.z = pk2(s[4 * 33], s[5 * 33]); o.w = pk2(s[6 * 33], s[7 * 33]);
        *(v4u*)(WT + (size_t)(dstrow0 + n) * K + k0 + 8 * c) = o; }
    LDS_WAIT(); asm volatile("" ::: "memory");
}
__device__ __forceinline__ void rms_row_to_bf16(const float* xrow, const float* g, bf16* orow, int lane) {
    const f32x4* xr = (const f32x4*)xrow + lane; const f32x4* gr = (const f32x4*)g + lane;
    f32x4 v[4]; float s = 0.f;
#pragma unroll
    for (int j = 0; j < 4; ++j) { v[j] = xr[64 * j]; s += (v[j].x * v[j].x + v[j].y * v[j].y) + (v[j].z * v[j].z + v[j].w * v[j].w); }
    const float rstd = 1.f / sqrtf(wave_sum(s) * (1.f / D) + EPS);
    unsigned long long* o8 = (unsigned long long*)orow + lane;
#pragma unroll
    for (int j = 0; j < 4; ++j) { const f32x4 gg = gr[64 * j];
        o8[64 * j] = (unsigned long long)pk2(v[j].x * rstd * gg.x, v[j].y * rstd * gg.y) | ((unsigned long long)pk2(v[j].z * rstd * gg.z, v[j].w * rstd * gg.w) << 32); }
}
__device__ __forceinline__ void p0_prologue(Frame& F) {
    float* scr = (float*)(F.lds + F.wave * 16384);
    const int gw = F.bid * NWAVES + F.wave, NGW = F.G * NWAVES;
    bf16* WinT = (bf16*)(F.ws + WS_WIN); bf16* WoutT = (bf16*)(F.ws + WS_WOUT); bf16* WguT = (bf16*)(F.ws + WS_WGU); bf16* WdT = (bf16*)(F.ws + WS_WD);
    constexpr int I_IN = 16 * 96, I_OUT = 16 * 32, I_E = 768, NITEMS = I_IN + I_OUT + NE * I_E;
    for (int it = gw; it < NITEMS; it += NGW) {
        int r = it;
        if (r < I_IN) { const int kb = r / 96, nb = r % 96, n0 = 32 * nb; const float sc = (n0 < C_KDA) ? C2 : ((n0 >= C_KR && n0 < C_VR) ? 0.125f : 1.f);
            p0_transpose_item(F.w_in, D, NIN, WinT, 64 * kb, n0, n0, sc, scr, F.lane); continue; }
        r -= I_IN;
        if (r < I_OUT) { const int kb = r / 32, nb = r % 32; p0_transpose_item(F.w_out, D, D, WoutT, 64 * kb, 32 * nb, 32 * nb, 1.f, scr, F.lane); continue; }
        r -= I_OUT;
        const int e = r / I_E; r %= I_E;
        if (r < 256) { const int kb = r / 16, nb = r % 16, n0 = 32 * nb; p0_transpose_item(F.wg + (size_t)e * D * HIDN, D, HIDN, WguT + (size_t)e * 1024 * D, 64 * kb, n0, 256 * (n0 >> 7) + (n0 & 127), 1.f, scr, F.lane); continue; }
        r -= 256;
        if (r < 256) { const int kb = r / 16, nb = r % 16, n0 = 32 * nb; p0_transpose_item(F.wu + (size_t)e * D * HIDN, D, HIDN, WguT + (size_t)e * 1024 * D, 64 * kb, n0, 256 * (n0 >> 7) + 128 + (n0 & 127), 1.f, scr, F.lane); continue; }
        r -= 256;
        { const int kb = r / 32, nb = r % 32; p0_transpose_item(F.wd + (size_t)e * HIDN * D, HIDN, D, WdT + (size_t)e * D * HIDN, 64 * kb, 32 * nb, 32 * nb, 1.f, scr, F.lane); }
    }
    float* WrT = (float*)(F.ws + WS_WRT);
    for (int i = F.bid * 512 + F.tid; i < NRT * D; i += F.G * 512) { const int c = i / D, k = i % D; WrT[i] = (c < 4) ? F.wrg[k * 4 + c] : F.wre[k * 32 + (c - 4)]; }
    bf16* XN1 = (bf16*)(F.ws + WS_A);
    for (int m = gw; m < T; m += NGW) rms_row_to_bf16(F.x + (size_t)m * D, F.g1, XN1 + (size_t)m * D, F.lane);
}

__device__ __forceinline__ float dot8(const v4u a, const v4u b) {
    return (bflo(a.x) * bflo(b.x) + bfhi(a.x) * bfhi(b.x)) + (bflo(a.y) * bflo(b.y) + bfhi(a.y) * bfhi(b.y)) + (bflo(a.z) * bflo(b.z) + bfhi(a.z) * bfhi(b.z)) + (bflo(a.w) * bflo(b.w) + bfhi(a.w) * bfhi(b.w));
}
__device__ __forceinline__ void naive_attn_unit(Frame& F, int h, int c, float lam, float slope2) {
    constexpr int QS = 136;
    bf16* Qs = (bf16*)F.lds; bf16* Ks = Qs + 64 * QS; float* Vs = (float*)(Ks + 64 * QS); float* Ps = Vs + 64 * 128;
    const bf16* PROJ = (const bf16*)(F.ws + WS_PROJ);
    const int tid = F.tid, q = tid >> 3, sub = tid & 7;
    const int qpos = 64 * c + q;
    __syncthreads();
    { const v4u* src = (const v4u*)(PROJ + (size_t)(64 * c + q) * NIN + C_QDA + h * 128 + sub * 16); v4u* dst = (v4u*)(Qs + q * QS + sub * 16); dst[0] = src[0]; dst[1] = src[1]; }
    float m0 = -1e30f, m1 = -1e30f, l0 = 0.f, l1 = 0.f, o0[16], o1[16];
#pragma unroll
    for (int i = 0; i < 16; ++i) { o0[i] = 0.f; o1[i] = 0.f; }
    for (int j = 0; j <= c; ++j) {
        __syncthreads();
        { const size_t row = (size_t)(64 * j + q) * NIN;
          const v4u* ks = (const v4u*)(PROJ + row + C_KDA + h * 128 + sub * 16); v4u* kd = (v4u*)(Ks + q * QS + sub * 16); kd[0] = ks[0]; kd[1] = ks[1];
          const v4u* vs = (const v4u*)(PROJ + row + C_VDA + h * 128 + sub * 16); const v4u a = vs[0], b = vs[1]; float* vd = Vs + q * 128 + sub * 16;
          vd[0] = bflo(a.x); vd[1] = bfhi(a.x); vd[2] = bflo(a.y); vd[3] = bfhi(a.y); vd[4] = bflo(a.z); vd[5] = bfhi(a.z); vd[6] = bflo(a.w); vd[7] = bfhi(a.w);
          vd[8] = bflo(b.x); vd[9] = bfhi(b.x); vd[10] = bflo(b.y); vd[11] = bfhi(b.y); vd[12] = bflo(b.z); vd[13] = bfhi(b.z); vd[14] = bflo(b.w); vd[15] = bfhi(b.w); }
        __syncthreads();
        float s0[8], s1[8];
#pragma unroll
        for (int kk = 0; kk < 8; ++kk) { s0[kk] = 0.f; s1[kk] = 0.f; }
#pragma unroll 1
        for (int d8 = 0; d8 < 8; ++d8) {
            const v4u qa = *(const v4u*)(Qs + q * QS + d8 * 8), qb = *(const v4u*)(Qs + q * QS + 64 + d8 * 8);
#pragma unroll
            for (int kk = 0; kk < 8; ++kk) { const int k = sub + 8 * kk;
                s0[kk] += dot8(qa, *(const v4u*)(Ks + k * QS + d8 * 8));
                if ((kk & 1) == 1) asm volatile("" ::: "memory"); }
#pragma unroll
            for (int kk = 0; kk < 8; ++kk) { const int k = sub + 8 * kk;
                s1[kk] += dot8(qb, *(const v4u*)(Ks + k * QS + 64 + d8 * 8));
                if ((kk & 1) == 1) asm volatile("" ::: "memory"); }
        }
#pragma unroll
        for (int kk = 0; kk < 8; ++kk) { const float dist = fabsf((float)(qpos - (64 * j + sub + 8 * kk))); s0[kk] -= slope2 * dist; s1[kk] -= slope2 * dist; }
        float t0 = s0[0], t1 = s1[0];
#pragma unroll
        for (int kk = 1; kk < 8; ++kk) { t0 = fmaxf(t0, s0[kk]); t1 = fmaxf(t1, s1[kk]); }
#pragma unroll
        for (int o = 1; o < 8; o <<= 1) { t0 = fmaxf(t0, __shfl_xor(t0, o)); t1 = fmaxf(t1, __shfl_xor(t1, o)); }
        const float mn0 = fmaxf(m0, t0), mn1 = fmaxf(m1, t1), al0 = exp2f(m0 - mn0), al1 = exp2f(m1 - mn1);
        m0 = mn0; m1 = mn1;
        float ps0 = 0.f, ps1 = 0.f;
#pragma unroll
        for (int kk = 0; kk < 8; ++kk) { const int k = sub + 8 * kk; const float p0 = exp2f(s0[kk] - mn0), p1 = exp2f(s1[kk] - mn1); ps0 += p0; ps1 += p1; Ps[q * 65 + k] = p0; Ps[64 * 65 + q * 65 + k] = p1; }
#pragma unroll
        for (int o = 1; o < 8; o <<= 1) { ps0 += __shfl_xor(ps0, o); ps1 += __shfl_xor(ps1, o); }
        l0 = l0 * al0 + ps0; l1 = l1 * al1 + ps1;
#pragma unroll
        for (int i = 0; i < 16; ++i) { o0[i] *= al0; o1[i] *= al1; }
        __syncthreads();
#pragma unroll 1
        for (int k = 0; k < 64; ++k) {
            const float p0 = Ps[q * 65 + k], p1 = Ps[64 * 65 + q * 65 + k];
            const float* vr = Vs + k * 128 + sub * 16;
#pragma unroll
            for (int i4 = 0; i4 < 4; ++i4) { const f32x4 v = *(const f32x4*)(vr + 4 * i4);
#pragma unroll
                for (int e = 0; e < 4; ++e) { o0[4 * i4 + e] += p0 * v[e]; o1[4 * i4 + e] += p1 * v[e]; } }
        }
    }
    const float r0 = 1.f / l0, r1 = lam / l1; float dv[16], ss = 0.f;
#pragma unroll
    for (int i = 0; i < 16; ++i) { dv[i] = o0[i] * r0 - o1[i] * r1; ss += dv[i] * dv[i]; }
#pragma unroll
    for (int o = 1; o < 8; o <<= 1) ss += __shfl_xor(ss, o);
    const float rstd = 1.f / sqrtf(ss * (1.f / 128.f) + EPS) * (1.f - LAMBDA_INIT);
    bf16* MIX = (bf16*)(F.ws + WS_A);
    unsigned w[8];
#pragma unroll
    for (int i = 0; i < 8; ++i) w[i] = pk2(dv[2 * i] * rstd * F.subg[sub * 16 + 2 * i], dv[2 * i + 1] * rstd * F.subg[sub * 16 + 2 * i + 1]);
    v4u* dst = (v4u*)(MIX + (size_t)qpos * D + h * 128 + sub * 16);
    dst[0] = (v4u){w[0], w[1], w[2], w[3]}; dst[1] = (v4u){w[4], w[5], w[6], w[7]};
}
__device__ __forceinline__ void p2_attention(Frame& F) {
    float a = 0.f, b = 0.f;
#pragma unroll 1
    for (int i = 0; i < 64; ++i) { a += F.lq1[i] * F.lk1[i]; b += F.lq2[i] * F.lk2[i]; }
    const float lam = __expf(a) - __expf(b) + LAMBDA_INIT;
    for (int u = F.bid; u < 512; u += F.G) {
        const int h = u >> 7, s = u & 127;
        const float slope2 = exp2f(-2.f * (float)(h + 1)) * LOG2E;
#pragma unroll 1
        for (int rep = 0; rep < 2; ++rep) naive_attn_unit(F, h, rep ? 255 - s : s, lam, slope2);
    }
}

__device__ __forceinline__ float ret_lg(int h) { return log1pf(-exp2f(-5.f - (float)h)); }
__device__ __forceinline__ void p3_ret_kv(Frame& F) {
    float* Ks = (float*)F.lds; float* Vs = Ks + 64 * 64;
    const bf16* PROJ = (const bf16*)(F.ws + WS_PROJ); float* KV = F.out;
    const int tid = F.tid, r = tid >> 3, sub = tid & 7;
    for (int u = F.bid; u < 1024; u += F.G) {
        const int n = u >> 2, h = u & 3; const float lg = ret_lg(h);
        __syncthreads();
        { const size_t row = (size_t)(64 * n + r) * NIN; const float w = __expf(lg * (float)(63 - r));
          const v4u a = *(const v4u*)(PROJ + row + C_KR + h * 64 + sub * 8); float* kd = Ks + r * 64 + sub * 8;
          kd[0] = bflo(a.x) * w; kd[1] = bfhi(a.x) * w; kd[2] = bflo(a.y) * w; kd[3] = bfhi(a.y) * w; kd[4] = bflo(a.z) * w; kd[5] = bfhi(a.z) * w; kd[6] = bflo(a.w) * w; kd[7] = bfhi(a.w) * w;
          const v4u* vs = (const v4u*)(PROJ + row + C_VR + h * 128 + sub * 16); const v4u b = vs[0], c = vs[1]; float* vd = Vs + r * 128 + sub * 16;
          vd[0] = bflo(b.x); vd[1] = bfhi(b.x); vd[2] = bflo(b.y); vd[3] = bfhi(b.y); vd[4] = bflo(b.z); vd[5] = bfhi(b.z); vd[6] = bflo(b.w); vd[7] = bfhi(b.w);
          vd[8] = bflo(c.x); vd[9] = bfhi(c.x); vd[10] = bflo(c.y); vd[11] = bfhi(c.y); vd[12] = bflo(c.z); vd[13] = bfhi(c.z); vd[14] = bflo(c.w); vd[15] = bfhi(c.w); }
        __syncthreads();
        float acc[16];
#pragma unroll
        for (int i = 0; i < 16; ++i) acc[i] = 0.f;
        const int d = r;
        for (int s = 0; s < 64; ++s) { const float kv = Ks[s * 64 + d]; const float* vr = Vs + s * 128 + sub * 16;
#pragma unroll
            for (int i = 0; i < 16; ++i) acc[i] += kv * vr[i]; }
        float* dst = KV + ((size_t)(n * 4 + h) * 64 + d) * 128 + sub * 16;
#pragma unroll
        for (int i = 0; i < 16; ++i) dst[i] = acc[i];
    }
}
__device__ __forceinline__ void p4_ret_scan(Frame& F) {
    const float* KV = F.out; float* SP = F.out + (size_t)8 * 1024 * 1024;
    const int gid = F.bid * 512 + F.tid;
    if (gid < 32768) {
        const int h = gid >> 13; const float dec = __expf(ret_lg(h) * 64.f);
        float st = 0.f;
        for (int n = 0; n < 256; ++n) { const size_t o = (size_t)n * 32768 + gid; SP[o] = st; st = st * dec + KV[o]; }
    }
}
__device__ __forceinline__ void p5_ret_out(Frame& F) {
    float* Qs = (float*)F.lds; float* Ks = Qs + 64 * 65; float* Vs = Ks + 64 * 65; float* Ss = Vs + 64 * 128; float* Ps = Ss + 64 * 128;
    const bf16* PROJ = (const bf16*)(F.ws + WS_PROJ); const float* SP = F.out + (size_t)8 * 1024 * 1024; bf16* MIX = (bf16*)(F.ws + WS_A);
    const int tid = F.tid, r = tid >> 3, sub = tid & 7;
    for (int u = F.bid; u < 1024; u += F.G) {
        const int n = u >> 2, h = u & 3; const float lg = ret_lg(h);
        __syncthreads();
        { const size_t row = (size_t)(64 * n + r) * NIN;
          const v4u a = *(const v4u*)(PROJ + row + C_QR + h * 64 + sub * 8); float* qd = Qs + r * 65 + sub * 8;
          qd[0] = bflo(a.x); qd[1] = bfhi(a.x); qd[2] = bflo(a.y); qd[3] = bfhi(a.y); qd[4] = bflo(a.z); qd[5] = bfhi(a.z); qd[6] = bflo(a.w); qd[7] = bfhi(a.w);
          const v4u k = *(const v4u*)(PROJ + row + C_KR + h * 64 + sub * 8); float* kd = Ks + r * 65 + sub * 8;
          kd[0] = bflo(k.x); kd[1] = bfhi(k.x); kd[2] = bflo(k.y); kd[3] = bfhi(k.y); kd[4] = bflo(k.z); kd[5] = bfhi(k.z); kd[6] = bflo(k.w); kd[7] = bfhi(k.w);
          const v4u* vs = (const v4u*)(PROJ + row + C_VR + h * 128 + sub * 16); const v4u b = vs[0], c = vs[1]; float* vd = Vs + r * 128 + sub * 16;
          vd[0] = bflo(b.x); vd[1] = bfhi(b.x); vd[2] = bflo(b.y); vd[3] = bfhi(b.y); vd[4] = bflo(b.z); vd[5] = bfhi(b.z); vd[6] = bflo(b.w); vd[7] = bfhi(b.w);
          vd[8] = bflo(c.x); vd[9] = bfhi(c.x); vd[10] = bflo(c.y); vd[11] = bfhi(c.y); vd[12] = bflo(c.z); vd[13] = bfhi(c.z); vd[14] = bflo(c.w); vd[15] = bfhi(c.w);
          const float* sp = SP + ((size_t)(n * 4 + h) * 64 + r) * 128 + sub * 16; float* sd = Ss + r * 128 + sub * 16;
#pragma unroll
          for (int i = 0; i < 16; ++i) sd[i] = sp[i]; }
        __syncthreads();
#pragma unroll 1
        for (int jj = 0; jj < 8; ++jj) { const int j = sub + 8 * jj; float s = 0.f;
#pragma unroll 8
            for (int d = 0; d < 64; ++d) s += Qs[r * 65 + d] * Ks[j * 65 + d];
            Ps[r * 65 + j] = (j <= r) ? s * __expf(lg * (float)(r - j)) : 0.f; }
        __syncthreads();
        float acc[16];
#pragma unroll
        for (int i = 0; i < 16; ++i) acc[i] = 0.f;
#pragma unroll 2
        for (int j = 0; j < 64; ++j) { const float p = Ps[r * 65 + j]; const float* vr = Vs + j * 128 + sub * 16;
#pragma unroll
            for (int i = 0; i < 16; ++i) acc[i] += p * vr[i]; }
        const float qd = __expf(lg * (float)(r + 1));
#pragma unroll 2
        for (int d = 0; d < 64; ++d) { const float qv = Qs[r * 65 + d] * qd; const float* sr = Ss + d * 128 + sub * 16;
#pragma unroll
            for (int i = 0; i < 16; ++i) acc[i] += qv * sr[i]; }
        float ss = 0.f;
#pragma unroll
        for (int i = 0; i < 16; ++i) ss += acc[i] * acc[i];
#pragma unroll
        for (int o = 1; o < 8; o <<= 1) ss += __shfl_xor(ss, o);
        const float rstd = 1.f / sqrtf(ss * (1.f / 128.f) + EPS);
        const size_t row = (size_t)(64 * n + r);
        const v4u* gs = (const v4u*)(PROJ + row * NIN + C_GR + h * 128 + sub * 16); const v4u ga = gs[0], gb = gs[1];
        const float gv[16] = {bflo(ga.x), bfhi(ga.x), bflo(ga.y), bfhi(ga.y), bflo(ga.z), bfhi(ga.z), bflo(ga.w), bfhi(ga.w), bflo(gb.x), bfhi(gb.x), bflo(gb.y), bfhi(gb.y), bflo(gb.z), bfhi(gb.z), bflo(gb.w), bfhi(gb.w)};
        unsigned w[8];
#pragma unroll
        for (int i = 0; i < 8; ++i) w[i] = pk2(silu_f(gv[2 * i]) * acc[2 * i] * rstd, silu_f(gv[2 * i + 1]) * acc[2 * i + 1] * rstd);
        v4u* dst = (v4u*)(MIX + row * D + 512 + h * 128 + sub * 16);
        dst[0] = (v4u){w[0], w[1], w[2], w[3]}; dst[1] = (v4u){w[4], w[5], w[6], w[7]};
    }
}

__device__ __forceinline__ void p7_route(Frame& F) {
    const float* H = F.out; bf16* XN2 = (bf16*)(F.ws + WS_A); const float* WrT = (const float*)(F.ws + WS_WRT);
    int* tok_e = (int*)(F.ws + WS_TOK + TK_E); int* tok_pos = (int*)(F.ws + WS_TOK + TK_POS); float* tok_w = (float*)(F.ws + WS_TOK + TK_W);
    const int gw = F.bid * NWAVES + F.wave, NGW = F.G * NWAVES, lane = F.lane;
    for (int t = gw; t < T; t += NGW) {
        const f32x4* xr = (const f32x4*)(H + (size_t)t * D) + lane; const f32x4* gr = (const f32x4*)F.g2 + lane;
        f32x4 v[4]; float s = 0.f;
#pragma unroll
        for (int j = 0; j < 4; ++j) { v[j] = xr[64 * j]; s += (v[j].x * v[j].x + v[j].y * v[j].y) + (v[j].z * v[j].z + v[j].w * v[j].w); }
        const float rstd = 1.f / sqrtf(wave_sum(s) * (1.f / D) + EPS);
        unsigned long long* o8 = (unsigned long long*)(XN2 + (size_t)t * D) + lane;
#pragma unroll
        for (int j = 0; j < 4; ++j) { const f32x4 gg = gr[64 * j]; v[j].x *= rstd * gg.x; v[j].y *= rstd * gg.y; v[j].z *= rstd * gg.z; v[j].w *= rstd * gg.w;
            o8[64 * j] = (unsigned long long)pk2(v[j].x, v[j].y) | ((unsigned long long)pk2(v[j].z, v[j].w) << 32); }
        float lg[4];
#pragma unroll
        for (int c = 0; c < 4; ++c) { const f32x4* wr = (const f32x4*)(WrT + (size_t)c * D) + lane; float p = 0.f;
#pragma unroll
            for (int j = 0; j < 4; ++j) { const f32x4 w = wr[64 * j]; p += (v[j].x * w.x + v[j].y * w.y) + (v[j].z * w.z + v[j].w * w.w); }
            lg[c] = wave_sum(p) + F.brg[c]; }
        int grp = 0; float gm = lg[0];
#pragma unroll
        for (int c = 1; c < 4; ++c) if (lg[c] > gm) { gm = lg[c]; grp = c; }
        float gs = 0.f;
#pragma unroll
        for (int c = 0; c < 4; ++c) gs += __expf(lg[c] - gm);
        const float gtop = 1.f / gs;
        float el[8];
#pragma unroll
        for (int i = 0; i < 8; ++i) { const f32x4* wr = (const f32x4*)(WrT + (size_t)(4 + grp * 8 + i) * D) + lane; float p = 0.f;
#pragma unroll
            for (int j = 0; j < 4; ++j) { const f32x4 w = wr[64 * j]; p += (v[j].x * w.x + v[j].y * w.y) + (v[j].z * w.z + v[j].w * w.w); }
            el[i] = wave_sum(p) + F.bre[grp * 8 + i]; }
        int i1 = 0; float v1 = el[0];
#pragma unroll
        for (int i = 1; i < 8; ++i) if (el[i] > v1) { v1 = el[i]; i1 = i; }
        int i2 = -1; float v2 = -3.0e38f;
#pragma unroll
        for (int i = 0; i < 8; ++i) if (i != i1 && el[i] > v2) { v2 = el[i]; i2 = i; }
        const float ex = __expf(v2 - v1), w1 = 1.f / (1.f + ex), w2 = ex / (1.f + ex);
        if (lane == 0) {
            const int e1 = grp * 8 + i1, e2 = grp * 8 + i2;
            const int p1 = (int)__hip_atomic_fetch_add(F.ctl + CW_CNT + 64 * e1, 1u, RLX_AGENT);
            const int p2 = (int)__hip_atomic_fetch_add(F.ctl + CW_CNT + 64 * e2, 1u, RLX_AGENT);
            tok_e[2 * t] = e1; tok_e[2 * t + 1] = e2; tok_pos[2 * t] = p1; tok_pos[2 * t + 1] = p2; tok_w[2 * t] = gtop * w1; tok_w[2 * t + 1] = gtop * w2;
        }
    }
}
__device__ __forceinline__ int build_tiles(Frame& F) {
    int* tile_e = (int*)(F.lds + TILEE_OFF); int* base = tile_e + 192; int* cnts = base + 32; int* nt = cnts + 32;
    __syncthreads();
    if (F.tid == 0) { int tiles = 0;
        for (int e = 0; e < NE; ++e) { const int c = (int)__hip_atomic_load(F.ctl + CW_CNT + 64 * e, RLX_AGENT); cnts[e] = c; base[e] = tiles * 256; const int n = (c + 255) >> 8; for (int i = 0; i < n; ++i) tile_e[tiles + i] = e; tiles += n; }
        nt[0] = tiles; }
    __syncthreads();
    return nt[0];
}
__device__ __forceinline__ void p8_permute(Frame& F) {
    (void)build_tiles(F);
    const int* base = (const int*)(F.lds + TILEE_OFF) + 192; const int* cnts = base + 32;
    const bf16* XN2 = (const bf16*)(F.ws + WS_A); bf16* XS = (bf16*)(F.ws + WS_PROJ);
    const int* tok_e = (const int*)(F.ws + WS_TOK + TK_E); const int* tok_pos = (const int*)(F.ws + WS_TOK + TK_POS); const float* tok_w = (const float*)(F.ws + WS_TOK + TK_W);
    int* stok = (int*)(F.ws + WS_TOK + TK_STOK); float* sw = (float*)(F.ws + WS_TOK + TK_SW);
    const int gw = F.bid * NWAVES + F.wave, NGW = F.G * NWAVES, lane = F.lane;
    for (int s = gw; s < NSLOT; s += NGW) {
        const int t = s >> 1, e = tok_e[s], dest = base[e] + tok_pos[s];
        const v4u* src = (const v4u*)(XN2 + (size_t)t * D) + lane; v4u* dst = (v4u*)(XS + (size_t)dest * D) + lane;
        dst[0] = src[0]; dst[64] = src[64];
        if (lane == 0) { stok[dest] = s; sw[dest] = tok_w[s]; }
    }
    for (int i = gw; i < NE * 256; i += NGW) { const int e = i >> 8, r = i & 255, c = cnts[e], padn = ((c + 255) & ~255) - c;
        if (r < padn) { const int dest = base[e] + c + r; v4u* dst = (v4u*)(XS + (size_t)dest * D) + lane; dst[0] = (v4u){0u, 0u, 0u, 0u}; dst[64] = (v4u){0u, 0u, 0u, 0u}; if (lane == 0) { stok[dest] = -1; sw[dest] = 0.f; } } }
}
__device__ __forceinline__ void p11_final(Frame& F) {
    const bf16* Y = (const bf16*)(F.ws + WS_WGU);
    const int gw = F.bid * NWAVES + F.wave, NGW = F.G * NWAVES, lane = F.lane;
    for (int t = gw; t < T; t += NGW) {
        f32x4* xr = (f32x4*)(F.out + (size_t)t * D) + lane; const f32x4* gr = (const f32x4*)F.gf + lane;
        const v2u* y0 = (const v2u*)(Y + (size_t)(2 * t) * D) + lane; const v2u* y1 = (const v2u*)(Y + (size_t)(2 * t + 1) * D) + lane;
        f32x4 v[4]; float s = 0.f;
#pragma unroll
        for (int j = 0; j < 4; ++j) { v[j] = xr[64 * j]; const v2u a = y0[64 * j], b = y1[64 * j];
            v[j].x += bflo(a.x) + bflo(b.x); v[j].y += bfhi(a.x) + bfhi(b.x); v[j].z += bflo(a.y) + bflo(b.y); v[j].w += bfhi(a.y) + bfhi(b.y);
            s += (v[j].x * v[j].x + v[j].y * v[j].y) + (v[j].z * v[j].z + v[j].w * v[j].w); }
        const float rstd = 1.f / sqrtf(wave_sum(s) * (1.f / D) + EPS);
#pragma unroll
        for (int j = 0; j < 4; ++j) { const f32x4 gg = gr[64 * j]; xr[64 * j] = (f32x4){v[j].x * rstd * gg.x, v[j].y * rstd * gg.y, v[j].z * rstd * gg.z, v[j].w * rstd * gg.w}; }
    }
}

struct Args { const float* in[18]; float* out; unsigned char* ws; int ph_lo, ph_hi; };
__global__ void __launch_bounds__(NWAVES * 64, 2) fwd_kernel(Args args) {
    extern __shared__ __attribute__((aligned(16))) unsigned char lds[];
    Frame F;
    F.lds = lds; F.tid = threadIdx.x; F.lane = F.tid & 63; F.wave = __builtin_amdgcn_readfirstlane(F.tid >> 6); F.G = gridDim.x; F.bid = blockIdx.x;
    F.ws = args.ws; F.ctl = (unsigned*)(args.ws + WS_CTL); F.out = args.out;
    F.x = args.in[0]; F.g1 = args.in[1]; F.w_in = args.in[2]; F.lq1 = args.in[3]; F.lk1 = args.in[4]; F.lq2 = args.in[5]; F.lk2 = args.in[6]; F.subg = args.in[7];
    F.w_out = args.in[8]; F.g2 = args.in[9]; F.wrg = args.in[10]; F.brg = args.in[11]; F.wre = args.in[12]; F.bre = args.in[13]; F.wg = args.in[14]; F.wu = args.in[15]; F.wd = args.in[16]; F.gf = args.in[17];
    volatile LAS unsigned* MISC = (volatile LAS unsigned*)((LAS unsigned char*)lds + MISC_OFF);
    for (int u = F.tid; u < (LDS_BYTES - LDSCTL_OFF) / 4; u += NWAVES * 64) ((LAS unsigned*)((LAS unsigned char*)lds + LDSCTL_OFF))[u] = 0u;
    __syncthreads();
    const int lo = args.ph_lo, hi = args.ph_hi;
    XcdBarrier bar; bar.bar = F.ctl + CW_BAR; bar.x = 0; bar.st = nullptr;
    if (hi - lo > 1) bar = xcd_barrier_post(F.ctl + CW_BAR, MISC + 8);
#ifndef PH_MASK
#define PH_MASK 0xFFFF
#endif
#define IN(k) (((PH_MASK >> (k)) & 1) && lo <= (k) && (k) < hi)
#define SEAM(k) do { if (IN(k) && IN((k) + 1)) xcd_barrier(bar); } while (0)
    if (IN(0)) { p0_prologue(F); } SEAM(0);
    if (IN(1)) { DenseOrder S{T / 256, NIN / 256, F.G, F.bid}; NEpiBf16 E{(bf16*)(F.ws + WS_PROJ), NIN};
        naive_gemm<false>(F, (const bf16*)(F.ws + WS_A), (const bf16*)(F.ws + WS_WIN), D, S, E); } SEAM(1);
    if (IN(2)) { p3_ret_kv(F); } SEAM(2);
    if (IN(3)) { p4_ret_scan(F); p2_attention(F); } SEAM(3);
    if (IN(4)) { p5_ret_out(F); } SEAM(4);
    if (IN(5)) { DenseOrder S{T / 256, D / 256, F.G, F.bid}; NEpiResF32 E{F.x, F.out, D};
        naive_gemm<false>(F, (const bf16*)(F.ws + WS_A), (const bf16*)(F.ws + WS_WOUT), D, S, E); } SEAM(5);
    if (IN(6)) { p7_route(F); } SEAM(6);
    if (IN(7)) { p8_permute(F); } SEAM(7);
    if (IN(8)) { const int nt = build_tiles(F); GroupedOrder S{(const int*)(F.lds + TILEE_OFF), nt, 4, F.G, F.bid}; NEpiBf16 E{(bf16*)(F.ws + WS_A), HIDN};
        naive_gemm<true>(F, (const bf16*)(F.ws + WS_PROJ), (const bf16*)(F.ws + WS_WGU), D, S, E); } SEAM(8);
    if (IN(9)) { const int nt = build_tiles(F); GroupedOrder S{(const int*)(F.lds + TILEE_OFF), nt, 4, F.G, F.bid};
        NEpiScatter E{(const int*)(F.ws + WS_TOK + TK_STOK), (const float*)(F.ws + WS_TOK + TK_SW), (bf16*)(F.ws + WS_WGU)};
        naive_gemm<false>(F, (const bf16*)(F.ws + WS_A), (const bf16*)(F.ws + WS_WD), HIDN, S, E); } SEAM(9);
    if (IN(10)) { p11_final(F); }
#undef IN
#undef SEAM
}

extern "C" void kernel_launch(void* const* d_in, const int* in_sizes, int n_in, void* d_out, int out_size, void* d_ws, size_t ws_size, hipStream_t stream) {
    static int grid = 0;
    if (grid == 0) {
        if (n_in != 18 || in_sizes[0] != T * D || out_size != T * D || ws_size < WS_END) { fprintf(stderr, "kernel_launch: shape mismatch n_in %d in0 %d out %d ws %zu\n", n_in, n_in > 0 ? in_sizes[0] : -1, out_size, ws_size); grid = -1; return; }
        int dev = 0, cus = 0, per_cu = 0;
        if (hipGetDevice(&dev) != hipSuccess || hipDeviceGetAttribute(&cus, hipDeviceAttributeMultiprocessorCount, dev) != hipSuccess) { grid = -1; return; }
        if (hipFuncSetAttribute((const void*)fwd_kernel, hipFuncAttributeMaxDynamicSharedMemorySize, LDS_BYTES) != hipSuccess) { fprintf(stderr, "kernel_launch: hipFuncSetAttribute failed\n"); grid = -1; return; }
        if (hipOccupancyMaxActiveBlocksPerMultiprocessor(&per_cu, (const void*)fwd_kernel, NWAVES * 64, LDS_BYTES) != hipSuccess || per_cu < 1) fprintf(stderr, "kernel_launch: occupancy query says %d\n", per_cu);
        (void)hipGetLastError();
        grid = cus;
    }
    if (grid < 0) return;
    (void)hipMemsetAsync((char*)d_ws + WS_CTL, 0, CTL_ZERO_BYTES, stream);
    Args a{};
    for (int i = 0; i < 18; ++i) a.in[i] = (const float*)d_in[i];
    a.out = (float*)d_out; a.ws = (unsigned char*)d_ws;
#if MK_ONE_LAUNCH
    a.ph_lo = 0; a.ph_hi = NPHASE;
    hipLaunchKernelGGL(fwd_kernel, dim3(grid), dim3(NWAVES * 64), LDS_BYTES, stream, a);
#else
    for (int p = 0; p < NPHASE; ++p) { a.ph_lo = p; a.ph_hi = p + 1; hipLaunchKernelGGL(fwd_kernel, dim3(grid), dim3(NWAVES * 64), LDS_BYTES, stream, a); }
#endif
}
```

```cpp
#include <hip/hip_runtime.h>
#include <cstdio>
#include <cstdint>

#ifndef MK_ONE_LAUNCH
#define MK_ONE_LAUNCH 1
#endif

constexpr int T = 16384, D = 1024, NIN = 3072;
constexpr int C_QDA = 0, C_KDA = 512, C_VDA = 1024, C_QR = 1536, C_KR = 1792, C_VR = 2048, C_GR = 2560;
constexpr int NE = 32, HIDN = 512, NSLOT = 2 * T, MAXTILES = NSLOT / 256 + NE, NPAD = MAXTILES * 256;
constexpr int NRT = 36;
constexpr float EPS = 1e-6f;
constexpr float LOG2E = 1.4426950408889634f;
constexpr float C2 = 0.125f * LOG2E;
constexpr float LAMBDA_INIT = 0.2f;
constexpr int NPHASE = 11;

constexpr size_t MiB = 1u << 20;
constexpr size_t WS_CTL = 0, CTL_ZERO_BYTES = 1 * MiB;
constexpr size_t WS_WRT = 1 * MiB;
constexpr size_t WS_WIN = 2 * MiB;
constexpr size_t WS_WOUT = 8 * MiB;
constexpr size_t WS_WGU = 10 * MiB;
constexpr size_t WS_WD = 74 * MiB;
constexpr size_t WS_A = 106 * MiB;
constexpr size_t WS_PROJ = 146 * MiB;
constexpr size_t WS_TOK = 242 * MiB;
constexpr size_t WS_END = 244 * MiB;
constexpr int CW_BAR = 4096;
constexpr int CW_CNT = 1024;
constexpr size_t TK_E = 0, TK_POS = 128 * 1024, TK_W = 256 * 1024, TK_STOK = 384 * 1024, TK_SW = 384 * 1024 + 160 * 1024;

constexpr int RING_BYTES = 131072;
constexpr int LDSCTL_OFF = RING_BYTES, MISC_OFF = LDSCTL_OFF + 320, TILEE_OFF = LDSCTL_OFF + 1024;
constexpr int LDS_BYTES = 147456;
constexpr int NWAVES = 8;

#define GAS __attribute__((address_space(1)))
#define LAS __attribute__((address_space(3)))
typedef unsigned short bf16;
typedef unsigned v4u __attribute__((ext_vector_type(4)));
typedef unsigned v2u __attribute__((ext_vector_type(2)));
typedef float f32x4 __attribute__((ext_vector_type(4)));
#define RLX_AGENT __ATOMIC_RELAXED, __HIP_MEMORY_SCOPE_AGENT
#define LDS_WAIT() asm volatile("s_waitcnt lgkmcnt(0)" ::: "memory")

__device__ __forceinline__ unsigned f2bf(float f) { unsigned u = __builtin_bit_cast(unsigned, f); return (u + 0x7fffu + ((u >> 16) & 1u)) >> 16; }
__device__ __forceinline__ unsigned pk2(float lo, float hi) { return f2bf(lo) | (f2bf(hi) << 16); }
__device__ __forceinline__ float bflo(unsigned w) { return __builtin_bit_cast(float, w << 16); }
__device__ __forceinline__ float bfhi(unsigned w) { return __builtin_bit_cast(float, w & 0xffff0000u); }
__device__ __forceinline__ float bf2f(bf16 b) { return __builtin_bit_cast(float, (unsigned)b << 16); }
__device__ __forceinline__ float wave_sum(float v) {
#pragma unroll
    for (int o = 1; o < 64; o <<= 1) v += __shfl_xor(v, o);
    return v;
}
__device__ __forceinline__ float silu_f(float v) { return v / (1.f + __expf(-v)); }

#define XB_TMO      128
#define XB_XCNT(j)  (256  + 64 * (j))
#define XB_XSUB(j)  (1280 + 64 * (j))
#define XB_XGEN(j)  (2304 + 64 * (j))
#define XB_TOP      3328
#define XB_TOPGEN   3392
#define XCD_BAR_WORDS 3456
#define XB_SPIN_CAP (1u << 18)
__device__ __forceinline__ unsigned xb_ld(unsigned* p)              { return __hip_atomic_load(p, __ATOMIC_RELAXED, __HIP_MEMORY_SCOPE_AGENT); }
__device__ __forceinline__ unsigned xb_add(unsigned* p, unsigned v) { return __hip_atomic_fetch_add(p, v, __ATOMIC_RELAXED, __HIP_MEMORY_SCOPE_AGENT); }
__device__ __forceinline__ unsigned xb_xcc_id() { return (unsigned)__builtin_amdgcn_s_getreg((3 << 11) | 20) & 0xFu; }
#define XB_SPIN(cond, bar) do { unsigned _sp = 0; while (cond) { __builtin_amdgcn_s_sleep(1); \
    if ((++_sp & 255u) == 0u) { if (xb_ld(&(bar)[XB_TMO])) break; if (_sp > XB_SPIN_CAP) { atomicAdd(&(bar)[XB_TMO], 1u); break; } } } } while (0)
struct XcdBarrier { unsigned* bar; unsigned x; volatile LAS unsigned* st; };
__device__ __forceinline__ XcdBarrier xcd_barrier_post(unsigned* bar, volatile LAS unsigned* st) {
    XcdBarrier b; b.bar = bar; b.x = xb_xcc_id(); b.st = st;
    if (threadIdx.x == 0) (void)xb_add(&bar[XB_XCNT(b.x)], 1u);
    return b;
}
__device__ __forceinline__ void xcd_barrier_complete(unsigned* bar, unsigned x, unsigned& nloc, unsigned& nx) {
    const unsigned G = gridDim.x * gridDim.y * gridDim.z;
    unsigned sum, cnt, mine, sp = 0u;
    for (;;) {
        sum = 0u; cnt = 0u; mine = 0u;
#pragma unroll
        for (unsigned j = 0; j < 16; ++j) { const unsigned c = xb_ld(&bar[XB_XCNT(j)]); sum += c; cnt += (c > 0u) ? 1u : 0u; mine = (j == x) ? c : mine; }
        if (sum == G) break;
        __builtin_amdgcn_s_sleep(1);
        if ((++sp & 255u) == 0u) { if (xb_ld(&bar[XB_TMO])) break; if (sp > XB_SPIN_CAP) { atomicAdd(&bar[XB_TMO], 1u); break; } }
    }
    nloc = mine > 0u ? mine : 1u; nx = cnt > 0u ? cnt : 1u;
}
__device__ __forceinline__ void xcd_barrier(const XcdBarrier& b) {
    asm volatile("s_waitcnt vmcnt(0)" ::: "memory");
    __syncthreads();
    if (threadIdx.x == 0) {
        unsigned* bar = b.bar;
        __builtin_amdgcn_s_waitcnt(0);
        unsigned nloc = b.st[0], nx = b.st[1];
        if (nloc == 0u) { xcd_barrier_complete(bar, b.x, nloc, nx); b.st[0] = nloc; b.st[1] = nx; }
        const unsigned old = xb_add(&bar[XB_XSUB(b.x)], 1u);
        const unsigned gen = old / nloc;
        if (old + 1u == (gen + 1u) * nloc) {
            __builtin_amdgcn_fence(__ATOMIC_RELEASE, "agent");
            asm volatile("s_waitcnt vmcnt(0)" ::: "memory");
            const unsigned og = xb_add(&bar[XB_TOP], 1u);
            const unsigned tg = og / nx;
            if (og + 1u == (tg + 1u) * nx) xb_add(&bar[XB_TOPGEN], 1u);
            else XB_SPIN(xb_ld(&bar[XB_TOPGEN]) == tg, bar);
            __builtin_amdgcn_fence(__ATOMIC_ACQUIRE, "agent");
            xb_add(&bar[XB_XGEN(b.x)], 1u);
            asm volatile("s_waitcnt vmcnt(0)" ::: "memory");
        } else {
            XB_SPIN(xb_ld(&bar[XB_XGEN(b.x)]) == gen, bar);
            __builtin_amdgcn_fence(__ATOMIC_ACQUIRE, "agent");
            asm volatile("s_waitcnt vmcnt(0)" ::: "memory");
        }
    }
    __syncthreads();
}

struct Frame {
    unsigned char* lds;
    unsigned* ctl;
    int tid, lane, wave, G, bid;
    const float *x, *g1, *w_in, *lq1, *lk1, *lq2, *lk2, *subg, *w_out, *g2, *wrg, *brg, *wre, *bre, *wg, *wu, *wd, *gf;
    float* out;
    unsigned char* ws;
};
struct Unit { int pm, pn, pb; };

struct DenseOrder {
    int nM, nN, G, c;
    __device__ __forceinline__ bool next(int i, Unit& u) const { const int L = i * G + c; if (L >= nM * nN) return false; u.pm = L / nN; u.pn = L % nN; u.pb = u.pn; return true; }
};
struct GroupedOrder {
    const int* tile_e; int ntiles, nN, G, c;
    __device__ __forceinline__ bool next(int i, Unit& u) const { const int L = i * G + c; if (L >= ntiles * nN) return false; u.pm = L / nN; u.pn = L % nN; u.pb = tile_e[u.pm] * nN + u.pn; return true; }
};

template <bool DUAL, class Sched, class Epi>
__device__ __forceinline__ void naive_gemm(Frame& F, const bf16* A, const bf16* Bt, int K, const Sched& S, const Epi& E) {
    float* As = (float*)F.lds; float* Bs = As + 32 * 68; float* Bs2 = Bs + 32 * 68;
    const int tid = F.tid, ty = tid >> 4, tx = tid & 15, lr = tid >> 3, lk = (tid & 7) * 4;
    Unit u;
    for (int i = 0; S.next(i, u); ++i) {
        for (int sm = 0; sm < 4; ++sm)
            for (int sn = 0; sn < (DUAL ? 2 : 4); ++sn) {
                float acc[2][4], acc2[2][4];
#pragma unroll
                for (int a = 0; a < 2; ++a)
#pragma unroll
                    for (int b = 0; b < 4; ++b) { acc[a][b] = 0.f; acc2[a][b] = 0.f; }
                const bf16* ap = A + (size_t)(256 * u.pm + 64 * sm + lr) * K + lk;
                const bf16* bp = Bt + (size_t)(256 * u.pb + 64 * sn + lr) * K + lk;
                for (int k0 = 0; k0 < K; k0 += 32) {
                    __syncthreads();
                    { const v2u w = *(const v2u*)(ap + k0); As[(lk + 0) * 68 + lr] = bflo(w.x); As[(lk + 1) * 68 + lr] = bfhi(w.x); As[(lk + 2) * 68 + lr] = bflo(w.y); As[(lk + 3) * 68 + lr] = bfhi(w.y); }
                    { const v2u w = *(const v2u*)(bp + k0); Bs[(lk + 0) * 68 + lr] = bflo(w.x); Bs[(lk + 1) * 68 + lr] = bfhi(w.x); Bs[(lk + 2) * 68 + lr] = bflo(w.y); Bs[(lk + 3) * 68 + lr] = bfhi(w.y); }
                    if (DUAL) { const v2u w = *(const v2u*)(bp + (size_t)128 * K + k0); Bs2[(lk + 0) * 68 + lr] = bflo(w.x); Bs2[(lk + 1) * 68 + lr] = bfhi(w.x); Bs2[(lk + 2) * 68 + lr] = bflo(w.y); Bs2[(lk + 3) * 68 + lr] = bfhi(w.y); }
                    __syncthreads();
#pragma unroll 8
                    for (int k = 0; k < 32; ++k) {
                        const float a0 = As[k * 68 + 2 * ty], a1 = As[k * 68 + 2 * ty + 1];
                        const f32x4 b = *(const f32x4*)(Bs + k * 68 + 4 * tx);
#pragma unroll
                        for (int j = 0; j < 4; ++j) { acc[0][j] += a0 * b[j]; acc[1][j] += a1 * b[j]; }
                        if (DUAL) { const f32x4 b2 = *(const f32x4*)(Bs2 + k * 68 + 4 * tx);
#pragma unroll
                            for (int j = 0; j < 4; ++j) { acc2[0][j] += a0 * b2[j]; acc2[1][j] += a1 * b2[j]; } }
                    }
                }
#pragma unroll
                for (int a = 0; a < 2; ++a)
#pragma unroll
                    for (int j = 0; j < 4; ++j) {
                        const int row = 256 * u.pm + 64 * sm + 2 * ty + a;
                        if (DUAL) E.elem(row, 128 * u.pn + 64 * sn + 4 * tx + j, silu_f(acc[a][j]) * acc2[a][j]);
                        else E.elem(row, 256 * u.pn + 64 * sn + 4 * tx + j, acc[a][j]);
                    }
            }
    }
    __syncthreads();
}
struct NEpiBf16 { bf16* O; int ldc; __device__ __forceinline__ void elem(int row, int col, float v) const { O[(size_t)row * ldc + col] = (bf16)f2bf(v); } };
struct NEpiResF32 { const float* base; float* O; int ldc; __device__ __forceinline__ void elem(int row, int col, float v) const { const size_t o = (size_t)row * ldc + col; O[o] = base[o] + v; } };
struct NEpiScatter { const int* stok; const float* sw; bf16* Y; __device__ __forceinline__ void elem(int row, int col, float v) const { const int tk = stok[row]; if (tk >= 0) Y[(size_t)tk * D + col] = (bf16)f2bf(v * sw[row]); } };

__device__ __forceinline__ void p0_transpose_item(const float* W, int K, int N, bf16* WT, int k0, int n0, int dstrow0, float scale, float* scr, int lane) {
#pragma unroll 8
    for (int i = 0; i < 32; ++i) { const int kk = 2 * i + (lane >> 5); scr[kk * 33 + (lane & 31)] = W[(size_t)(k0 + kk) * N + n0 + (lane & 31)] * scale; }
    LDS_WAIT(); asm volatile("" ::: "memory");
    const int c = lane & 7;
#pragma unroll
    for (int j = 0; j < 4; ++j) { const int n = (lane >> 3) + 8 * j; const float* s = scr + (8 * c) * 33 + n;
        v4u o; o.x = pk2(s[0 * 33], s[1 * 33]); o.y = pk2(s[2 * 33], s[3 * 33]); o.z = pk2(s[4 * 33], s[5 * 33]); o.w = pk2(s[6 * 33], s[7 * 33]);
        *(v4u*)(WT + (size_t)(dstrow0 + n) * K + k0 + 8 * c) = o; }
    LDS_WAIT(); asm volatile("" ::: "memory");
}
__device__ __forceinline__ void rms_row_to_bf16(const float* xrow, const float* g, bf16* orow, int lane) {
    const f32x4* xr = (const f32x4*)xrow + lane; const f32x4* gr = (const f32x4*)g + lane;
    f32x4 v[4]; float s = 0.f;
#pragma unroll
    for (int j = 0; j < 4; ++j) { v[j] = xr[64 * j]; s += (v[j].x * v[j].x + v[j].y * v[j].y) + (v[j].z * v[j].z + v[j].w * v[j].w); }
    const float rstd = 1.f / sqrtf(wave_sum(s) * (1.f / D) + EPS);
    unsigned long long* o8 = (unsigned long long*)orow + lane;
#pragma unroll
    for (int j = 0; j < 4; ++j) { const f32x4 gg = gr[64 * j];
        o8[64 * j] = (unsigned long long)pk2(v[j].x * rstd * gg.x, v[j].y * rstd * gg.y) | ((unsigned long long)pk2(v[j].z * rstd * gg.z, v[j].w * rstd * gg.w) << 32); }
}
__device__ __forceinline__ void p0_prologue(Frame& F) {
    float* scr = (float*)(F.lds + F.wave * 16384);
    const int gw = F.bid * NWAVES + F.wave, NGW = F.G * NWAVES;
    bf16* WinT = (bf16*)(F.ws + WS_WIN); bf16* WoutT = (bf16*)(F.ws + WS_WOUT); bf16* WguT = (bf16*)(F.ws + WS_WGU); bf16* WdT = (bf16*)(F.ws + WS_WD);
    constexpr int I_IN = 16 * 96, I_OUT = 16 * 32, I_E = 768, NITEMS = I_IN + I_OUT + NE * I_E;
    for (int it = gw; it < NITEMS; it += NGW) {
        int r = it;
        if (r < I_IN) { const int kb = r / 96, nb = r % 96, n0 = 32 * nb; const float sc = (n0 < C_KDA) ? C2 : ((n0 >= C_KR && n0 < C_VR) ? 0.125f : 1.f);
            p0_transpose_item(F.w_in, D, NIN, WinT, 64 * kb, n0, n0, sc, scr, F.lane); continue; }
        r -= I_IN;
        if (r < I_OUT) { const int kb = r / 32, nb = r % 32; p0_transpose_item(F.w_out, D, D, WoutT, 64 * kb, 32 * nb, 32 * nb, 1.f, scr, F.lane); continue; }
        r -= I_OUT;
        const int e = r / I_E; r %= I_E;
        if (r < 256) { const int kb = r / 16, nb = r % 16, n0 = 32 * nb; p0_transpose_item(F.wg + (size_t)e * D * HIDN, D, HIDN, WguT + (size_t)e * 1024 * D, 64 * kb, n0, 256 * (n0 >> 7) + (n0 & 127), 1.f, scr, F.lane); continue; }
        r -= 256;
        if (r < 256) { const int kb = r / 16, nb = r % 16, n0 = 32 * nb; p0_transpose_item(F.wu + (size_t)e * D * HIDN, D, HIDN, WguT + (size_t)e * 1024 * D, 64 * kb, n0, 256 * (n0 >> 7) + 128 + (n0 & 127), 1.f, scr, F.lane); continue; }
        r -= 256;
        { const int kb = r / 32, nb = r % 32; p0_transpose_item(F.wd + (size_t)e * HIDN * D, HIDN, D, WdT + (size_t)e * D * HIDN, 64 * kb, 32 * nb, 32 * nb, 1.f, scr, F.lane); }
    }
    float* WrT = (float*)(F.ws + WS_WRT);
    for (int i = F.bid * 512 + F.tid; i < NRT * D; i += F.G * 512) { const int c = i / D, k = i % D; WrT[i] = (c < 4) ? F.wrg[k * 4 + c] : F.wre[k * 32 + (c - 4)]; }
    bf16* XN1 = (bf16*)(F.ws + WS_A);
    for (int m = gw; m < T; m += NGW) rms_row_to_bf16(F.x + (size_t)m * D, F.g1, XN1 + (size_t)m * D, F.lane);
}

__device__ __forceinline__ float dot8(const v4u a, const v4u b) {
    return (bflo(a.x) * bflo(b.x) + bfhi(a.x) * bfhi(b.x)) + (bflo(a.y) * bflo(b.y) + bfhi(a.y) * bfhi(b.y)) + (bflo(a.z) * bflo(b.z) + bfhi(a.z) * bfhi(b.z)) + (bflo(a.w) * bflo(b.w) + bfhi(a.w) * bfhi(b.w));
}
__device__ __forceinline__ void naive_attn_unit(Frame& F, int h, int c, float lam, float slope2) {
    constexpr int QS = 136;
    bf16* Qs = (bf16*)F.lds; bf16* Ks = Qs + 64 * QS; float* Vs = (float*)(Ks + 64 * QS); float* Ps = Vs + 64 * 128;
    const bf16* PROJ = (const bf16*)(F.ws + WS_PROJ);
    const int tid = F.tid, q = tid >> 3, sub = tid & 7;
    const int qpos = 64 * c + q;
    __syncthreads();
    { const v4u* src = (const v4u*)(PROJ + (size_t)(64 * c + q) * NIN + C_QDA + h * 128 + sub * 16); v4u* dst = (v4u*)(Qs + q * QS + sub * 16); dst[0] = src[0]; dst[1] = src[1]; }
    float m0 = -1e30f, m1 = -1e30f, l0 = 0.f, l1 = 0.f, o0[16], o1[16];
#pragma unroll
    for (int i = 0; i < 16; ++i) { o0[i] = 0.f; o1[i] = 0.f; }
    for (int j = 0; j <= c; ++j) {
        __syncthreads();
        { const size_t row = (size_t)(64 * j + q) * NIN;
          const v4u* ks = (const v4u*)(PROJ + row + C_KDA + h * 128 + sub * 16); v4u* kd = (v4u*)(Ks + q * QS + sub * 16); kd[0] = ks[0]; kd[1] = ks[1];
          const v4u* vs = (const v4u*)(PROJ + row + C_VDA + h * 128 + sub * 16); const v4u a = vs[0], b = vs[1]; float* vd = Vs + q * 128 + sub * 16;
          vd[0] = bflo(a.x); vd[1] = bfhi(a.x); vd[2] = bflo(a.y); vd[3] = bfhi(a.y); vd[4] = bflo(a.z); vd[5] = bfhi(a.z); vd[6] = bflo(a.w); vd[7] = bfhi(a.w);
          vd[8] = bflo(b.x); vd[9] = bfhi(b.x); vd[10] = bflo(b.y); vd[11] = bfhi(b.y); vd[12] = bflo(b.z); vd[13] = bfhi(b.z); vd[14] = bflo(b.w); vd[15] = bfhi(b.w); }
        __syncthreads();
        float s0[8], s1[8];
#pragma unroll
        for (int kk = 0; kk < 8; ++kk) { s0[kk] = 0.f; s1[kk] = 0.f; }
#pragma unroll 1
        for (int d8 = 0; d8 < 8; ++d8) {
            const v4u qa = *(const v4u*)(Qs + q * QS + d8 * 8), qb = *(const v4u*)(Qs + q * QS + 64 + d8 * 8);
#pragma unroll
            for (int kk = 0; kk < 8; ++kk) { const int k = sub + 8 * kk;
                s0[kk] += dot8(qa, *(const v4u*)(Ks + k * QS + d8 * 8));
                if ((kk & 1) == 1) asm volatile("" ::: "memory"); }
#pragma unroll
            for (int kk = 0; kk < 8; ++kk) { const int k = sub + 8 * kk;
                s1[kk] += dot8(qb, *(const v4u*)(Ks + k * QS + 64 + d8 * 8));
                if ((kk & 1) == 1) asm volatile("" ::: "memory"); }
        }
#pragma unroll
        for (int kk = 0; kk < 8; ++kk) { const float dist = fabsf((float)(qpos - (64 * j + sub + 8 * kk))); s0[kk] -= slope2 * dist; s1[kk] -= slope2 * dist; }
        float t0 = s0[0], t1 = s1[0];
#pragma unroll
        for (int kk = 1; kk < 8; ++kk) { t0 = fmaxf(t0, s0[kk]); t1 = fmaxf(t1, s1[kk]); }
#pragma unroll
        for (int o = 1; o < 8; o <<= 1) { t0 = fmaxf(t0, __shfl_xor(t0, o)); t1 = fmaxf(t1, __shfl_xor(t1, o)); }
        const float mn0 = fmaxf(m0, t0), mn1 = fmaxf(m1, t1), al0 = exp2f(m0 - mn0), al1 = exp2f(m1 - mn1);
        m0 = mn0; m1 = mn1;
        float ps0 = 0.f, ps1 = 0.f;
#pragma unroll
        for (int kk = 0; kk < 8; ++kk) { const int k = sub + 8 * kk; const float p0 = exp2f(s0[kk] - mn0), p1 = exp2f(s1[kk] - mn1); ps0 += p0; ps1 += p1; Ps[q * 65 + k] = p0; Ps[64 * 65 + q * 65 + k] = p1; }
#pragma unroll
        for (int o = 1; o < 8; o <<= 1) { ps0 += __shfl_xor(ps0, o); ps1 += __shfl_xor(ps1, o); }
        l0 = l0 * al0 + ps0; l1 = l1 * al1 + ps1;
#pragma unroll
        for (int i = 0; i < 16; ++i) { o0[i] *= al0; o1[i] *= al1; }
        __syncthreads();
#pragma unroll 1
        for (int k = 0; k < 64; ++k) {
            const float p0 = Ps[q * 65 + k], p1 = Ps[64 * 65 + q * 65 + k];
            const float* vr = Vs + k * 128 + sub * 16;
#pragma unroll
            for (int i4 = 0; i4 < 4; ++i4) { const f32x4 v = *(const f32x4*)(vr + 4 * i4);
#pragma unroll
                for (int e = 0; e < 4; ++e) { o0[4 * i4 + e] += p0 * v[e]; o1[4 * i4 + e] += p1 * v[e]; } }
        }
    }
    const float r0 = 1.f / l0, r1 = lam / l1; float dv[16], ss = 0.f;
#pragma unroll
    for (int i = 0; i < 16; ++i) { dv[i] = o0[i] * r0 - o1[i] * r1; ss += dv[i] * dv[i]; }
#pragma unroll
    for (int o = 1; o < 8; o <<= 1) ss += __shfl_xor(ss, o);
    const float rstd = 1.f / sqrtf(ss * (1.f / 128.f) + EPS) * (1.f - LAMBDA_INIT);
    bf16* MIX = (bf16*)(F.ws + WS_A);
    unsigned w[8];
#pragma unroll
    for (int i = 0; i < 8; ++i) w[i] = pk2(dv[2 * i] * rstd * F.subg[sub * 16 + 2 * i], dv[2 * i + 1] * rstd * F.subg[sub * 16 + 2 * i + 1]);
    v4u* dst = (v4u*)(MIX + (size_t)qpos * D + h * 128 + sub * 16);
    dst[0] = (v4u){w[0], w[1], w[2], w[3]}; dst[1] = (v4u){w[4], w[5], w[6], w[7]};
}
__device__ __forceinline__ void p2_attention(Frame& F) {
    float a = 0.f, b = 0.f;
#pragma unroll 1
    for (int i = 0; i < 64; ++i) { a += F.lq1[i] * F.lk1[i]; b += F.lq2[i] * F.lk2[i]; }
    const float lam = __expf(a) - __expf(b) + LAMBDA_INIT;
    for (int u = F.bid; u < 512; u += F.G) {
        const int h = u >> 7, s = u & 127;
        const float slope2 = exp2f(-2.f * (float)(h + 1)) * LOG2E;
#pragma unroll 1
        for (int rep = 0; rep < 2; ++rep) naive_attn_unit(F, h, rep ? 255 - s : s, lam, slope2);
    }
}

__device__ __forceinline__ float ret_lg(int h) { return log1pf(-exp2f(-5.f - (float)h)); }
__device__ __forceinline__ void p3_ret_kv(Frame& F) {
    float* Ks = (float*)F.lds; float* Vs = Ks + 64 * 64;
    const bf16* PROJ = (const bf16*)(F.ws + WS_PROJ); float* KV = F.out;
    const int tid = F.tid, r = tid >> 3, sub = tid & 7;
    for (int u = F.bid; u < 1024; u += F.G) {
        const int n = u >> 2, h = u & 3; const float lg = ret_lg(h);
        __syncthreads();
        { const size_t row = (size_t)(64 * n + r) * NIN; const float w = __expf(lg * (float)(63 - r));
          const v4u a = *(const v4u*)(PROJ + row + C_KR + h * 64 + sub * 8); float* kd = Ks + r * 64 + sub * 8;
          kd[0] = bflo(a.x) * w; kd[1] = bfhi(a.x) * w; kd[2] = bflo(a.y) * w; kd[3] = bfhi(a.y) * w; kd[4] = bflo(a.z) * w; kd[5] = bfhi(a.z) * w; kd[6] = bflo(a.w) * w; kd[7] = bfhi(a.w) * w;
          const v4u* vs = (const v4u*)(PROJ + row + C_VR + h * 128 + sub * 16); const v4u b = vs[0], c = vs[1]; float* vd = Vs + r * 128 + sub * 16;
          vd[0] = bflo(b.x); vd[1] = bfhi(b.x); vd[2] = bflo(b.y); vd[3] = bfhi(b.y); vd[4] = bflo(b.z); vd[5] = bfhi(b.z); vd[6] = bflo(b.w); vd[7] = bfhi(b.w);
          vd[8] = bflo(c.x); vd[9] = bfhi(c.x); vd[10] = bflo(c.y); vd[11] = bfhi(c.y); vd[12] = bflo(c.z); vd[13] = bfhi(c.z); vd[14] = bflo(c.w); vd[15] = bfhi(c.w); }
        __syncthreads();
        float acc[16];
#pragma unroll
        for (int i = 0; i < 16; ++i) acc[i] = 0.f;
        const int d = r;
        for (int s = 0; s < 64; ++s) { const float kv = Ks[s * 64 + d]; const float* vr = Vs + s * 128 + sub * 16;
#pragma unroll
            for (int i = 0; i < 16; ++i) acc[i] += kv * vr[i]; }
        float* dst = KV + ((size_t)(n * 4 + h) * 64 + d) * 128 + sub * 16;
#pragma unroll
        for (int i = 0; i < 16; ++i) dst[i] = acc[i];
    }
}
__device__ __forceinline__ void p4_ret_scan(Frame& F) {
    const float* KV = F.out; float* SP = F.out + (size_t)8 * 1024 * 1024;
    const int gid = F.bid * 512 + F.tid;
    if (gid < 32768) {
        const int h = gid >> 13; const float dec = __expf(ret_lg(h) * 64.f);
        float st = 0.f;
        for (int n = 0; n < 256; ++n) { const size_t o = (size_t)n * 32768 + gid; SP[o] = st; st = st * dec + KV[o]; }
    }
}
__device__ __forceinline__ void p5_ret_out(Frame& F) {
    float* Qs = (float*)F.lds; float* Ks = Qs + 64 * 65; float* Vs = Ks + 64 * 65; float* Ss = Vs + 64 * 128; float* Ps = Ss + 64 * 128;
    const bf16* PROJ = (const bf16*)(F.ws + WS_PROJ); const float* SP = F.out + (size_t)8 * 1024 * 1024; bf16* MIX = (bf16*)(F.ws + WS_A);
    const int tid = F.tid, r = tid >> 3, sub = tid & 7;
    for (int u = F.bid; u < 1024; u += F.G) {
        const int n = u >> 2, h = u & 3; const float lg = ret_lg(h);
        __syncthreads();
        { const size_t row = (size_t)(64 * n + r) * NIN;
          const v4u a = *(const v4u*)(PROJ + row + C_QR + h * 64 + sub * 8); float* qd = Qs + r * 65 + sub * 8;
          qd[0] = bflo(a.x); qd[1] = bfhi(a.x); qd[2] = bflo(a.y); qd[3] = bfhi(a.y); qd[4] = bflo(a.z); qd[5] = bfhi(a.z); qd[6] = bflo(a.w); qd[7] = bfhi(a.w);
          const v4u k = *(const v4u*)(PROJ + row + C_KR + h * 64 + sub * 8); float* kd = Ks + r * 65 + sub * 8;
          kd[0] = bflo(k.x); kd[1] = bfhi(k.x); kd[2] = bflo(k.y); kd[3] = bfhi(k.y); kd[4] = bflo(k.z); kd[5] = bfhi(k.z); kd[6] = bflo(k.w); kd[7] = bfhi(k.w);
          const v4u* vs = (const v4u*)(PROJ + row + C_VR + h * 128 + sub * 16); const v4u b = vs[0], c = vs[1]; float* vd = Vs + r * 128 + sub * 16;
          vd[0] = bflo(b.x); vd[1] = bfhi(b.x); vd[2] = bflo(b.y); vd[3] = bfhi(b.y); vd[4] = bflo(b.z); vd[5] = bfhi(b.z); vd[6] = bflo(b.w); vd[7] = bfhi(b.w);
          vd[8] = bflo(c.x); vd[9] = bfhi(c.x); vd[10] = bflo(c.y); vd[11] = bfhi(c.y); vd[12] = bflo(c.z); vd[13] = bfhi(c.z); vd[14] = bflo(c.w); vd[15] = bfhi(c.w);
          const float* sp = SP + ((size_t)(n * 4 + h) * 64 + r) * 128 + sub * 16; float* sd = Ss + r * 128 + sub * 16;
#pragma unroll
          for (int i = 0; i < 16; ++i) sd[i] = sp[i]; }
        __syncthreads();
#pragma unroll 1
        for (int jj = 0; jj < 8; ++jj) { const int j = sub + 8 * jj; float s = 0.f;
#pragma unroll 8
            for (int d = 0; d < 64; ++d) s += Qs[r * 65 + d] * Ks[j * 65 + d];
            Ps[r * 65 + j] = (j <= r) ? s * __expf(lg * (float)(r - j)) : 0.f; }
        __syncthreads();
        float acc[16];
#pragma unroll
        for (int i = 0; i < 16; ++i) acc[i] = 0.f;
#pragma unroll 2
        for (int j = 0; j < 64; ++j) { const float p = Ps[r * 65 + j]; const float* vr = Vs + j * 128 + sub * 16;
#pragma unroll
            for (int i = 0; i < 16; ++i) acc[i] += p * vr[i]; }
        const float qd = __expf(lg * (float)(r + 1));
#pragma unroll 2
        for (int d = 0; d < 64; ++d) { const float qv = Qs[r * 65 + d] * qd; const float* sr = Ss + d * 128 + sub * 16;
#pragma unroll
            for (int i = 0; i < 16; ++i) acc[i] += qv * sr[i]; }
        float ss = 0.f;
#pragma unroll
        for (int i = 0; i < 16; ++i) ss += acc[i] * acc[i];
#pragma unroll
        for (int o = 1; o < 8; o <<= 1) ss += __shfl_xor(ss, o);
        const float rstd = 1.f / sqrtf(ss * (1.f / 128.f) + EPS);
        const size_t row = (size_t)(64 * n + r);
        const v4u* gs = (const v4u*)(PROJ + row * NIN + C_GR + h * 128 + sub * 16); const v4u ga = gs[0], gb = gs[1];
        const float gv[16] = {bflo(ga.x), bfhi(ga.x), bflo(ga.y), bfhi(ga.y), bflo(ga.z), bfhi(ga.z), bflo(ga.w), bfhi(ga.w), bflo(gb.x), bfhi(gb.x), bflo(gb.y), bfhi(gb.y), bflo(gb.z), bfhi(gb.z), bflo(gb.w), bfhi(gb.w)};
        unsigned w[8];
#pragma unroll
        for (int i = 0; i < 8; ++i) w[i] = pk2(silu_f(gv[2 * i]) * acc[2 * i] * rstd, silu_f(gv[2 * i + 1]) * acc[2 * i + 1] * rstd);
        v4u* dst = (v4u*)(MIX + row * D + 512 + h * 128 + sub * 16);
        dst[0] = (v4u){w[0], w[1], w[2], w[3]}; dst[1] = (v4u){w[4], w[5], w[6], w[7]};
    }
}

__device__ __forceinline__ void p7_route(Frame& F) {
    const float* H = F.out; bf16* XN2 = (bf16*)(F.ws + WS_A); const float* WrT = (const float*)(F.ws + WS_WRT);
    int* tok_e = (int*)(F.ws + WS_TOK + TK_E); int* tok_pos = (int*)(F.ws + WS_TOK + TK_POS); float* tok_w = (float*)(F.ws + WS_TOK + TK_W);
    const int gw = F.bid * NWAVES + F.wave, NGW = F.G * NWAVES, lane = F.lane;
    for (int t = gw; t < T; t += NGW) {
        const f32x4* xr = (const f32x4*)(H + (size_t)t * D) + lane; const f32x4* gr = (const f32x4*)F.g2 + lane;
        f32x4 v[4]; float s = 0.f;
#pragma unroll
        for (int j = 0; j < 4; ++j) { v[j] = xr[64 * j]; s += (v[j].x * v[j].x + v[j].y * v[j].y) + (v[j].z * v[j].z + v[j].w * v[j].w); }
        const float rstd = 1.f / sqrtf(wave_sum(s) * (1.f / D) + EPS);
        unsigned long long* o8 = (unsigned long long*)(XN2 + (size_t)t * D) + lane;
#pragma unroll
        for (int j = 0; j < 4; ++j) { const f32x4 gg = gr[64 * j]; v[j].x *= rstd * gg.x; v[j].y *= rstd * gg.y; v[j].z *= rstd * gg.z; v[j].w *= rstd * gg.w;
            o8[64 * j] = (unsigned long long)pk2(v[j].x, v[j].y) | ((unsigned long long)pk2(v[j].z, v[j].w) << 32); }
        float lg[4];
#pragma unroll
        for (int c = 0; c < 4; ++c) { const f32x4* wr = (const f32x4*)(WrT + (size_t)c * D) + lane; float p = 0.f;
#pragma unroll
            for (int j = 0; j < 4; ++j) { const f32x4 w = wr[64 * j]; p += (v[j].x * w.x + v[j].y * w.y) + (v[j].z * w.z + v[j].w * w.w); }
            lg[c] = wave_sum(p) + F.brg[c]; }
        int grp = 0; float gm = lg[0];
#pragma unroll
        for (int c = 1; c < 4; ++c) if (lg[c] > gm) { gm = lg[c]; grp = c; }
        float gs = 0.f;
#pragma unroll
        for (int c = 0; c < 4; ++c) gs += __expf(lg[c] - gm);
        const float gtop = 1.f / gs;
        float el[8];
#pragma unroll
        for (int i = 0; i < 8; ++i) { const f32x4* wr = (const f32x4*)(WrT + (size_t)(4 + grp * 8 + i) * D) + lane; float p = 0.f;
#pragma unroll
            for (int j = 0; j < 4; ++j) { const f32x4 w = wr[64 * j]; p += (v[j].x * w.x + v[j].y * w.y) + (v[j].z * w.z + v[j].w * w.w); }
            el[i] = wave_sum(p) + F.bre[grp * 8 + i]; }
        int i1 = 0; float v1 = el[0];
#pragma unroll
        for (int i = 1; i < 8; ++i) if (el[i] > v1) { v1 = el[i]; i1 = i; }
        int i2 = -1; float v2 = -3.0e38f;
#pragma unroll
        for (int i = 0; i < 8; ++i) if (i != i1 && el[i] > v2) { v2 = el[i]; i2 = i; }
        const float ex = __expf(v2 - v1), w1 = 1.f / (1.f + ex), w2 = ex / (1.f + ex);
        if (lane == 0) {
            const int e1 = grp * 8 + i1, e2 = grp * 8 + i2;
            const int p1 = (int)__hip_atomic_fetch_add(F.ctl + CW_CNT + 64 * e1, 1u, RLX_AGENT);
            const int p2 = (int)__hip_atomic_fetch_add(F.ctl + CW_CNT + 64 * e2, 1u, RLX_AGENT);
            tok_e[2 * t] = e1; tok_e[2 * t + 1] = e2; tok_pos[2 * t] = p1; tok_pos[2 * t + 1] = p2; tok_w[2 * t] = gtop * w1; tok_w[2 * t + 1] = gtop * w2;
        }
    }
}
__device__ __forceinline__ int build_tiles(Frame& F) {
    int* tile_e = (int*)(F.lds + TILEE_OFF); int* base = tile_e + 192; int* cnts = base + 32; int* nt = cnts + 32;
    __syncthreads();
    if (F.tid == 0) { int tiles = 0;
        for (int e = 0; e < NE; ++e) { const int c = (int)__hip_atomic_load(F.ctl + CW_CNT + 64 * e, RLX_AGENT); cnts[e] = c; base[e] = tiles * 256; const int n = (c + 255) >> 8; for (int i = 0; i < n; ++i) tile_e[tiles + i] = e; tiles += n; }
        nt[0] = tiles; }
    __syncthreads();
    return nt[0];
}
__device__ __forceinline__ void p8_permute(Frame& F) {
    (void)build_tiles(F);
    const int* base = (const int*)(F.lds + TILEE_OFF) + 192; const int* cnts = base + 32;
    const bf16* XN2 = (const bf16*)(F.ws + WS_A); bf16* XS = (bf16*)(F.ws + WS_PROJ);
    const int* tok_e = (const int*)(F.ws + WS_TOK + TK_E); const int* tok_pos = (const int*)(F.ws + WS_TOK + TK_POS); const float* tok_w = (const float*)(F.ws + WS_TOK + TK_W);
    int* stok = (int*)(F.ws + WS_TOK + TK_STOK); float* sw = (float*)(F.ws + WS_TOK + TK_SW);
    const int gw = F.bid * NWAVES + F.wave, NGW = F.G * NWAVES, lane = F.lane;
    for (int s = gw; s < NSLOT; s += NGW) {
        const int t = s >> 1, e = tok_e[s], dest = base[e] + tok_pos[s];
        const v4u* src = (const v4u*)(XN2 + (size_t)t * D) + lane; v4u* dst = (v4u*)(XS + (size_t)dest * D) + lane;
        dst[0] = src[0]; dst[64] = src[64];
        if (lane == 0) { stok[dest] = s; sw[dest] = tok_w[s]; }
    }
    for (int i = gw; i < NE * 256; i += NGW) { const int e = i >> 8, r = i & 255, c = cnts[e], padn = ((c + 255) & ~255) - c;
        if (r < padn) { const int dest = base[e] + c + r; v4u* dst = (v4u*)(XS + (size_t)dest * D) + lane; dst[0] = (v4u){0u, 0u, 0u, 0u}; dst[64] = (v4u){0u, 0u, 0u, 0u}; if (lane == 0) { stok[dest] = -1; sw[dest] = 0.f; } } }
}
__device__ __forceinline__ void p11_final(Frame& F) {
    const bf16* Y = (const bf16*)(F.ws + WS_WGU);
    const int gw = F.bid * NWAVES + F.wave, NGW = F.G * NWAVES, lane = F.lane;
    for (int t = gw; t < T; t += NGW) {
        f32x4* xr = (f32x4*)(F.out + (size_t)t * D) + lane; const f32x4* gr = (const f32x4*)F.gf + lane;
        const v2u* y0 = (const v2u*)(Y + (size_t)(2 * t) * D) + lane; const v2u* y1 = (const v2u*)(Y + (size_t)(2 * t + 1) * D) + lane;
        f32x4 v[4]; float s = 0.f;
#pragma unroll
        for (int j = 0; j < 4; ++j) { v[j] = xr[64 * j]; const v2u a = y0[64 * j], b = y1[64 * j];
            v[j].x += bflo(a.x) + bflo(b.x); v[j].y += bfhi(a.x) + bfhi(b.x); v[j].z += bflo(a.y) + bflo(b.y); v[j].w += bfhi(a.y) + bfhi(b.y);
            s += (v[j].x * v[j].x + v[j].y * v[j].y) + (v[j].z * v[j].z + v[j].w * v[j].w); }
        const float rstd = 1.f / sqrtf(wave_sum(s) * (1.f / D) + EPS);
#pragma unroll
        for (int j = 0; j < 4; ++j) { const f32x4 gg = gr[64 * j]; xr[64 * j] = (f32x4){v[j].x * rstd * gg.x, v[j].y * rstd * gg.y, v[j].z * rstd * gg.z, v[j].w * rstd * gg.w}; }
    }
}

struct Args { const float* in[18]; float* out; unsigned char* ws; int ph_lo, ph_hi; };
__global__ void __launch_bounds__(NWAVES * 64, 2) fwd_kernel(Args args) {
    extern __shared__ __attribute__((aligned(16))) unsigned char lds[];
    Frame F;
    F.lds = lds; F.tid = threadIdx.x; F.lane = F.tid & 63; F.wave = __builtin_amdgcn_readfirstlane(F.tid >> 6); F.G = gridDim.x; F.bid = blockIdx.x;
    F.ws = args.ws; F.ctl = (unsigned*)(args.ws + WS_CTL); F.out = args.out;
    F.x = args.in[0]; F.g1 = args.in[1]; F.w_in = args.in[2]; F.lq1 = args.in[3]; F.lk1 = args.in[4]; F.lq2 = args.in[5]; F.lk2 = args.in[6]; F.subg = args.in[7];
    F.w_out = args.in[8]; F.g2 = args.in[9]; F.wrg = args.in[10]; F.brg = args.in[11]; F.wre = args.in[12]; F.bre = args.in[13]; F.wg = args.in[14]; F.wu = args.in[15]; F.wd = args.in[16]; F.gf = args.in[17];
    volatile LAS unsigned* MISC = (volatile LAS unsigned*)((LAS unsigned char*)lds + MISC_OFF);
    for (int u = F.tid; u < (LDS_BYTES - LDSCTL_OFF) / 4; u += NWAVES * 64) ((LAS unsigned*)((LAS unsigned char*)lds + LDSCTL_OFF))[u] = 0u;
    __syncthreads();
    const int lo = args.ph_lo, hi = args.ph_hi;
    XcdBarrier bar; bar.bar = F.ctl + CW_BAR; bar.x = 0; bar.st = nullptr;
    if (hi - lo > 1) bar = xcd_barrier_post(F.ctl + CW_BAR, MISC + 8);
#ifndef PH_MASK
#define PH_MASK 0xFFFF
#endif
#define IN(k) (((PH_MASK >> (k)) & 1) && lo <= (k) && (k) < hi)
#define SEAM(k) do { if (IN(k) && IN((k) + 1)) xcd_barrier(bar); } while (0)
    if (IN(0)) { p0_prologue(F); } SEAM(0);
    if (IN(1)) { DenseOrder S{T / 256, NIN / 256, F.G, F.bid}; NEpiBf16 E{(bf16*)(F.ws + WS_PROJ), NIN};
        naive_gemm<false>(F, (const bf16*)(F.ws + WS_A), (const bf16*)(F.ws + WS_WIN), D, S, E); } SEAM(1);
    if (IN(2)) { p3_ret_kv(F); } SEAM(2);
    if (IN(3)) { p4_ret_scan(F); p2_attention(F); } SEAM(3);
    if (IN(4)) { p5_ret_out(F); } SEAM(4);
    if (IN(5)) { DenseOrder S{T / 256, D / 256, F.G, F.bid}; NEpiResF32 E{F.x, F.out, D};
        naive_gemm<false>(F, (const bf16*)(F.ws + WS_A), (const bf16*)(F.ws + WS_WOUT), D, S, E); } SEAM(5);
    if (IN(6)) { p7_route(F); } SEAM(6);
    if (IN(7)) { p8_permute(F); } SEAM(7);
    if (IN(8)) { const int nt = build_tiles(F); GroupedOrder S{(const int*)(F.lds + TILEE_OFF), nt, 4, F.G, F.bid}; NEpiBf16 E{(bf16*)(F.ws + WS_A), HIDN};
        naive_gemm<true>(F, (const bf16*)(F.ws + WS_PROJ), (const bf16*)(F.ws + WS_WGU), D, S, E); } SEAM(8);
    if (IN(9)) { const int nt = build_tiles(F); GroupedOrder S{(const int*)(F.lds + TILEE_OFF), nt, 4, F.G, F.bid};
        NEpiScatter E{(const int*)(F.ws + WS_TOK + TK_STOK), (const float*)(F.ws + WS_TOK + TK_SW), (bf16*)(F.ws + WS_WGU)};
        naive_gemm<false>(F, (const bf16*)(F.ws + WS_A), (const bf16*)(F.ws + WS_WD), HIDN, S, E); } SEAM(9);
    if (IN(10)) { p11_final(F); }
#undef IN
#undef SEAM
}

extern "C" void kernel_launch(void* const* d_in, const int* in_sizes, int n_in, void* d_out, int out_size, void* d_ws, size_t ws_size, hipStream_t stream) {
    static int grid = 0;
    if (grid == 0) {
        if (n_in != 18 || in_sizes[0] != T * D || out_size != T * D || ws_size < WS_END) { fprintf(stderr, "kernel_launch: shape mismatch n_in %d in0 %d out %d ws %zu\n", n_in, n_in > 0 ? in_sizes[0] : -1, out_size, ws_size); grid = -1; return; }
        int dev = 0, cus = 0, per_cu = 0;
        if (hipGetDevice(&dev) != hipSuccess || hipDeviceGetAttribute(&cus, hipDeviceAttributeMultiprocessorCount, dev) != hipSuccess) { grid = -1; return; }
        if (hipFuncSetAttribute((const void*)fwd_kernel, hipFuncAttributeMaxDynamicSharedMemorySize, LDS_BYTES) != hipSuccess) { fprintf(stderr, "kernel_launch: hipFuncSetAttribute failed\n"); grid = -1; return; }
        if (hipOccupancyMaxActiveBlocksPerMultiprocessor(&per_cu, (const void*)fwd_kernel, NWAVES * 64, LDS_BYTES) != hipSuccess || per_cu < 1) fprintf(stderr, "kernel_launch: occupancy query says %d\n", per_cu);
        (void)hipGetLastError();
        grid = cus;
    }
    if (grid < 0) return;
    (void)hipMemsetAsync((char*)d_ws + WS_CTL, 0, CTL_ZERO_BYTES, stream);
    Args a{};
    for (int i = 0; i < 18; ++i) a.in[i] = (const float*)d_in[i];
    a.out = (float*)d_out; a.ws = (unsigned char*)d_ws;
#if MK_ONE_LAUNCH
    a.ph_lo = 0; a.ph_hi = NPHASE;
    hipLaunchKernelGGL(fwd_kernel, dim3(grid), dim3(NWAVES * 64), LDS_BYTES, stream, a);
#else
    for (int p = 0; p < NPHASE; ++p) { a.ph_lo = p; a.ph_hi = p + 1; hipLaunchKernelGGL(fwd_kernel, dim3(grid), dim3(NWAVES * 64), LDS_BYTES, stream, a); }
#endif
}
```

```cpp
#include <hip/hip_runtime.h>
#include <cstdio>
#include <cstdint>

#ifndef USE_MFMA
#define USE_MFMA 0xF
#endif
#ifndef MK_ONE_LAUNCH
#define MK_ONE_LAUNCH 1
#endif

constexpr int T = 16384, D = 1024, NIN = 3072;
constexpr int C_QDA = 0, C_KDA = 512, C_VDA = 1024, C_QR = 1536, C_KR = 1792, C_VR = 2048, C_GR = 2560;
constexpr int NE = 32, HIDN = 512, NSLOT = 2 * T, MAXTILES = NSLOT / 256 + NE, NPAD = MAXTILES * 256;
constexpr int NRT = 36;
constexpr float EPS = 1e-6f;
constexpr float LOG2E = 1.4426950408889634f;
constexpr float C2 = 0.125f * LOG2E;
constexpr float LAMBDA_INIT = 0.2f;
constexpr int NPHASE = 11;

constexpr size_t MiB = 1u << 20;
constexpr size_t WS_CTL = 0, CTL_ZERO_BYTES = 1 * MiB;
constexpr size_t WS_WRT = 1 * MiB;
constexpr size_t WS_WIN = 2 * MiB;
constexpr size_t WS_WOUT = 8 * MiB;
constexpr size_t WS_WGU = 10 * MiB;
constexpr size_t WS_WD = 74 * MiB;
constexpr size_t WS_A = 106 * MiB;
constexpr size_t WS_PROJ = 146 * MiB;
constexpr size_t WS_TOK = 242 * MiB;
constexpr size_t WS_END = 244 * MiB;
constexpr int CW_BAR = 4096;
constexpr int CW_CNT = 1024;
constexpr size_t TK_E = 0, TK_POS = 128 * 1024, TK_W = 256 * 1024, TK_STOK = 384 * 1024, TK_SW = 384 * 1024 + 160 * 1024;

constexpr int RING_BYTES = 131072;
constexpr int LDSCTL_OFF = RING_BYTES, MISC_OFF = LDSCTL_OFF + 320, TILEE_OFF = LDSCTL_OFF + 1024;
constexpr int LDS_BYTES = 147456;
constexpr int NWAVES = 8;

#define GAS __attribute__((address_space(1)))
#define LAS __attribute__((address_space(3)))
typedef unsigned short bf16;
typedef unsigned v4u __attribute__((ext_vector_type(4)));
typedef unsigned v2u __attribute__((ext_vector_type(2)));
typedef float f32x4 __attribute__((ext_vector_type(4)));
#define RLX_AGENT __ATOMIC_RELAXED, __HIP_MEMORY_SCOPE_AGENT
#define LDS_WAIT() asm volatile("s_waitcnt lgkmcnt(0)" ::: "memory")

__device__ __forceinline__ unsigned f2bf(float f) { unsigned u = __builtin_bit_cast(unsigned, f); return (u + 0x7fffu + ((u >> 16) & 1u)) >> 16; }
__device__ __forceinline__ unsigned pk2(float lo, float hi) { return f2bf(lo) | (f2bf(hi) << 16); }
__device__ __forceinline__ float bflo(unsigned w) { return __builtin_bit_cast(float, w << 16); }
__device__ __forceinline__ float bfhi(unsigned w) { return __builtin_bit_cast(float, w & 0xffff0000u); }
__device__ __forceinline__ float bf2f(bf16 b) { return __builtin_bit_cast(float, (unsigned)b << 16); }
__device__ __forceinline__ float wave_sum(float v) {
#pragma unroll
    for (int o = 1; o < 64; o <<= 1) v += __shfl_xor(v, o);
    return v;
}
__device__ __forceinline__ float silu_f(float v) { return v / (1.f + __expf(-v)); }

#define XB_TMO      128
#define XB_XCNT(j)  (256  + 64 * (j))
#define XB_XSUB(j)  (1280 + 64 * (j))
#define XB_XGEN(j)  (2304 + 64 * (j))
#define XB_TOP      3328
#define XB_TOPGEN   3392
#define XCD_BAR_WORDS 3456
#define XB_SPIN_CAP (1u << 18)
__device__ __forceinline__ unsigned xb_ld(unsigned* p)              { return __hip_atomic_load(p, __ATOMIC_RELAXED, __HIP_MEMORY_SCOPE_AGENT); }
__device__ __forceinline__ unsigned xb_add(unsigned* p, unsigned v) { return __hip_atomic_fetch_add(p, v, __ATOMIC_RELAXED, __HIP_MEMORY_SCOPE_AGENT); }
__device__ __forceinline__ unsigned xb_xcc_id() { return (unsigned)__builtin_amdgcn_s_getreg((3 << 11) | 20) & 0xFu; }
#define XB_SPIN(cond, bar) do { unsigned _sp = 0; while (cond) { __builtin_amdgcn_s_sleep(1); \
    if ((++_sp & 255u) == 0u) { if (xb_ld(&(bar)[XB_TMO])) break; if (_sp > XB_SPIN_CAP) { atomicAdd(&(bar)[XB_TMO], 1u); break; } } } } while (0)
struct XcdBarrier { unsigned* bar; unsigned x; volatile LAS unsigned* st; };
__device__ __forceinline__ XcdBarrier xcd_barrier_post(unsigned* bar, volatile LAS unsigned* st) {
    XcdBarrier b; b.bar = bar; b.x = xb_xcc_id(); b.st = st;
    if (threadIdx.x == 0) (void)xb_add(&bar[XB_XCNT(b.x)], 1u);
    return b;
}
__device__ __forceinline__ void xcd_barrier_complete(unsigned* bar, unsigned x, unsigned& nloc, unsigned& nx) {
    const unsigned G = gridDim.x * gridDim.y * gridDim.z;
    unsigned sum, cnt, mine, sp = 0u;
    for (;;) {
        sum = 0u; cnt = 0u; mine = 0u;
#pragma unroll
        for (unsigned j = 0; j < 16; ++j) { const unsigned c = xb_ld(&bar[XB_XCNT(j)]); sum += c; cnt += (c > 0u) ? 1u : 0u; mine = (j == x) ? c : mine; }
        if (sum == G) break;
        __builtin_amdgcn_s_sleep(1);
        if ((++sp & 255u) == 0u) { if (xb_ld(&bar[XB_TMO])) break; if (sp > XB_SPIN_CAP) { atomicAdd(&bar[XB_TMO], 1u); break; } }
    }
    nloc = mine > 0u ? mine : 1u; nx = cnt > 0u ? cnt : 1u;
}
__device__ __forceinline__ void xcd_barrier(const XcdBarrier& b) {
    asm volatile("s_waitcnt vmcnt(0)" ::: "memory");
    __syncthreads();
    if (threadIdx.x == 0) {
        unsigned* bar = b.bar;
        __builtin_amdgcn_s_waitcnt(0);
        unsigned nloc = b.st[0], nx = b.st[1];
        if (nloc == 0u) { xcd_barrier_complete(bar, b.x, nloc, nx); b.st[0] = nloc; b.st[1] = nx; }
        const unsigned old = xb_add(&bar[XB_XSUB(b.x)], 1u);
        const unsigned gen = old / nloc;
        if (old + 1u == (gen + 1u) * nloc) {
            __builtin_amdgcn_fence(__ATOMIC_RELEASE, "agent");
            asm volatile("s_waitcnt vmcnt(0)" ::: "memory");
            const unsigned og = xb_add(&bar[XB_TOP], 1u);
            const unsigned tg = og / nx;
            if (og + 1u == (tg + 1u) * nx) xb_add(&bar[XB_TOPGEN], 1u);
            else XB_SPIN(xb_ld(&bar[XB_TOPGEN]) == tg, bar);
            __builtin_amdgcn_fence(__ATOMIC_ACQUIRE, "agent");
            xb_add(&bar[XB_XGEN(b.x)], 1u);
            asm volatile("s_waitcnt vmcnt(0)" ::: "memory");
        } else {
            XB_SPIN(xb_ld(&bar[XB_XGEN(b.x)]) == gen, bar);
            __builtin_amdgcn_fence(__ATOMIC_ACQUIRE, "agent");
            asm volatile("s_waitcnt vmcnt(0)" ::: "memory");
        }
    }
    __syncthreads();
}

namespace pg8 {
#define PG8_LAS __attribute__((address_space(3)))
typedef unsigned short bf16_t;
typedef short bf16x8 __attribute__((ext_vector_type(8)));
typedef float f32x4 __attribute__((ext_vector_type(4)));
typedef unsigned u32x4 __attribute__((ext_vector_type(4)));
constexpr int BM = 256, BK = 64, HALF = 128, HTB = HALF * BK * 2  , STAGE_BYTES = 8 * HTB, NXCD = 8, WGM = 8;

__host__ __device__ __forceinline__ int lds_byte(int r, int c) { const int st = (r >> 4) * 2 + (c >> 5), rr = r & 15, cc = c & 31, ob = rr * 64 + cc * 2; return st * 1024 + (ob ^ (((ob >> 9) & 1) << 5)); }
__host__ __device__ __forceinline__ void stage_rc(int b, int& R, int& C) { const int st = b / 1024, sb = b % 1024, swz = sb ^ (((sb >> 9) & 1) << 5); R = (st >> 1) * 16 + swz / 64; C = (st & 1) * 32 + (swz % 64) / 2; }
__host__ __device__ __forceinline__ int perm32(int rho) { const int n = rho >> 4, i = rho & 15; return 8 * (i >> 2) + 4 * n + (i & 3); }

struct Unit { int pm, pn, pb; };
struct Gemm { const bf16_t* A; const bf16_t* Bt; int M, N, K; };
__device__ __forceinline__ unsigned cvt_pk_bf16(float lo, float hi) { unsigned r; asm volatile("v_cvt_pk_bf16_f32 %0, %1, %2" : "=v"(r) : "v"(lo), "v"(hi)); return r; }
template <class Epi, class Sched, bool ALIGN_EPI = false, bool SP2 = false>
__device__ __forceinline__ void gemm_phase(PG8_LAS unsigned char* lds, const Gemm g, const Sched& S, const Epi& E) {
    const int tid = threadIdx.x, wid = __builtin_amdgcn_readfirstlane(tid >> 6), lane = tid & 63, wr = wid >> 2, wc = wid & 3, fr = lane & 15, fq = lane >> 4;
    const int K = g.K, nt = K / BK;
    unsigned voffA[2], voffB[2];
#pragma unroll
    for (int i = 0; i < 2; ++i) { int R, C; stage_rc(tid * 16 + i * 8192, R, C); const int Rb = Epi::PERM ? ((R & ~31) + perm32(R & 31)) : R;
        voffA[i] = (unsigned)(R * K + C) * 2u; voffB[i] = (unsigned)(Rb * K + C) * 2u; }
    const size_t kstep = (size_t)(BK * 2);
    const size_t hstep = (size_t)HALF * K * 2;
    const size_t tstep = 2 * hstep;
    const unsigned ldsw = (unsigned)wid * 1024u;
    const int aoff = lds_byte(wr * 64 + fr, fq * 8), boff = lds_byte(wc * 32 + fr, fq * 8);
#define PG8_SA(b, h) (((b) * 2 + (h)) * HTB)
#define PG8_SB(b, h) ((4 + (b) * 2 + (h)) * HTB)
#define PG8_STAGE(bufoff, gbase, voff) do { _Pragma("unroll") for (int _i = 0; _i < 2; ++_i) \
        __builtin_amdgcn_global_load_lds((const unsigned*)((const char*)(gbase) + (voff)[_i]), (PG8_LAS unsigned*)(lds + (bufoff) + ldsw + _i * 8192), 16, 0, 0); } while (0)
#define PG8_LDA(dst, b, h) do { _Pragma("unroll") for (int m = 0; m < 4; ++m) _Pragma("unroll") for (int k = 0; k < 2; ++k) dst[m][k] = *(const PG8_LAS bf16x8*)(lds + PG8_SA(b, h) + aoff + m * 2048 + k * 1024); } while (0)
#define PG8_LDB(dst, b, h) do { _Pragma("unroll") for (int n = 0; n < 2; ++n) _Pragma("unroll") for (int k = 0; k < 2; ++k) dst[n][k] = *(const PG8_LAS bf16x8*)(lds + PG8_SB(b, h) + boff + n * 2048 + k * 1024); } while (0)
#define PG8_MMA(ai, bj, At, Bt) do { __builtin_amdgcn_s_setprio(1); _Pragma("unroll") for (int m = 0; m < 4; ++m) _Pragma("unroll") for (int n = 0; n < 2; ++n) _Pragma("unroll") for (int k = 0; k < 2; ++k) \
        acc[ai][bj][m][n] = __builtin_amdgcn_mfma_f32_16x16x32_bf16(Bt[n][k], At[m][k], acc[ai][bj][m][n], 0, 0, 0); __builtin_amdgcn_s_setprio(0); } while (0)
#define PG8_WAIT_V(n) asm volatile("s_waitcnt vmcnt(" #n ")" ::: "memory")
#define PG8_WAIT_L(n) asm volatile("s_waitcnt lgkmcnt(" #n ")" ::: "memory")
#define PG8_BAR __builtin_amdgcn_s_barrier()
#define PG8_SCHED __builtin_amdgcn_sched_barrier(0)
    Unit cur, nxt; int ui = 0;
    if (!S.next(0, cur)) return;
    f32x4 acc[2][2][4][2];
#pragma unroll
    for (int a = 0; a < 2; ++a)
#pragma unroll
        for (int b = 0; b < 2; ++b)
#pragma unroll
            for (int m = 0; m < 4; ++m)
#pragma unroll
                for (int n = 0; n < 2; ++n) acc[a][b][m][n] = (f32x4){0.f, 0.f, 0.f, 0.f};
    bf16x8 At[4][2], B0[2][2], B1[2][2];
    const char* cA = (const char*)g.A + (size_t)cur.pm * tstep; const char* cB = (const char*)g.Bt + (size_t)cur.pb * tstep;
    S.a_ready(cur);
    if constexpr (SP2) {
        PG8_STAGE(PG8_SB(0, 0), cB, voffB); PG8_STAGE(PG8_SB(0, 1), cB + hstep, voffB); PG8_STAGE(PG8_SA(0, 0), cA, voffA); PG8_STAGE(PG8_SA(0, 1), cA + hstep, voffA);
        if (wr == 1) PG8_BAR;
        PG8_WAIT_V(2); PG8_BAR;
        PG8_STAGE(PG8_SB(1, 0), cB + kstep, voffB); PG8_STAGE(PG8_SA(1, 0), cA + kstep, voffA); PG8_STAGE(PG8_SB(1, 1), cB + hstep + kstep, voffB);
        PG8_WAIT_V(6); PG8_BAR;
    } else {
        PG8_STAGE(PG8_SB(0, 0), cB, voffB); PG8_STAGE(PG8_SA(0, 0), cA, voffA); PG8_STAGE(PG8_SB(0, 1), cB + hstep, voffB); PG8_STAGE(PG8_SA(0, 1), cA + hstep, voffA);
        if (wr == 1) PG8_BAR;
        PG8_WAIT_V(4); PG8_BAR;
        PG8_STAGE(PG8_SB(1, 0), cB + kstep, voffB); PG8_STAGE(PG8_SA(1, 0), cA + kstep, voffA); PG8_STAGE(PG8_SB(1, 1), cB + hstep + kstep, voffB);
        PG8_WAIT_V(6); PG8_BAR;
    }
    for (;;) {
        const bool has_next = S.next(ui + 1, nxt);
        const char* nA = has_next ? (const char*)g.A + (size_t)nxt.pm * tstep : cA; const char* nB = has_next ? (const char*)g.Bt + (size_t)nxt.pb * tstep : cB;
        for (int t = 0; t < nt; t += 2) {
            const bool last = (t == nt - 2);
            const char* a1 = cA + (size_t)(t + 1) * kstep;
            const char* a2 = last ? nA : cA + (size_t)(t + 2) * kstep; const char* b2 = last ? nB : cB + (size_t)(t + 2) * kstep;
            const char* a3 = a2 + kstep; const char* b3 = b2 + kstep;
            if (last && has_next) S.a_ready(nxt);
            if constexpr (SP2) {
            PG8_LDB(B0, 0, 0); PG8_LDB(B1, 0, 1); PG8_SCHED; PG8_LDA(At, 0, 0); PG8_STAGE(PG8_SA(1, 1), a1 + hstep, voffA);
            PG8_WAIT_V(8); PG8_WAIT_L(0); PG8_BAR; PG8_MMA(0, 0, At, B0); PG8_MMA(0, 1, At, B1); PG8_BAR; PG8_SCHED;
            PG8_LDA(At, 0, 1); PG8_STAGE(PG8_SB(0, 0), b2, voffB); PG8_STAGE(PG8_SB(0, 1), b2 + hstep, voffB); PG8_STAGE(PG8_SA(0, 0), a2, voffA);
            PG8_WAIT_V(8); PG8_WAIT_L(0); PG8_BAR; PG8_MMA(1, 0, At, B0); PG8_MMA(1, 1, At, B1); PG8_BAR; PG8_SCHED;
            PG8_LDB(B0, 1, 0); PG8_LDB(B1, 1, 1); PG8_SCHED; PG8_LDA(At, 1, 0); PG8_STAGE(PG8_SA(0, 1), a2 + hstep, voffA);
            PG8_WAIT_V(8); PG8_WAIT_L(0); PG8_BAR; PG8_MMA(0, 0, At, B0); PG8_MMA(0, 1, At, B1); PG8_BAR; PG8_SCHED;
            PG8_LDA(At, 1, 1); PG8_STAGE(PG8_SB(1, 0), b3, voffB); PG8_STAGE(PG8_SB(1, 1), b3 + hstep, voffB); PG8_STAGE(PG8_SA(1, 0), a3, voffA);
            PG8_WAIT_V(8); PG8_WAIT_L(0); PG8_BAR; PG8_MMA(1, 0, At, B0); PG8_MMA(1, 1, At, B1); PG8_BAR; PG8_SCHED;
            } else {
            PG8_LDB(B0, 0, 0); PG8_SCHED; PG8_LDA(At, 0, 0); PG8_STAGE(PG8_SA(1, 1), a1 + hstep, voffA);
            PG8_WAIT_L(8); PG8_BAR; PG8_WAIT_L(0); PG8_MMA(0, 0, At, B0); PG8_BAR; PG8_SCHED;
            PG8_LDB(B1, 0, 1); PG8_STAGE(PG8_SB(0, 0), b2, voffB);
            PG8_BAR; PG8_WAIT_L(0); PG8_MMA(0, 1, At, B1); PG8_BAR;
            PG8_LDA(At, 0, 1); PG8_STAGE(PG8_SA(0, 0), a2, voffA);
            PG8_BAR; PG8_WAIT_L(0); PG8_MMA(1, 0, At, B0); PG8_BAR; PG8_SCHED;
            PG8_STAGE(PG8_SB(0, 1), b2 + hstep, voffB);
            PG8_WAIT_V(6); PG8_BAR; PG8_MMA(1, 1, At, B1); PG8_BAR;
            PG8_LDB(B0, 1, 0); PG8_SCHED; PG8_LDA(At, 1, 0); PG8_STAGE(PG8_SA(0, 1), a2 + hstep, voffA);
            PG8_WAIT_L(8); PG8_BAR; PG8_WAIT_L(0); PG8_MMA(0, 0, At, B0); PG8_BAR; PG8_SCHED;
            PG8_LDB(B1, 1, 1); PG8_STAGE(PG8_SB(1, 0), b3, voffB);
            PG8_BAR; PG8_WAIT_L(0); PG8_MMA(0, 1, At, B1); PG8_BAR;
            PG8_LDA(At, 1, 1); PG8_STAGE(PG8_SA(1, 0), a3, voffA);
            PG8_BAR; PG8_WAIT_L(0); PG8_MMA(1, 0, At, B0); PG8_BAR; PG8_SCHED;
            PG8_STAGE(PG8_SB(1, 1), b3 + hstep, voffB);
            PG8_WAIT_V(6); PG8_BAR; PG8_MMA(1, 1, At, B1); PG8_BAR;
            }
        }
        if constexpr (ALIGN_EPI) { if (wr == 0) PG8_BAR; }
        if constexpr (!Epi::AFTER_DRAIN) { E(acc, cur, wr, wc, fr, fq); S.done(cur); }
        if (!has_next) break;
#pragma unroll
        for (int a = 0; a < 2; ++a)
#pragma unroll
            for (int b = 0; b < 2; ++b)
#pragma unroll
                for (int m = 0; m < 4; ++m)
#pragma unroll
                    for (int n = 0; n < 2; ++n) acc[a][b][m][n] = (f32x4){0.f, 0.f, 0.f, 0.f};
        cur = nxt; cA = nA; cB = nB; ++ui;
        if constexpr (ALIGN_EPI) { if (wr == 1) PG8_BAR; }
    }
    PG8_WAIT_V(0);
    if constexpr (!ALIGN_EPI) { if (wr == 0) PG8_BAR; }
    PG8_BAR;
    if constexpr (Epi::AFTER_DRAIN) { E.fused(acc, cur, wr, wc, fr, fq, lds, wid, lane); S.done(cur); }
#undef PG8_SA
#undef PG8_SB
#undef PG8_STAGE
#undef PG8_LDA
#undef PG8_LDB
#undef PG8_MMA
#undef PG8_WAIT_V
#undef PG8_WAIT_L
#undef PG8_BAR
#undef PG8_SCHED
}

struct EpiBf16Plain {
    static constexpr bool PERM = true, AFTER_DRAIN = false;
    bf16_t* O; int ldc;
    __device__ __forceinline__ void operator()(const f32x4 (&acc)[2][2][4][2], const Unit& u, int wr, int wc, int fr, int fq) const {
        const int row0 = u.pm * BM + wr * 64 + fr, col0 = u.pn * BM + wc * 32 + 8 * fq;
#pragma unroll
        for (int ai = 0; ai < 2; ++ai)
#pragma unroll
            for (int m = 0; m < 4; ++m) { bf16_t* rowp = O + (size_t)(row0 + ai * HALF + m * 16) * ldc + col0;
#pragma unroll
                for (int bj = 0; bj < 2; ++bj) { const f32x4 v0 = acc[ai][bj][m][0], v1 = acc[ai][bj][m][1];
                    u32x4 w; w.x = cvt_pk_bf16(v0[0], v0[1]); w.y = cvt_pk_bf16(v0[2], v0[3]); w.z = cvt_pk_bf16(v1[0], v1[1]); w.w = cvt_pk_bf16(v1[2], v1[3]);
                    *(u32x4*)(rowp + bj * HALF) = w; } }
    }
};
struct EpiResF32 {
    static constexpr bool PERM = false, AFTER_DRAIN = false;
    const float* base; float* C; int ldc;
    __device__ __forceinline__ void operator()(const f32x4 (&acc)[2][2][4][2], const Unit& u, int wr, int wc, int fr, int fq) const {
        const int row0 = u.pm * BM + wr * 64 + fr, col0 = u.pn * BM + wc * 32 + 4 * fq;
#pragma unroll
        for (int ai = 0; ai < 2; ++ai)
#pragma unroll
            for (int m = 0; m < 4; ++m) { const size_t off = (size_t)(row0 + ai * HALF + m * 16) * ldc + col0;
                f32x4 b[2][2];
#pragma unroll
                for (int bj = 0; bj < 2; ++bj)
#pragma unroll
                    for (int n = 0; n < 2; ++n) b[bj][n] = *(const f32x4*)(base + off + bj * HALF + n * 16);
#pragma unroll
                for (int bj = 0; bj < 2; ++bj)
#pragma unroll
                    for (int n = 0; n < 2; ++n) *(f32x4*)(C + off + bj * HALF + n * 16) = b[bj][n] + acc[ai][bj][m][n];
                if (m & 1) asm volatile("" ::: "memory"); }
    }
};
__device__ __forceinline__ float silu_mul(float g, float u) { return g * u * __builtin_amdgcn_rcpf(1.f + __expf(-g)); }
struct EpiSwiglu {
    static constexpr bool PERM = true, AFTER_DRAIN = false;
    bf16_t* H; int ldh;
    __device__ __forceinline__ void operator()(const f32x4 (&acc)[2][2][4][2], const Unit& u, int wr, int wc, int fr, int fq) const {
        const int row0 = u.pm * BM + wr * 64 + fr, col0 = u.pn * HALF + wc * 32 + 8 * fq;
#pragma unroll
        for (int ai = 0; ai < 2; ++ai)
#pragma unroll
            for (int m = 0; m < 4; ++m) { const f32x4 g0 = acc[ai][0][m][0], g1 = acc[ai][0][m][1], u0 = acc[ai][1][m][0], u1 = acc[ai][1][m][1];
                u32x4 w; w.x = cvt_pk_bf16(silu_mul(g0[0], u0[0]), silu_mul(g0[1], u0[1])); w.y = cvt_pk_bf16(silu_mul(g0[2], u0[2]), silu_mul(g0[3], u0[3]));
                w.z = cvt_pk_bf16(silu_mul(g1[0], u1[0]), silu_mul(g1[1], u1[1])); w.w = cvt_pk_bf16(silu_mul(g1[2], u1[2]), silu_mul(g1[3], u1[3]));
                *(u32x4*)(H + (size_t)(row0 + ai * HALF + m * 16) * ldh + col0) = w; }
    }
};
struct EpiScatter {
    static constexpr bool PERM = true, AFTER_DRAIN = false;
    const int* stok; const float* sw; bf16_t* Y; int ldy;
    __device__ __forceinline__ void operator()(const f32x4 (&acc)[2][2][4][2], const Unit& u, int wr, int wc, int fr, int fq) const {
        const int row0 = u.pm * BM + wr * 64 + fr, col0 = u.pn * BM + wc * 32 + 8 * fq;
#pragma unroll
        for (int ai = 0; ai < 2; ++ai)
#pragma unroll
            for (int m = 0; m < 4; ++m) { const int row = row0 + ai * HALF + m * 16; const int tk = stok[row]; const float s = sw[row];
                if (tk >= 0) { bf16_t* rowp = Y + (size_t)tk * ldy + col0;
#pragma unroll
                    for (int bj = 0; bj < 2; ++bj) { const f32x4 v0 = acc[ai][bj][m][0] * s, v1 = acc[ai][bj][m][1] * s;
                        u32x4 w; w.x = cvt_pk_bf16(v0[0], v0[1]); w.y = cvt_pk_bf16(v0[2], v0[3]); w.z = cvt_pk_bf16(v1[0], v1[1]); w.w = cvt_pk_bf16(v1[2], v1[3]);
                        *(u32x4*)(rowp + bj * HALF) = w; } } }
    }
};
struct StaticOrder {
    int nM, nN, nwg, G, c;
    __device__ void init(int M, int N, int G_, int c_) { nM = M / BM; nN = N / BM; nwg = nM * nN; G = G_; c = c_; }
    __device__ bool next(int i, Unit& u) const {
        const long L = (long)i * G + c; if (L >= nwg) return false;
        int wgid = (int)L; { const int q = nwg / NXCD, r = nwg % NXCD, xcd = wgid % NXCD, off = wgid / NXCD; wgid = (xcd < r ? xcd * (q + 1) : r * (q + 1) + (xcd - r) * q) + off; }
        const int nig = WGM * nN, gid = wgid / nig, fm = gid * WGM, gsz = (nM - fm) < WGM ? (nM - fm) : WGM;
        u.pm = fm + ((wgid % nig) % gsz); u.pn = (wgid % nig) / gsz; u.pb = u.pn; return true;
    }
    __device__ __forceinline__ void a_ready(const Unit&) const {}
    __device__ __forceinline__ void done(const Unit&) const {}
};
struct GroupedOrder {
    const PG8_LAS int* tile_e; int ntiles, nN, G, c;
    __device__ __forceinline__ bool next(int i, Unit& u) const { const int L = i * G + c; if (L >= ntiles * nN) return false; u.pm = L / nN; u.pn = L % nN; u.pb = tile_e[u.pm] * nN + u.pn; return true; }
    __device__ __forceinline__ void a_ready(const Unit&) const {}
    __device__ __forceinline__ void done(const Unit&) const {}
};
}

struct Frame {
    unsigned char* lds;
    unsigned* ctl;
    int tid, lane, wave, G, bid;
    const float *x, *g1, *w_in, *lq1, *lk1, *lq2, *lk2, *subg, *w_out, *g2, *wrg, *brg, *wre, *bre, *wg, *wu, *wd, *gf;
    float* out;
    unsigned char* ws;
};
using pg8::Unit;

struct DenseOrder {
    int nM, nN, G, c;
    __device__ __forceinline__ bool next(int i, Unit& u) const { const int L = i * G + c; if (L >= nM * nN) return false; u.pm = L / nN; u.pn = L % nN; u.pb = u.pn; return true; }
};
struct GroupedOrder {
    const int* tile_e; int ntiles, nN, G, c;
    __device__ __forceinline__ bool next(int i, Unit& u) const { const int L = i * G + c; if (L >= ntiles * nN) return false; u.pm = L / nN; u.pn = L % nN; u.pb = tile_e[u.pm] * nN + u.pn; return true; }
};

template <bool DUAL, class Sched, class Epi>
__device__ __forceinline__ void naive_gemm(Frame& F, const bf16* A, const bf16* Bt, int K, const Sched& S, const Epi& E) {
    float* As = (float*)F.lds; float* Bs = As + 32 * 68; float* Bs2 = Bs + 32 * 68;
    const int tid = F.tid, ty = tid >> 4, tx = tid & 15, lr = tid >> 3, lk = (tid & 7) * 4;
    Unit u;
    for (int i = 0; S.next(i, u); ++i) {
        for (int sm = 0; sm < 4; ++sm)
            for (int sn = 0; sn < (DUAL ? 2 : 4); ++sn) {
                float acc[2][4], acc2[2][4];
#pragma unroll
                for (int a = 0; a < 2; ++a)
#pragma unroll
                    for (int b = 0; b < 4; ++b) { acc[a][b] = 0.f; acc2[a][b] = 0.f; }
                const bf16* ap = A + (size_t)(256 * u.pm + 64 * sm + lr) * K + lk;
                const bf16* bp = Bt + (size_t)(256 * u.pb + 64 * sn + lr) * K + lk;
                for (int k0 = 0; k0 < K; k0 += 32) {
                    __syncthreads();
                    { const v2u w = *(const v2u*)(ap + k0); As[(lk + 0) * 68 + lr] = bflo(w.x); As[(lk + 1) * 68 + lr] = bfhi(w.x); As[(lk + 2) * 68 + lr] = bflo(w.y); As[(lk + 3) * 68 + lr] = bfhi(w.y); }
                    { const v2u w = *(const v2u*)(bp + k0); Bs[(lk + 0) * 68 + lr] = bflo(w.x); Bs[(lk + 1) * 68 + lr] = bfhi(w.x); Bs[(lk + 2) * 68 + lr] = bflo(w.y); Bs[(lk + 3) * 68 + lr] = bfhi(w.y); }
                    if (DUAL) { const v2u w = *(const v2u*)(bp + (size_t)128 * K + k0); Bs2[(lk + 0) * 68 + lr] = bflo(w.x); Bs2[(lk + 1) * 68 + lr] = bfhi(w.x); Bs2[(lk + 2) * 68 + lr] = bflo(w.y); Bs2[(lk + 3) * 68 + lr] = bfhi(w.y); }
                    __syncthreads();
#pragma unroll 8
                    for (int k = 0; k < 32; ++k) {
                        const float a0 = As[k * 68 + 2 * ty], a1 = As[k * 68 + 2 * ty + 1];
                        const f32x4 b = *(const f32x4*)(Bs + k * 68 + 4 * tx);
#pragma unroll
                        for (int j = 0; j < 4; ++j) { acc[0][j] += a0 * b[j]; acc[1][j] += a1 * b[j]; }
                        if (DUAL) { const f32x4 b2 = *(const f32x4*)(Bs2 + k * 68 + 4 * tx);
#pragma unroll
                            for (int j = 0; j < 4; ++j) { acc2[0][j] += a0 * b2[j]; acc2[1][j] += a1 * b2[j]; } }
                    }
                }
#pragma unroll
                for (int a = 0; a < 2; ++a)
#pragma unroll
                    for (int j = 0; j < 4; ++j) {
                        const int row = 256 * u.pm + 64 * sm + 2 * ty + a;
                        if (DUAL) E.elem(row, 128 * u.pn + 64 * sn + 4 * tx + j, silu_f(acc[a][j]) * acc2[a][j]);
                        else E.elem(row, 256 * u.pn + 64 * sn + 4 * tx + j, acc[a][j]);
                    }
            }
    }
    __syncthreads();
}
struct NEpiBf16 { bf16* O; int ldc; __device__ __forceinline__ void elem(int row, int col, float v) const { O[(size_t)row * ldc + col] = (bf16)f2bf(v); } };
struct NEpiResF32 { const float* base; float* O; int ldc; __device__ __forceinline__ void elem(int row, int col, float v) const { const size_t o = (size_t)row * ldc + col; O[o] = base[o] + v; } };
struct NEpiScatter { const int* stok; const float* sw; bf16* Y; __device__ __forceinline__ void elem(int row, int col, float v) const { const int tk = stok[row]; if (tk >= 0) Y[(size_t)tk * D + col] = (bf16)f2bf(v * sw[row]); } };

__device__ __forceinline__ void p0_transpose_item(const float* W, int K, int N, bf16* WT, int k0, int n0, int dstrow0, float scale, float* scr, int lane) {
#pragma unroll 8
    for (int i = 0; i < 32; ++i) { const int kk = 2 * i + (lane >> 5); scr[kk * 33 + (lane & 31)] = W[(size_t)(k0 + kk) * N + n0 + (lane & 31)] * scale; }
    LDS_WAIT(); asm volatile("" ::: "memory");
    const int c = lane & 7;
#pragma unroll
    for (int j = 0; j < 4; ++j) { const int n = (lane >> 3) + 8 * j; const float* s = scr + (8 * c) * 33 + n;
        v4u o; o.x = pk2(s[0 * 33], s[1 * 33]); o.y = pk2(s[2 * 33], s[3 * 33]); o.z = pk2(s[4 * 33], s[5 * 33]); o.w = pk2(s[6 * 33], s[7 * 33]);
        *(v4u*)(WT + (size_t)(dstrow0 + n) * K + k0 + 8 * c) = o; }
    LDS_WAIT(); asm volatile("" ::: "memory");
}
__device__ __forceinline__ void rms_row_to_bf16(const float* xrow, const float* g, bf16* orow, int lane) {
    const f32x4* xr = (const f32x4*)xrow + lane; const f32x4* gr = (const f32x4*)g + lane;
    f32x4 v[4]; float s = 0.f;
#pragma unroll
    for (int j = 0; j < 4; ++j) { v[j] = xr[64 * j]; s += (v[j].x * v[j].x + v[j].y * v[j].y) + (v[j].z * v[j].z + v[j].w * v[j].w); }
    const float rstd = 1.f / sqrtf(wave_sum(s) * (1.f / D) + EPS);
    unsigned long long* o8 = (unsigned long long*)orow + lane;
#pragma unroll
    for (int j = 0; j < 4; ++j) { const f32x4 gg = gr[64 * j];
        o8[64 * j] = (unsigned long long)pk2(v[j].x * rstd * gg.x, v[j].y * rstd * gg.y) | ((unsigned long long)pk2(v[j].z * rstd * gg.z, v[j].w * rstd * gg.w) << 32); }
}
__device__ __forceinline__ void p0_prologue(Frame& F) {
    float* scr = (float*)(F.lds + F.wave * 16384);
    const int gw = F.bid * NWAVES + F.wave, NGW = F.G * NWAVES;
    bf16* WinT = (bf16*)(F.ws + WS_WIN); bf16* WoutT = (bf16*)(F.ws + WS_WOUT); bf16* WguT = (bf16*)(F.ws + WS_WGU); bf16* WdT = (bf16*)(F.ws + WS_WD);
    constexpr int I_IN = 16 * 96, I_OUT = 16 * 32, I_E = 768, NITEMS = I_IN + I_OUT + NE * I_E;
    for (int it = gw; it < NITEMS; it += NGW) {
        int r = it;
        if (r < I_IN) { const int kb = r / 96, nb = r % 96, n0 = 32 * nb; const float sc = (n0 < C_KDA) ? C2 : ((n0 >= C_KR && n0 < C_VR) ? 0.125f : 1.f);
            p0_transpose_item(F.w_in, D, NIN, WinT, 64 * kb, n0, n0, sc, scr, F.lane); continue; }
        r -= I_IN;
        if (r < I_OUT) { const int kb = r / 32, nb = r % 32; p0_transpose_item(F.w_out, D, D, WoutT, 64 * kb, 32 * nb, 32 * nb, 1.f, scr, F.lane); continue; }
        r -= I_OUT;
        const int e = r / I_E; r %= I_E;
        if (r < 256) { const int kb = r / 16, nb = r % 16, n0 = 32 * nb; p0_transpose_item(F.wg + (size_t)e * D * HIDN, D, HIDN, WguT + (size_t)e * 1024 * D, 64 * kb, n0, 256 * (n0 >> 7) + (n0 & 127), 1.f, scr, F.lane); continue; }
        r -= 256;
        if (r < 256) { const int kb = r / 16, nb = r % 16, n0 = 32 * nb; p0_transpose_item(F.wu + (size_t)e * D * HIDN, D, HIDN, WguT + (size_t)e * 1024 * D, 64 * kb, n0, 256 * (n0 >> 7) + 128 + (n0 & 127), 1.f, scr, F.lane); continue; }
        r -= 256;
        { const int kb = r / 32, nb = r % 32; p0_transpose_item(F.wd + (size_t)e * HIDN * D, HIDN, D, WdT + (size_t)e * D * HIDN, 64 * kb, 32 * nb, 32 * nb, 1.f, scr, F.lane); }
    }
    float* WrT = (float*)(F.ws + WS_WRT);
    for (int i = F.bid * 512 + F.tid; i < NRT * D; i += F.G * 512) { const int c = i / D, k = i % D; WrT[i] = (c < 4) ? F.wrg[k * 4 + c] : F.wre[k * 32 + (c - 4)]; }
    bf16* XN1 = (bf16*)(F.ws + WS_A);
    for (int m = gw; m < T; m += NGW) rms_row_to_bf16(F.x + (size_t)m * D, F.g1, XN1 + (size_t)m * D, F.lane);
}

__device__ __forceinline__ float dot8(const v4u a, const v4u b) {
    return (bflo(a.x) * bflo(b.x) + bfhi(a.x) * bfhi(b.x)) + (bflo(a.y) * bflo(b.y) + bfhi(a.y) * bfhi(b.y)) + (bflo(a.z) * bflo(b.z) + bfhi(a.z) * bfhi(b.z)) + (bflo(a.w) * bflo(b.w) + bfhi(a.w) * bfhi(b.w));
}
__device__ __forceinline__ void naive_attn_unit(Frame& F, int h, int c, float lam, float slope2) {
    constexpr int QS = 136;
    bf16* Qs = (bf16*)F.lds; bf16* Ks = Qs + 64 * QS; float* Vs = (float*)(Ks + 64 * QS); float* Ps = Vs + 64 * 128;
    const bf16* PROJ = (const bf16*)(F.ws + WS_PROJ);
    const int tid = F.tid, q = tid >> 3, sub = tid & 7;
    const int qpos = 64 * c + q;
    __syncthreads();
    { const v4u* src = (const v4u*)(PROJ + (size_t)(64 * c + q) * NIN + C_QDA + h * 128 + sub * 16); v4u* dst = (v4u*)(Qs + q * QS + sub * 16); dst[0] = src[0]; dst[1] = src[1]; }
    float m0 = -1e30f, m1 = -1e30f, l0 = 0.f, l1 = 0.f, o0[16], o1[16];
#pragma unroll
    for (int i = 0; i < 16; ++i) { o0[i] = 0.f; o1[i] = 0.f; }
    for (int j = 0; j <= c; ++j) {
        __syncthreads();
        { const size_t row = (size_t)(64 * j + q) * NIN;
          const v4u* ks = (const v4u*)(PROJ + row + C_KDA + h * 128 + sub * 16); v4u* kd = (v4u*)(Ks + q * QS + sub * 16); kd[0] = ks[0]; kd[1] = ks[1];
          const v4u* vs = (const v4u*)(PROJ + row + C_VDA + h * 128 + sub * 16); const v4u a = vs[0], b = vs[1]; float* vd = Vs + q * 128 + sub * 16;
          vd[0] = bflo(a.x); vd[1] = bfhi(a.x); vd[2] = bflo(a.y); vd[3] = bfhi(a.y); vd[4] = bflo(a.z); vd[5] = bfhi(a.z); vd[6] = bflo(a.w); vd[7] = bfhi(a.w);
          vd[8] = bflo(b.x); vd[9] = bfhi(b.x); vd[10] = bflo(b.y); vd[11] = bfhi(b.y); vd[12] = bflo(b.z); vd[13] = bfhi(b.z); vd[14] = bflo(b.w); vd[15] = bfhi(b.w); }
        __syncthreads();
        float s0[8], s1[8];
#pragma unroll
        for (int kk = 0; kk < 8; ++kk) { s0[kk] = 0.f; s1[kk] = 0.f; }
#pragma unroll 1
        for (int d8 = 0; d8 < 8; ++d8) {
            const v4u qa = *(const v4u*)(Qs + q * QS + d8 * 8), qb = *(const v4u*)(Qs + q * QS + 64 + d8 * 8);
#pragma unroll
            for (int kk = 0; kk < 8; ++kk) { const int k = sub + 8 * kk;
                s0[kk] += dot8(qa, *(const v4u*)(Ks + k * QS + d8 * 8));
                if ((kk & 1) == 1) asm volatile("" ::: "memory"); }
#pragma unroll
            for (int kk = 0; kk < 8; ++kk) { const int k = sub + 8 * kk;
                s1[kk] += dot8(qb, *(const v4u*)(Ks + k * QS + 64 + d8 * 8));
                if ((kk & 1) == 1) asm volatile("" ::: "memory"); }
        }
#pragma unroll
        for (int kk = 0; kk < 8; ++kk) { const float dist = fabsf((float)(qpos - (64 * j + sub + 8 * kk))); s0[kk] -= slope2 * dist; s1[kk] -= slope2 * dist; }
        float t0 = s0[0], t1 = s1[0];
#pragma unroll
        for (int kk = 1; kk < 8; ++kk) { t0 = fmaxf(t0, s0[kk]); t1 = fmaxf(t1, s1[kk]); }
#pragma unroll
        for (int o = 1; o < 8; o <<= 1) { t0 = fmaxf(t0, __shfl_xor(t0, o)); t1 = fmaxf(t1, __shfl_xor(t1, o)); }
        const float mn0 = fmaxf(m0, t0), mn1 = fmaxf(m1, t1), al0 = exp2f(m0 - mn0), al1 = exp2f(m1 - mn1);
        m0 = mn0; m1 = mn1;
        float ps0 = 0.f, ps1 = 0.f;
#pragma unroll
        for (int kk = 0; kk < 8; ++kk) { const int k = sub + 8 * kk; const float p0 = exp2f(s0[kk] - mn0), p1 = exp2f(s1[kk] - mn1); ps0 += p0; ps1 += p1; Ps[q * 65 + k] = p0; Ps[64 * 65 + q * 65 + k] = p1; }
#pragma unroll
        for (int o = 1; o < 8; o <<= 1) { ps0 += __shfl_xor(ps0, o); ps1 += __shfl_xor(ps1, o); }
        l0 = l0 * al0 + ps0; l1 = l1 * al1 + ps1;
#pragma unroll
        for (int i = 0; i < 16; ++i) { o0[i] *= al0; o1[i] *= al1; }
        __syncthreads();
#pragma unroll 1
        for (int k = 0; k < 64; ++k) {
            const float p0 = Ps[q * 65 + k], p1 = Ps[64 * 65 + q * 65 + k];
            const float* vr = Vs + k * 128 + sub * 16;
#pragma unroll
            for (int i4 = 0; i4 < 4; ++i4) { const f32x4 v = *(const f32x4*)(vr + 4 * i4);
#pragma unroll
                for (int e = 0; e < 4; ++e) { o0[4 * i4 + e] += p0 * v[e]; o1[4 * i4 + e] += p1 * v[e]; } }
        }
    }
    const float r0 = 1.f / l0, r1 = lam / l1; float dv[16], ss = 0.f;
#pragma unroll
    for (int i = 0; i < 16; ++i) { dv[i] = o0[i] * r0 - o1[i] * r1; ss += dv[i] * dv[i]; }
#pragma unroll
    for (int o = 1; o < 8; o <<= 1) ss += __shfl_xor(ss, o);
    const float rstd = 1.f / sqrtf(ss * (1.f / 128.f) + EPS) * (1.f - LAMBDA_INIT);
    bf16* MIX = (bf16*)(F.ws + WS_A);
    unsigned w[8];
#pragma unroll
    for (int i = 0; i < 8; ++i) w[i] = pk2(dv[2 * i] * rstd * F.subg[sub * 16 + 2 * i], dv[2 * i + 1] * rstd * F.subg[sub * 16 + 2 * i + 1]);
    v4u* dst = (v4u*)(MIX + (size_t)qpos * D + h * 128 + sub * 16);
    dst[0] = (v4u){w[0], w[1], w[2], w[3]}; dst[1] = (v4u){w[4], w[5], w[6], w[7]};
}
__device__ __forceinline__ void p2_attention(Frame& F) {
    float a = 0.f, b = 0.f;
#pragma unroll 1
    for (int i = 0; i < 64; ++i) { a += F.lq1[i] * F.lk1[i]; b += F.lq2[i] * F.lk2[i]; }
    const float lam = __expf(a) - __expf(b) + LAMBDA_INIT;
    for (int u = F.bid; u < 512; u += F.G) {
        const int h = u >> 7, s = u & 127;
        const float slope2 = exp2f(-2.f * (float)(h + 1)) * LOG2E;
#pragma unroll 1
        for (int rep = 0; rep < 2; ++rep) naive_attn_unit(F, h, rep ? 255 - s : s, lam, slope2);
    }
}

__device__ __forceinline__ float ret_lg(int h) { return log1pf(-exp2f(-5.f - (float)h)); }
__device__ __forceinline__ void p3_ret_kv(Frame& F) {
    float* Ks = (float*)F.lds; float* Vs = Ks + 64 * 64;
    const bf16* PROJ = (const bf16*)(F.ws + WS_PROJ); float* KV = F.out;
    const int tid = F.tid, r = tid >> 3, sub = tid & 7;
    for (int u = F.bid; u < 1024; u += F.G) {
        const int n = u >> 2, h = u & 3; const float lg = ret_lg(h);
        __syncthreads();
        { const size_t row = (size_t)(64 * n + r) * NIN; const float w = __expf(lg * (float)(63 - r));
          const v4u a = *(const v4u*)(PROJ + row + C_KR + h * 64 + sub * 8); float* kd = Ks + r * 64 + sub * 8;
          kd[0] = bflo(a.x) * w; kd[1] = bfhi(a.x) * w; kd[2] = bflo(a.y) * w; kd[3] = bfhi(a.y) * w; kd[4] = bflo(a.z) * w; kd[5] = bfhi(a.z) * w; kd[6] = bflo(a.w) * w; kd[7] = bfhi(a.w) * w;
          const v4u* vs = (const v4u*)(PROJ + row + C_VR + h * 128 + sub * 16); const v4u b = vs[0], c = vs[1]; float* vd = Vs + r * 128 + sub * 16;
          vd[0] = bflo(b.x); vd[1] = bfhi(b.x); vd[2] = bflo(b.y); vd[3] = bfhi(b.y); vd[4] = bflo(b.z); vd[5] = bfhi(b.z); vd[6] = bflo(b.w); vd[7] = bfhi(b.w);
          vd[8] = bflo(c.x); vd[9] = bfhi(c.x); vd[10] = bflo(c.y); vd[11] = bfhi(c.y); vd[12] = bflo(c.z); vd[13] = bfhi(c.z); vd[14] = bflo(c.w); vd[15] = bfhi(c.w); }
        __syncthreads();
        float acc[16];
#pragma unroll
        for (int i = 0; i < 16; ++i) acc[i] = 0.f;
        const int d = r;
        for (int s = 0; s < 64; ++s) { const float kv = Ks[s * 64 + d]; const float* vr = Vs + s * 128 + sub * 16;
#pragma unroll
            for (int i = 0; i < 16; ++i) acc[i] += kv * vr[i]; }
        float* dst = KV + ((size_t)(n * 4 + h) * 64 + d) * 128 + sub * 16;
#pragma unroll
        for (int i = 0; i < 16; ++i) dst[i] = acc[i];
    }
}
__device__ __forceinline__ void p4_ret_scan(Frame& F) {
    const float* KV = F.out; float* SP = F.out + (size_t)8 * 1024 * 1024;
    const int gid = F.bid * 512 + F.tid;
    if (gid < 32768) {
        const int h = gid >> 13; const float dec = __expf(ret_lg(h) * 64.f);
        float st = 0.f;
        for (int n = 0; n < 256; ++n) { const size_t o = (size_t)n * 32768 + gid; SP[o] = st; st = st * dec + KV[o]; }
    }
}
__device__ __forceinline__ void p5_ret_out(Frame& F) {
    float* Qs = (float*)F.lds; float* Ks = Qs + 64 * 65; float* Vs = Ks + 64 * 65; float* Ss = Vs + 64 * 128; float* Ps = Ss + 64 * 128;
    const bf16* PROJ = (const bf16*)(F.ws + WS_PROJ); const float* SP = F.out + (size_t)8 * 1024 * 1024; bf16* MIX = (bf16*)(F.ws + WS_A);
    const int tid = F.tid, r = tid >> 3, sub = tid & 7;
    for (int u = F.bid; u < 1024; u += F.G) {
        const int n = u >> 2, h = u & 3; const float lg = ret_lg(h);
        __syncthreads();
        { const size_t row = (size_t)(64 * n + r) * NIN;
          const v4u a = *(const v4u*)(PROJ + row + C_QR + h * 64 + sub * 8); float* qd = Qs + r * 65 + sub * 8;
          qd[0] = bflo(a.x); qd[1] = bfhi(a.x); qd[2] = bflo(a.y); qd[3] = bfhi(a.y); qd[4] = bflo(a.z); qd[5] = bfhi(a.z); qd[6] = bflo(a.w); qd[7] = bfhi(a.w);
          const v4u k = *(const v4u*)(PROJ + row + C_KR + h * 64 + sub * 8); float* kd = Ks + r * 65 + sub * 8;
          kd[0] = bflo(k.x); kd[1] = bfhi(k.x); kd[2] = bflo(k.y); kd[3] = bfhi(k.y); kd[4] = bflo(k.z); kd[5] = bfhi(k.z); kd[6] = bflo(k.w); kd[7] = bfhi(k.w);
          const v4u* vs = (const v4u*)(PROJ + row + C_VR + h * 128 + sub * 16); const v4u b = vs[0], c = vs[1]; float* vd = Vs + r * 128 + sub * 16;
          vd[0] = bflo(b.x); vd[1] = bfhi(b.x); vd[2] = bflo(b.y); vd[3] = bfhi(b.y); vd[4] = bflo(b.z); vd[5] = bfhi(b.z); vd[6] = bflo(b.w); vd[7] = bfhi(b.w);
          vd[8] = bflo(c.x); vd[9] = bfhi(c.x); vd[10] = bflo(c.y); vd[11] = bfhi(c.y); vd[12] = bflo(c.z); vd[13] = bfhi(c.z); vd[14] = bflo(c.w); vd[15] = bfhi(c.w);
          const float* sp = SP + ((size_t)(n * 4 + h) * 64 + r) * 128 + sub * 16; float* sd = Ss + r * 128 + sub * 16;
#pragma unroll
          for (int i = 0; i < 16; ++i) sd[i] = sp[i]; }
        __syncthreads();
#pragma unroll 1
        for (int jj = 0; jj < 8; ++jj) { const int j = sub + 8 * jj; float s = 0.f;
#pragma unroll 8
            for (int d = 0; d < 64; ++d) s += Qs[r * 65 + d] * Ks[j * 65 + d];
            Ps[r * 65 + j] = (j <= r) ? s * __expf(lg * (float)(r - j)) : 0.f; }
        __syncthreads();
        float acc[16];
#pragma unroll
        for (int i = 0; i < 16; ++i) acc[i] = 0.f;
#pragma unroll 2
        for (int j = 0; j < 64; ++j) { const float p = Ps[r * 65 + j]; const float* vr = Vs + j * 128 + sub * 16;
#pragma unroll
            for (int i = 0; i < 16; ++i) acc[i] += p * vr[i]; }
        const float qd = __expf(lg * (float)(r + 1));
#pragma unroll 2
        for (int d = 0; d < 64; ++d) { const float qv = Qs[r * 65 + d] * qd; const float* sr = Ss + d * 128 + sub * 16;
#pragma unroll
            for (int i = 0; i < 16; ++i) acc[i] += qv * sr[i]; }
        float ss = 0.f;
#pragma unroll
        for (int i = 0; i < 16; ++i) ss += acc[i] * acc[i];
#pragma unroll
        for (int o = 1; o < 8; o <<= 1) ss += __shfl_xor(ss, o);
        const float rstd = 1.f / sqrtf(ss * (1.f / 128.f) + EPS);
        const size_t row = (size_t)(64 * n + r);
        const v4u* gs = (const v4u*)(PROJ + row * NIN + C_GR + h * 128 + sub * 16); const v4u ga = gs[0], gb = gs[1];
        const float gv[16] = {bflo(ga.x), bfhi(ga.x), bflo(ga.y), bfhi(ga.y), bflo(ga.z), bfhi(ga.z), bflo(ga.w), bfhi(ga.w), bflo(gb.x), bfhi(gb.x), bflo(gb.y), bfhi(gb.y), bflo(gb.z), bfhi(gb.z), bflo(gb.w), bfhi(gb.w)};
        unsigned w[8];
#pragma unroll
        for (int i = 0; i < 8; ++i) w[i] = pk2(silu_f(gv[2 * i]) * acc[2 * i] * rstd, silu_f(gv[2 * i + 1]) * acc[2 * i + 1] * rstd);
        v4u* dst = (v4u*)(MIX + row * D + 512 + h * 128 + sub * 16);
        dst[0] = (v4u){w[0], w[1], w[2], w[3]}; dst[1] = (v4u){w[4], w[5], w[6], w[7]};
    }
}

__device__ __forceinline__ void p7_route(Frame& F) {
    const float* H = F.out; bf16* XN2 = (bf16*)(F.ws + WS_A); const float* WrT = (const float*)(F.ws + WS_WRT);
    int* tok_e = (int*)(F.ws + WS_TOK + TK_E); int* tok_pos = (int*)(F.ws + WS_TOK + TK_POS); float* tok_w = (float*)(F.ws + WS_TOK + TK_W);
    const int gw = F.bid * NWAVES + F.wave, NGW = F.G * NWAVES, lane = F.lane;
    for (int t = gw; t < T; t += NGW) {
        const f32x4* xr = (const f32x4*)(H + (size_t)t * D) + lane; const f32x4* gr = (const f32x4*)F.g2 + lane;
        f32x4 v[4]; float s = 0.f;
#pragma unroll
        for (int j = 0; j < 4; ++j) { v[j] = xr[64 * j]; s += (v[j].x * v[j].x + v[j].y * v[j].y) + (v[j].z * v[j].z + v[j].w * v[j].w); }
        const float rstd = 1.f / sqrtf(wave_sum(s) * (1.f / D) + EPS);
        unsigned long long* o8 = (unsigned long long*)(XN2 + (size_t)t * D) + lane;
#pragma unroll
        for (int j = 0; j < 4; ++j) { const f32x4 gg = gr[64 * j]; v[j].x *= rstd * gg.x; v[j].y *= rstd * gg.y; v[j].z *= rstd * gg.z; v[j].w *= rstd * gg.w;
            o8[64 * j] = (unsigned long long)pk2(v[j].x, v[j].y) | ((unsigned long long)pk2(v[j].z, v[j].w) << 32); }
        float lg[4];
#pragma unroll
        for (int c = 0; c < 4; ++c) { const f32x4* wr = (const f32x4*)(WrT + (size_t)c * D) + lane; float p = 0.f;
#pragma unroll
            for (int j = 0; j < 4; ++j) { const f32x4 w = wr[64 * j]; p += (v[j].x * w.x + v[j].y * w.y) + (v[j].z * w.z + v[j].w * w.w); }
            lg[c] = wave_sum(p) + F.brg[c]; }
        int grp = 0; float gm = lg[0];
#pragma unroll
        for (int c = 1; c < 4; ++c) if (lg[c] > gm) { gm = lg[c]; grp = c; }
        float gs = 0.f;
#pragma unroll
        for (int c = 0; c < 4; ++c) gs += __expf(lg[c] - gm);
        const float gtop = 1.f / gs;
        float el[8];
#pragma unroll
        for (int i = 0; i < 8; ++i) { const f32x4* wr = (const f32x4*)(WrT + (size_t)(4 + grp * 8 + i) * D) + lane; float p = 0.f;
#pragma unroll
            for (int j = 0; j < 4; ++j) { const f32x4 w = wr[64 * j]; p += (v[j].x * w.x + v[j].y * w.y) + (v[j].z * w.z + v[j].w * w.w); }
            el[i] = wave_sum(p) + F.bre[grp * 8 + i]; }
        int i1 = 0; float v1 = el[0];
#pragma unroll
        for (int i = 1; i < 8; ++i) if (el[i] > v1) { v1 = el[i]; i1 = i; }
        int i2 = -1; float v2 = -3.0e38f;
#pragma unroll
        for (int i = 0; i < 8; ++i) if (i != i1 && el[i] > v2) { v2 = el[i]; i2 = i; }
        const float ex = __expf(v2 - v1), w1 = 1.f / (1.f + ex), w2 = ex / (1.f + ex);
        if (lane == 0) {
            const int e1 = grp * 8 + i1, e2 = grp * 8 + i2;
            const int p1 = (int)__hip_atomic_fetch_add(F.ctl + CW_CNT + 64 * e1, 1u, RLX_AGENT);
            const int p2 = (int)__hip_atomic_fetch_add(F.ctl + CW_CNT + 64 * e2, 1u, RLX_AGENT);
            tok_e[2 * t] = e1; tok_e[2 * t + 1] = e2; tok_pos[2 * t] = p1; tok_pos[2 * t + 1] = p2; tok_w[2 * t] = gtop * w1; tok_w[2 * t + 1] = gtop * w2;
        }
    }
}
__device__ __forceinline__ int build_tiles(Frame& F) {
    int* tile_e = (int*)(F.lds + TILEE_OFF); int* base = tile_e + 192; int* cnts = base + 32; int* nt = cnts + 32;
    __syncthreads();
    if (F.tid == 0) { int tiles = 0;
        for (int e = 0; e < NE; ++e) { const int c = (int)__hip_atomic_load(F.ctl + CW_CNT + 64 * e, RLX_AGENT); cnts[e] = c; base[e] = tiles * 256; const int n = (c + 255) >> 8; for (int i = 0; i < n; ++i) tile_e[tiles + i] = e; tiles += n; }
        nt[0] = tiles; }
    __syncthreads();
    return nt[0];
}
__device__ __forceinline__ void p8_permute(Frame& F) {
    (void)build_tiles(F);
    const int* base = (const int*)(F.lds + TILEE_OFF) + 192; const int* cnts = base + 32;
    const bf16* XN2 = (const bf16*)(F.ws + WS_A); bf16* XS = (bf16*)(F.ws + WS_PROJ);
    const int* tok_e = (const int*)(F.ws + WS_TOK + TK_E); const int* tok_pos = (const int*)(F.ws + WS_TOK + TK_POS); const float* tok_w = (const float*)(F.ws + WS_TOK + TK_W);
    int* stok = (int*)(F.ws + WS_TOK + TK_STOK); float* sw = (float*)(F.ws + WS_TOK + TK_SW);
    const int gw = F.bid * NWAVES + F.wave, NGW = F.G * NWAVES, lane = F.lane;
    for (int s = gw; s < NSLOT; s += NGW) {
        const int t = s >> 1, e = tok_e[s], dest = base[e] + tok_pos[s];
        const v4u* src = (const v4u*)(XN2 + (size_t)t * D) + lane; v4u* dst = (v4u*)(XS + (size_t)dest * D) + lane;
        dst[0] = src[0]; dst[64] = src[64];
        if (lane == 0) { stok[dest] = s; sw[dest] = tok_w[s]; }
    }
    for (int i = gw; i < NE * 256; i += NGW) { const int e = i >> 8, r = i & 255, c = cnts[e], padn = ((c + 255) & ~255) - c;
        if (r < padn) { const int dest = base[e] + c + r; v4u* dst = (v4u*)(XS + (size_t)dest * D) + lane; dst[0] = (v4u){0u, 0u, 0u, 0u}; dst[64] = (v4u){0u, 0u, 0u, 0u}; if (lane == 0) { stok[dest] = -1; sw[dest] = 0.f; } } }
}
__device__ __forceinline__ void p11_final(Frame& F) {
    const bf16* Y = (const bf16*)(F.ws + WS_WGU);
    const int gw = F.bid * NWAVES + F.wave, NGW = F.G * NWAVES, lane = F.lane;
    for (int t = gw; t < T; t += NGW) {
        f32x4* xr = (f32x4*)(F.out + (size_t)t * D) + lane; const f32x4* gr = (const f32x4*)F.gf + lane;
        const v2u* y0 = (const v2u*)(Y + (size_t)(2 * t) * D) + lane; const v2u* y1 = (const v2u*)(Y + (size_t)(2 * t + 1) * D) + lane;
        f32x4 v[4]; float s = 0.f;
#pragma unroll
        for (int j = 0; j < 4; ++j) { v[j] = xr[64 * j]; const v2u a = y0[64 * j], b = y1[64 * j];
            v[j].x += bflo(a.x) + bflo(b.x); v[j].y += bfhi(a.x) + bfhi(b.x); v[j].z += bflo(a.y) + bflo(b.y); v[j].w += bfhi(a.y) + bfhi(b.y);
            s += (v[j].x * v[j].x + v[j].y * v[j].y) + (v[j].z * v[j].z + v[j].w * v[j].w); }
        const float rstd = 1.f / sqrtf(wave_sum(s) * (1.f / D) + EPS);
#pragma unroll
        for (int j = 0; j < 4; ++j) { const f32x4 gg = gr[64 * j]; xr[64 * j] = (f32x4){v[j].x * rstd * gg.x, v[j].y * rstd * gg.y, v[j].z * rstd * gg.z, v[j].w * rstd * gg.w}; }
    }
}

struct Args { const float* in[18]; float* out; unsigned char* ws; int ph_lo, ph_hi; };
__global__ void __launch_bounds__(NWAVES * 64, 2) fwd_kernel(Args args) {
    extern __shared__ __attribute__((aligned(16))) unsigned char lds[];
    Frame F;
    F.lds = lds; F.tid = threadIdx.x; F.lane = F.tid & 63; F.wave = __builtin_amdgcn_readfirstlane(F.tid >> 6); F.G = gridDim.x; F.bid = blockIdx.x;
    F.ws = args.ws; F.ctl = (unsigned*)(args.ws + WS_CTL); F.out = args.out;
    F.x = args.in[0]; F.g1 = args.in[1]; F.w_in = args.in[2]; F.lq1 = args.in[3]; F.lk1 = args.in[4]; F.lq2 = args.in[5]; F.lk2 = args.in[6]; F.subg = args.in[7];
    F.w_out = args.in[8]; F.g2 = args.in[9]; F.wrg = args.in[10]; F.brg = args.in[11]; F.wre = args.in[12]; F.bre = args.in[13]; F.wg = args.in[14]; F.wu = args.in[15]; F.wd = args.in[16]; F.gf = args.in[17];
    volatile LAS unsigned* MISC = (volatile LAS unsigned*)((LAS unsigned char*)lds + MISC_OFF);
    for (int u = F.tid; u < (LDS_BYTES - LDSCTL_OFF) / 4; u += NWAVES * 64) ((LAS unsigned*)((LAS unsigned char*)lds + LDSCTL_OFF))[u] = 0u;
    __syncthreads();
    const int lo = args.ph_lo, hi = args.ph_hi;
    const int vcu = (F.G % 8 == 0) ? (F.bid % 8) * (F.G / 8) + F.bid / 8 : F.bid;
    XcdBarrier bar; bar.bar = F.ctl + CW_BAR; bar.x = 0; bar.st = nullptr;
    if (hi - lo > 1) bar = xcd_barrier_post(F.ctl + CW_BAR, MISC + 8);
#ifndef PH_MASK
#define PH_MASK 0xFFFF
#endif
#define IN(k) (((PH_MASK >> (k)) & 1) && lo <= (k) && (k) < hi)
#define SEAM(k) do { if (IN(k) && IN((k) + 1)) xcd_barrier(bar); } while (0)
    if (IN(0)) { p0_prologue(F); } SEAM(0);
    if (IN(1)) {
        if (USE_MFMA & 1) { pg8::Gemm g{(const bf16*)(F.ws + WS_A), (const bf16*)(F.ws + WS_WIN), T, NIN, D}; pg8::StaticOrder S; S.init(T, NIN, F.G, F.bid);
            pg8::EpiBf16Plain E{(bf16*)(F.ws + WS_PROJ), NIN}; pg8::gemm_phase<pg8::EpiBf16Plain, pg8::StaticOrder, true, true>((LAS unsigned char*)lds, g, S, E); }
        else { DenseOrder S{T / 256, NIN / 256, F.G, F.bid}; NEpiBf16 E{(bf16*)(F.ws + WS_PROJ), NIN};
            naive_gemm<false>(F, (const bf16*)(F.ws + WS_A), (const bf16*)(F.ws + WS_WIN), D, S, E); } } SEAM(1);
    if (IN(2)) { p3_ret_kv(F); } SEAM(2);
    if (IN(3)) { p4_ret_scan(F); p2_attention(F); } SEAM(3);
    if (IN(4)) { p5_ret_out(F); } SEAM(4);
    if (IN(5)) {
        if (USE_MFMA & 2) { pg8::Gemm g{(const bf16*)(F.ws + WS_A), (const bf16*)(F.ws + WS_WOUT), T, D, D}; pg8::StaticOrder S; S.init(T, D, F.G, F.bid);
            pg8::EpiResF32 E{F.x, F.out, D}; pg8::gemm_phase<pg8::EpiResF32, pg8::StaticOrder, true, true>((LAS unsigned char*)lds, g, S, E); }
        else { DenseOrder S{T / 256, D / 256, F.G, F.bid}; NEpiResF32 E{F.x, F.out, D};
            naive_gemm<false>(F, (const bf16*)(F.ws + WS_A), (const bf16*)(F.ws + WS_WOUT), D, S, E); } } SEAM(5);
    if (IN(6)) { p7_route(F); } SEAM(6);
    if (IN(7)) { p8_permute(F); } SEAM(7);
    if (IN(8)) { const int nt = build_tiles(F);
        if (USE_MFMA & 4) { pg8::Gemm g{(const bf16*)(F.ws + WS_PROJ), (const bf16*)(F.ws + WS_WGU), NPAD, 1024, D}; pg8::GroupedOrder S{(const LAS int*)((LAS unsigned char*)lds + TILEE_OFF), nt, 4, F.G, vcu};
            pg8::EpiSwiglu E{(bf16*)(F.ws + WS_A), HIDN}; pg8::gemm_phase<pg8::EpiSwiglu, pg8::GroupedOrder, true, true>((LAS unsigned char*)lds, g, S, E); }
        else { GroupedOrder S{(const int*)(F.lds + TILEE_OFF), nt, 4, F.G, F.bid}; NEpiBf16 E{(bf16*)(F.ws + WS_A), HIDN};
            naive_gemm<true>(F, (const bf16*)(F.ws + WS_PROJ), (const bf16*)(F.ws + WS_WGU), D, S, E); } } SEAM(8);
    if (IN(9)) { const int nt = build_tiles(F);
        if (USE_MFMA & 8) { pg8::Gemm g{(const bf16*)(F.ws + WS_A), (const bf16*)(F.ws + WS_WD), NPAD, 1024, HIDN}; pg8::GroupedOrder S{(const LAS int*)((LAS unsigned char*)lds + TILEE_OFF), nt, 4, F.G, vcu};
            pg8::EpiScatter E{(const int*)(F.ws + WS_TOK + TK_STOK), (const float*)(F.ws + WS_TOK + TK_SW), (bf16*)(F.ws + WS_WGU), D};
            pg8::gemm_phase<pg8::EpiScatter, pg8::GroupedOrder, true, true>((LAS unsigned char*)lds, g, S, E); }
        else { GroupedOrder S{(const int*)(F.lds + TILEE_OFF), nt, 4, F.G, F.bid};
            NEpiScatter E{(const int*)(F.ws + WS_TOK + TK_STOK), (const float*)(F.ws + WS_TOK + TK_SW), (bf16*)(F.ws + WS_WGU)};
            naive_gemm<false>(F, (const bf16*)(F.ws + WS_A), (const bf16*)(F.ws + WS_WD), HIDN, S, E); } } SEAM(9);
    if (IN(10)) { p11_final(F); }
#undef IN
#undef SEAM
}

extern "C" void kernel_launch(void* const* d_in, const int* in_sizes, int n_in, void* d_out, int out_size, void* d_ws, size_t ws_size, hipStream_t stream) {
    static int grid = 0;
    if (grid == 0) {
        if (n_in != 18 || in_sizes[0] != T * D || out_size != T * D || ws_size < WS_END) { fprintf(stderr, "kernel_launch: shape mismatch n_in %d in0 %d out %d ws %zu\n", n_in, n_in > 0 ? in_sizes[0] : -1, out_size, ws_size); grid = -1; return; }
        int dev = 0, cus = 0, per_cu = 0;
        if (hipGetDevice(&dev) != hipSuccess || hipDeviceGetAttribute(&cus, hipDeviceAttributeMultiprocessorCount, dev) != hipSuccess) { grid = -1; return; }
        if (hipFuncSetAttribute((const void*)fwd_kernel, hipFuncAttributeMaxDynamicSharedMemorySize, LDS_BYTES) != hipSuccess) { fprintf(stderr, "kernel_launch: hipFuncSetAttribute failed\n"); grid = -1; return; }
        if (hipOccupancyMaxActiveBlocksPerMultiprocessor(&per_cu, (const void*)fwd_kernel, NWAVES * 64, LDS_BYTES) != hipSuccess || per_cu < 1) fprintf(stderr, "kernel_launch: occupancy query says %d\n", per_cu);
        (void)hipGetLastError();
        grid = cus;
    }
    if (grid < 0) return;
    (void)hipMemsetAsync((char*)d_ws + WS_CTL, 0, CTL_ZERO_BYTES, stream);
    Args a{};
    for (int i = 0; i < 18; ++i) a.in[i] = (const float*)d_in[i];
    a.out = (float*)d_out; a.ws = (unsigned char*)d_ws;
#if MK_ONE_LAUNCH
    a.ph_lo = 0; a.ph_hi = NPHASE;
    hipLaunchKernelGGL(fwd_kernel, dim3(grid), dim3(NWAVES * 64), LDS_BYTES, stream, a);
#else
    for (int p = 0; p < NPHASE; ++p) { a.ph_lo = p; a.ph_hi = p + 1; hipLaunchKernelGGL(fwd_kernel, dim3(grid), dim3(NWAVES * 64), LDS_BYTES, stream, a); }
#endif
}
```

```cpp
#include <hip/hip_runtime.h>
#include <cstdio>
#include <cstdint>

#ifndef USE_MFMA
#define USE_MFMA 0x1F
#endif
#ifndef MK_ONE_LAUNCH
#define MK_ONE_LAUNCH 1
#endif

constexpr int T = 16384, D = 1024, NIN = 3072;
constexpr int C_QDA = 0, C_KDA = 512, C_VDA = 1024, C_QR = 1536, C_KR = 1792, C_VR = 2048, C_GR = 2560;
constexpr int NE = 32, HIDN = 512, NSLOT = 2 * T, MAXTILES = NSLOT / 256 + NE, NPAD = MAXTILES * 256;
constexpr int NRT = 36;
constexpr float EPS = 1e-6f;
constexpr float LOG2E = 1.4426950408889634f;
constexpr float C2 = 0.125f * LOG2E;
constexpr float LAMBDA_INIT = 0.2f;
constexpr int NPHASE = 11;

constexpr size_t MiB = 1u << 20;
constexpr size_t WS_CTL = 0, CTL_ZERO_BYTES = 1 * MiB;
constexpr size_t WS_WRT = 1 * MiB;
constexpr size_t WS_WIN = 2 * MiB;
constexpr size_t WS_WOUT = 8 * MiB;
constexpr size_t WS_WGU = 10 * MiB;
constexpr size_t WS_WD = 74 * MiB;
constexpr size_t WS_A = 106 * MiB;
constexpr size_t WS_PROJ = 146 * MiB;
constexpr size_t WS_TOK = 242 * MiB;
constexpr size_t WS_END = 244 * MiB;
constexpr int CW_BAR = 4096;
constexpr int CW_CNT = 1024;
constexpr size_t TK_E = 0, TK_POS = 128 * 1024, TK_W = 256 * 1024, TK_STOK = 384 * 1024, TK_SW = 384 * 1024 + 160 * 1024;

constexpr int RING_BYTES = 131072;
constexpr int LDSCTL_OFF = RING_BYTES, MISC_OFF = LDSCTL_OFF + 320, TILEE_OFF = LDSCTL_OFF + 1024;
constexpr int LDS_BYTES = 147456;
constexpr int NWAVES = 8;

#define GAS __attribute__((address_space(1)))
#define LAS __attribute__((address_space(3)))
typedef unsigned short bf16;
typedef unsigned v4u __attribute__((ext_vector_type(4)));
typedef unsigned v2u __attribute__((ext_vector_type(2)));
typedef float f32x4 __attribute__((ext_vector_type(4)));
#define RLX_AGENT __ATOMIC_RELAXED, __HIP_MEMORY_SCOPE_AGENT
#define LDS_WAIT() asm volatile("s_waitcnt lgkmcnt(0)" ::: "memory")

__device__ __forceinline__ unsigned f2bf(float f) { unsigned u = __builtin_bit_cast(unsigned, f); return (u + 0x7fffu + ((u >> 16) & 1u)) >> 16; }
__device__ __forceinline__ unsigned pk2(float lo, float hi) { return f2bf(lo) | (f2bf(hi) << 16); }
__device__ __forceinline__ float bflo(unsigned w) { return __builtin_bit_cast(float, w << 16); }
__device__ __forceinline__ float bfhi(unsigned w) { return __builtin_bit_cast(float, w & 0xffff0000u); }
__device__ __forceinline__ float bf2f(bf16 b) { return __builtin_bit_cast(float, (unsigned)b << 16); }
__device__ __forceinline__ float wave_sum(float v) {
#pragma unroll
    for (int o = 1; o < 64; o <<= 1) v += __shfl_xor(v, o);
    return v;
}
__device__ __forceinline__ float silu_f(float v) { return v / (1.f + __expf(-v)); }

#define XB_TMO      128
#define XB_XCNT(j)  (256  + 64 * (j))
#define XB_XSUB(j)  (1280 + 64 * (j))
#define XB_XGEN(j)  (2304 + 64 * (j))
#define XB_TOP      3328
#define XB_TOPGEN   3392
#define XCD_BAR_WORDS 3456
#define XB_SPIN_CAP (1u << 18)
__device__ __forceinline__ unsigned xb_ld(unsigned* p)              { return __hip_atomic_load(p, __ATOMIC_RELAXED, __HIP_MEMORY_SCOPE_AGENT); }
__device__ __forceinline__ unsigned xb_add(unsigned* p, unsigned v) { return __hip_atomic_fetch_add(p, v, __ATOMIC_RELAXED, __HIP_MEMORY_SCOPE_AGENT); }
__device__ __forceinline__ unsigned xb_xcc_id() { return (unsigned)__builtin_amdgcn_s_getreg((3 << 11) | 20) & 0xFu; }
#define XB_SPIN(cond, bar) do { unsigned _sp = 0; while (cond) { __builtin_amdgcn_s_sleep(1); \
    if ((++_sp & 255u) == 0u) { if (xb_ld(&(bar)[XB_TMO])) break; if (_sp > XB_SPIN_CAP) { atomicAdd(&(bar)[XB_TMO], 1u); break; } } } } while (0)
struct XcdBarrier { unsigned* bar; unsigned x; volatile LAS unsigned* st; };
__device__ __forceinline__ XcdBarrier xcd_barrier_post(unsigned* bar, volatile LAS unsigned* st) {
    XcdBarrier b; b.bar = bar; b.x = xb_xcc_id(); b.st = st;
    if (threadIdx.x == 0) (void)xb_add(&bar[XB_XCNT(b.x)], 1u);
    return b;
}
__device__ __forceinline__ void xcd_barrier_complete(unsigned* bar, unsigned x, unsigned& nloc, unsigned& nx) {
    const unsigned G = gridDim.x * gridDim.y * gridDim.z;
    unsigned sum, cnt, mine, sp = 0u;
    for (;;) {
        sum = 0u; cnt = 0u; mine = 0u;
#pragma unroll
        for (unsigned j = 0; j < 16; ++j) { const unsigned c = xb_ld(&bar[XB_XCNT(j)]); sum += c; cnt += (c > 0u) ? 1u : 0u; mine = (j == x) ? c : mine; }
        if (sum == G) break;
        __builtin_amdgcn_s_sleep(1);
        if ((++sp & 255u) == 0u) { if (xb_ld(&bar[XB_TMO])) break; if (sp > XB_SPIN_CAP) { atomicAdd(&bar[XB_TMO], 1u); break; } }
    }
    nloc = mine > 0u ? mine : 1u; nx = cnt > 0u ? cnt : 1u;
}
__device__ __forceinline__ void xcd_barrier(const XcdBarrier& b) {
    asm volatile("s_waitcnt vmcnt(0)" ::: "memory");
    __syncthreads();
    if (threadIdx.x == 0) {
        unsigned* bar = b.bar;
        __builtin_amdgcn_s_waitcnt(0);
        unsigned nloc = b.st[0], nx = b.st[1];
        if (nloc == 0u) { xcd_barrier_complete(bar, b.x, nloc, nx); b.st[0] = nloc; b.st[1] = nx; }
        const unsigned old = xb_add(&bar[XB_XSUB(b.x)], 1u);
        const unsigned gen = old / nloc;
        if (old + 1u == (gen + 1u) * nloc) {
            __builtin_amdgcn_fence(__ATOMIC_RELEASE, "agent");
            asm volatile("s_waitcnt vmcnt(0)" ::: "memory");
            const unsigned og = xb_add(&bar[XB_TOP], 1u);
            const unsigned tg = og / nx;
            if (og + 1u == (tg + 1u) * nx) xb_add(&bar[XB_TOPGEN], 1u);
            else XB_SPIN(xb_ld(&bar[XB_TOPGEN]) == tg, bar);
            __builtin_amdgcn_fence(__ATOMIC_ACQUIRE, "agent");
            xb_add(&bar[XB_XGEN(b.x)], 1u);
            asm volatile("s_waitcnt vmcnt(0)" ::: "memory");
        } else {
            XB_SPIN(xb_ld(&bar[XB_XGEN(b.x)]) == gen, bar);
            __builtin_amdgcn_fence(__ATOMIC_ACQUIRE, "agent");
            asm volatile("s_waitcnt vmcnt(0)" ::: "memory");
        }
    }
    __syncthreads();
}

namespace pg8 {
#define PG8_LAS __attribute__((address_space(3)))
typedef unsigned short bf16_t;
typedef short bf16x8 __attribute__((ext_vector_type(8)));
typedef float f32x4 __attribute__((ext_vector_type(4)));
typedef unsigned u32x4 __attribute__((ext_vector_type(4)));
constexpr int BM = 256, BK = 64, HALF = 128, HTB = HALF * BK * 2  , STAGE_BYTES = 8 * HTB, NXCD = 8, WGM = 8;

__host__ __device__ __forceinline__ int lds_byte(int r, int c) { const int st = (r >> 4) * 2 + (c >> 5), rr = r & 15, cc = c & 31, ob = rr * 64 + cc * 2; return st * 1024 + (ob ^ (((ob >> 9) & 1) << 5)); }
__host__ __device__ __forceinline__ void stage_rc(int b, int& R, int& C) { const int st = b / 1024, sb = b % 1024, swz = sb ^ (((sb >> 9) & 1) << 5); R = (st >> 1) * 16 + swz / 64; C = (st & 1) * 32 + (swz % 64) / 2; }
__host__ __device__ __forceinline__ int perm32(int rho) { const int n = rho >> 4, i = rho & 15; return 8 * (i >> 2) + 4 * n + (i & 3); }

struct Unit { int pm, pn, pb; };
struct Gemm { const bf16_t* A; const bf16_t* Bt; int M, N, K; };
__device__ __forceinline__ unsigned cvt_pk_bf16(float lo, float hi) { unsigned r; asm volatile("v_cvt_pk_bf16_f32 %0, %1, %2" : "=v"(r) : "v"(lo), "v"(hi)); return r; }
template <class Epi, class Sched, bool ALIGN_EPI = false, bool SP2 = false>
__device__ __forceinline__ void gemm_phase(PG8_LAS unsigned char* lds, const Gemm g, const Sched& S, const Epi& E) {
    const int tid = threadIdx.x, wid = __builtin_amdgcn_readfirstlane(tid >> 6), lane = tid & 63, wr = wid >> 2, wc = wid & 3, fr = lane & 15, fq = lane >> 4;
    const int K = g.K, nt = K / BK;
    unsigned voffA[2], voffB[2];
#pragma unroll
    for (int i = 0; i < 2; ++i) { int R, C; stage_rc(tid * 16 + i * 8192, R, C); const int Rb = Epi::PERM ? ((R & ~31) + perm32(R & 31)) : R;
        voffA[i] = (unsigned)(R * K + C) * 2u; voffB[i] = (unsigned)(Rb * K + C) * 2u; }
    const size_t kstep = (size_t)(BK * 2);
    const size_t hstep = (size_t)HALF * K * 2;
    const size_t tstep = 2 * hstep;
    const unsigned ldsw = (unsigned)wid * 1024u;
    const int aoff = lds_byte(wr * 64 + fr, fq * 8), boff = lds_byte(wc * 32 + fr, fq * 8);
#define PG8_SA(b, h) (((b) * 2 + (h)) * HTB)
#define PG8_SB(b, h) ((4 + (b) * 2 + (h)) * HTB)
#define PG8_STAGE(bufoff, gbase, voff) do { _Pragma("unroll") for (int _i = 0; _i < 2; ++_i) \
        __builtin_amdgcn_global_load_lds((const unsigned*)((const char*)(gbase) + (voff)[_i]), (PG8_LAS unsigned*)(lds + (bufoff) + ldsw + _i * 8192), 16, 0, 0); } while (0)
#define PG8_LDA(dst, b, h) do { _Pragma("unroll") for (int m = 0; m < 4; ++m) _Pragma("unroll") for (int k = 0; k < 2; ++k) dst[m][k] = *(const PG8_LAS bf16x8*)(lds + PG8_SA(b, h) + aoff + m * 2048 + k * 1024); } while (0)
#define PG8_LDB(dst, b, h) do { _Pragma("unroll") for (int n = 0; n < 2; ++n) _Pragma("unroll") for (int k = 0; k < 2; ++k) dst[n][k] = *(const PG8_LAS bf16x8*)(lds + PG8_SB(b, h) + boff + n * 2048 + k * 1024); } while (0)
#define PG8_MMA(ai, bj, At, Bt) do { __builtin_amdgcn_s_setprio(1); _Pragma("unroll") for (int m = 0; m < 4; ++m) _Pragma("unroll") for (int n = 0; n < 2; ++n) _Pragma("unroll") for (int k = 0; k < 2; ++k) \
        acc[ai][bj][m][n] = __builtin_amdgcn_mfma_f32_16x16x32_bf16(Bt[n][k], At[m][k], acc[ai][bj][m][n], 0, 0, 0); __builtin_amdgcn_s_setprio(0); } while (0)
#define PG8_WAIT_V(n) asm volatile("s_waitcnt vmcnt(" #n ")" ::: "memory")
#define PG8_WAIT_L(n) asm volatile("s_waitcnt lgkmcnt(" #n ")" ::: "memory")
#define PG8_BAR __builtin_amdgcn_s_barrier()
#define PG8_SCHED __builtin_amdgcn_sched_barrier(0)
    Unit cur, nxt; int ui = 0;
    if (!S.next(0, cur)) return;
    f32x4 acc[2][2][4][2];
#pragma unroll
    for (int a = 0; a < 2; ++a)
#pragma unroll
        for (int b = 0; b < 2; ++b)
#pragma unroll
            for (int m = 0; m < 4; ++m)
#pragma unroll
                for (int n = 0; n < 2; ++n) acc[a][b][m][n] = (f32x4){0.f, 0.f, 0.f, 0.f};
    bf16x8 At[4][2], B0[2][2], B1[2][2];
    const char* cA = (const char*)g.A + (size_t)cur.pm * tstep; const char* cB = (const char*)g.Bt + (size_t)cur.pb * tstep;
    S.a_ready(cur);
    if constexpr (SP2) {
        PG8_STAGE(PG8_SB(0, 0), cB, voffB); PG8_STAGE(PG8_SB(0, 1), cB + hstep, voffB); PG8_STAGE(PG8_SA(0, 0), cA, voffA); PG8_STAGE(PG8_SA(0, 1), cA + hstep, voffA);
        if (wr == 1) PG8_BAR;
        PG8_WAIT_V(2); PG8_BAR;
        PG8_STAGE(PG8_SB(1, 0), cB + kstep, voffB); PG8_STAGE(PG8_SA(1, 0), cA + kstep, voffA); PG8_STAGE(PG8_SB(1, 1), cB + hstep + kstep, voffB);
        PG8_WAIT_V(6); PG8_BAR;
    } else {
        PG8_STAGE(PG8_SB(0, 0), cB, voffB); PG8_STAGE(PG8_SA(0, 0), cA, voffA); PG8_STAGE(PG8_SB(0, 1), cB + hstep, voffB); PG8_STAGE(PG8_SA(0, 1), cA + hstep, voffA);
        if (wr == 1) PG8_BAR;
        PG8_WAIT_V(4); PG8_BAR;
        PG8_STAGE(PG8_SB(1, 0), cB + kstep, voffB); PG8_STAGE(PG8_SA(1, 0), cA + kstep, voffA); PG8_STAGE(PG8_SB(1, 1), cB + hstep + kstep, voffB);
        PG8_WAIT_V(6); PG8_BAR;
    }
    for (;;) {
        const bool has_next = S.next(ui + 1, nxt);
        const char* nA = has_next ? (const char*)g.A + (size_t)nxt.pm * tstep : cA; const char* nB = has_next ? (const char*)g.Bt + (size_t)nxt.pb * tstep : cB;
        for (int t = 0; t < nt; t += 2) {
            const bool last = (t == nt - 2);
            const char* a1 = cA + (size_t)(t + 1) * kstep;
            const char* a2 = last ? nA : cA + (size_t)(t + 2) * kstep; const char* b2 = last ? nB : cB + (size_t)(t + 2) * kstep;
            const char* a3 = a2 + kstep; const char* b3 = b2 + kstep;
            if (last && has_next) S.a_ready(nxt);
            if constexpr (SP2) {
            PG8_LDB(B0, 0, 0); PG8_LDB(B1, 0, 1); PG8_SCHED; PG8_LDA(At, 0, 0); PG8_STAGE(PG8_SA(1, 1), a1 + hstep, voffA);
            PG8_WAIT_V(8); PG8_WAIT_L(0); PG8_BAR; PG8_MMA(0, 0, At, B0); PG8_MMA(0, 1, At, B1); PG8_BAR; PG8_SCHED;
            PG8_LDA(At, 0, 1); PG8_STAGE(PG8_SB(0, 0), b2, voffB); PG8_STAGE(PG8_SB(0, 1), b2 + hstep, voffB); PG8_STAGE(PG8_SA(0, 0), a2, voffA);
            PG8_WAIT_V(8); PG8_WAIT_L(0); PG8_BAR; PG8_MMA(1, 0, At, B0); PG8_MMA(1, 1, At, B1); PG8_BAR; PG8_SCHED;
            PG8_LDB(B0, 1, 0); PG8_LDB(B1, 1, 1); PG8_SCHED; PG8_LDA(At, 1, 0); PG8_STAGE(PG8_SA(0, 1), a2 + hstep, voffA);
            PG8_WAIT_V(8); PG8_WAIT_L(0); PG8_BAR; PG8_MMA(0, 0, At, B0); PG8_MMA(0, 1, At, B1); PG8_BAR; PG8_SCHED;
            PG8_LDA(At, 1, 1); PG8_STAGE(PG8_SB(1, 0), b3, voffB); PG8_STAGE(PG8_SB(1, 1), b3 + hstep, voffB); PG8_STAGE(PG8_SA(1, 0), a3, voffA);
            PG8_WAIT_V(8); PG8_WAIT_L(0); PG8_BAR; PG8_MMA(1, 0, At, B0); PG8_MMA(1, 1, At, B1); PG8_BAR; PG8_SCHED;
            } else {
            PG8_LDB(B0, 0, 0); PG8_SCHED; PG8_LDA(At, 0, 0); PG8_STAGE(PG8_SA(1, 1), a1 + hstep, voffA);
            PG8_WAIT_L(8); PG8_BAR; PG8_WAIT_L(0); PG8_MMA(0, 0, At, B0); PG8_BAR; PG8_SCHED;
            PG8_LDB(B1, 0, 1); PG8_STAGE(PG8_SB(0, 0), b2, voffB);
            PG8_BAR; PG8_WAIT_L(0); PG8_MMA(0, 1, At, B1); PG8_BAR;
            PG8_LDA(At, 0, 1); PG8_STAGE(PG8_SA(0, 0), a2, voffA);
            PG8_BAR; PG8_WAIT_L(0); PG8_MMA(1, 0, At, B0); PG8_BAR; PG8_SCHED;
            PG8_STAGE(PG8_SB(0, 1), b2 + hstep, voffB);
            PG8_WAIT_V(6); PG8_BAR; PG8_MMA(1, 1, At, B1); PG8_BAR;
            PG8_LDB(B0, 1, 0); PG8_SCHED; PG8_LDA(At, 1, 0); PG8_STAGE(PG8_SA(0, 1), a2 + hstep, voffA);
            PG8_WAIT_L(8); PG8_BAR; PG8_WAIT_L(0); PG8_MMA(0, 0, At, B0); PG8_BAR; PG8_SCHED;
            PG8_LDB(B1, 1, 1); PG8_STAGE(PG8_SB(1, 0), b3, voffB);
            PG8_BAR; PG8_WAIT_L(0); PG8_MMA(0, 1, At, B1); PG8_BAR;
            PG8_LDA(At, 1, 1); PG8_STAGE(PG8_SA(1, 0), a3, voffA);
            PG8_BAR; PG8_WAIT_L(0); PG8_MMA(1, 0, At, B0); PG8_BAR; PG8_SCHED;
            PG8_STAGE(PG8_SB(1, 1), b3 + hstep, voffB);
            PG8_WAIT_V(6); PG8_BAR; PG8_MMA(1, 1, At, B1); PG8_BAR;
            }
        }
        if constexpr (ALIGN_EPI) { if (wr == 0) PG8_BAR; }
        if constexpr (!Epi::AFTER_DRAIN) { E(acc, cur, wr, wc, fr, fq); S.done(cur); }
        if (!has_next) break;
#pragma unroll
        for (int a = 0; a < 2; ++a)
#pragma unroll
            for (int b = 0; b < 2; ++b)
#pragma unroll
                for (int m = 0; m < 4; ++m)
#pragma unroll
                    for (int n = 0; n < 2; ++n) acc[a][b][m][n] = (f32x4){0.f, 0.f, 0.f, 0.f};
        cur = nxt; cA = nA; cB = nB; ++ui;
        if constexpr (ALIGN_EPI) { if (wr == 1) PG8_BAR; }
    }
    PG8_WAIT_V(0);
    if constexpr (!ALIGN_EPI) { if (wr == 0) PG8_BAR; }
    PG8_BAR;
    if constexpr (Epi::AFTER_DRAIN) { E.fused(acc, cur, wr, wc, fr, fq, lds, wid, lane); S.done(cur); }
#undef PG8_SA
#undef PG8_SB
#undef PG8_STAGE
#undef PG8_LDA
#undef PG8_LDB
#undef PG8_MMA
#undef PG8_WAIT_V
#undef PG8_WAIT_L
#undef PG8_BAR
#undef PG8_SCHED
}

struct EpiBf16Plain {
    static constexpr bool PERM = true, AFTER_DRAIN = false;
    bf16_t* O; int ldc;
    __device__ __forceinline__ void operator()(const f32x4 (&acc)[2][2][4][2], const Unit& u, int wr, int wc, int fr, int fq) const {
        const int row0 = u.pm * BM + wr * 64 + fr, col0 = u.pn * BM + wc * 32 + 8 * fq;
#pragma unroll
        for (int ai = 0; ai < 2; ++ai)
#pragma unroll
            for (int m = 0; m < 4; ++m) { bf16_t* rowp = O + (size_t)(row0 + ai * HALF + m * 16) * ldc + col0;
#pragma unroll
                for (int bj = 0; bj < 2; ++bj) { const f32x4 v0 = acc[ai][bj][m][0], v1 = acc[ai][bj][m][1];
                    u32x4 w; w.x = cvt_pk_bf16(v0[0], v0[1]); w.y = cvt_pk_bf16(v0[2], v0[3]); w.z = cvt_pk_bf16(v1[0], v1[1]); w.w = cvt_pk_bf16(v1[2], v1[3]);
                    *(u32x4*)(rowp + bj * HALF) = w; } }
    }
};
struct EpiResF32 {
    static constexpr bool PERM = false, AFTER_DRAIN = false;
    const float* base; float* C; int ldc;
    __device__ __forceinline__ void operator()(const f32x4 (&acc)[2][2][4][2], const Unit& u, int wr, int wc, int fr, int fq) const {
        const int row0 = u.pm * BM + wr * 64 + fr, col0 = u.pn * BM + wc * 32 + 4 * fq;
#pragma unroll
        for (int ai = 0; ai < 2; ++ai)
#pragma unroll
            for (int m = 0; m < 4; ++m) { const size_t off = (size_t)(row0 + ai * HALF + m * 16) * ldc + col0;
                f32x4 b[2][2];
#pragma unroll
                for (int bj = 0; bj < 2; ++bj)
#pragma unroll
                    for (int n = 0; n < 2; ++n) b[bj][n] = *(const f32x4*)(base + off + bj * HALF + n * 16);
#pragma unroll
                for (int bj = 0; bj < 2; ++bj)
#pragma unroll
                    for (int n = 0; n < 2; ++n) *(f32x4*)(C + off + bj * HALF + n * 16) = b[bj][n] + acc[ai][bj][m][n];
                if (m & 1) asm volatile("" ::: "memory"); }
    }
};
__device__ __forceinline__ float silu_mul(float g, float u) { return g * u * __builtin_amdgcn_rcpf(1.f + __expf(-g)); }
struct EpiSwiglu {
    static constexpr bool PERM = true, AFTER_DRAIN = false;
    bf16_t* H; int ldh;
    __device__ __forceinline__ void operator()(const f32x4 (&acc)[2][2][4][2], const Unit& u, int wr, int wc, int fr, int fq) const {
        const int row0 = u.pm * BM + wr * 64 + fr, col0 = u.pn * HALF + wc * 32 + 8 * fq;
#pragma unroll
        for (int ai = 0; ai < 2; ++ai)
#pragma unroll
            for (int m = 0; m < 4; ++m) { const f32x4 g0 = acc[ai][0][m][0], g1 = acc[ai][0][m][1], u0 = acc[ai][1][m][0], u1 = acc[ai][1][m][1];
                u32x4 w; w.x = cvt_pk_bf16(silu_mul(g0[0], u0[0]), silu_mul(g0[1], u0[1])); w.y = cvt_pk_bf16(silu_mul(g0[2], u0[2]), silu_mul(g0[3], u0[3]));
                w.z = cvt_pk_bf16(silu_mul(g1[0], u1[0]), silu_mul(g1[1], u1[1])); w.w = cvt_pk_bf16(silu_mul(g1[2], u1[2]), silu_mul(g1[3], u1[3]));
                *(u32x4*)(H + (size_t)(row0 + ai * HALF + m * 16) * ldh + col0) = w; }
    }
};
struct EpiScatter {
    static constexpr bool PERM = true, AFTER_DRAIN = false;
    const int* stok; const float* sw; bf16_t* Y; int ldy;
    __device__ __forceinline__ void operator()(const f32x4 (&acc)[2][2][4][2], const Unit& u, int wr, int wc, int fr, int fq) const {
        const int row0 = u.pm * BM + wr * 64 + fr, col0 = u.pn * BM + wc * 32 + 8 * fq;
#pragma unroll
        for (int ai = 0; ai < 2; ++ai)
#pragma unroll
            for (int m = 0; m < 4; ++m) { const int row = row0 + ai * HALF + m * 16; const int tk = stok[row]; const float s = sw[row];
                if (tk >= 0) { bf16_t* rowp = Y + (size_t)tk * ldy + col0;
#pragma unroll
                    for (int bj = 0; bj < 2; ++bj) { const f32x4 v0 = acc[ai][bj][m][0] * s, v1 = acc[ai][bj][m][1] * s;
                        u32x4 w; w.x = cvt_pk_bf16(v0[0], v0[1]); w.y = cvt_pk_bf16(v0[2], v0[3]); w.z = cvt_pk_bf16(v1[0], v1[1]); w.w = cvt_pk_bf16(v1[2], v1[3]);
                        *(u32x4*)(rowp + bj * HALF) = w; } } }
    }
};
struct StaticOrder {
    int nM, nN, nwg, G, c;
    __device__ void init(int M, int N, int G_, int c_) { nM = M / BM; nN = N / BM; nwg = nM * nN; G = G_; c = c_; }
    __device__ bool next(int i, Unit& u) const {
        const long L = (long)i * G + c; if (L >= nwg) return false;
        int wgid = (int)L; { const int q = nwg / NXCD, r = nwg % NXCD, xcd = wgid % NXCD, off = wgid / NXCD; wgid = (xcd < r ? xcd * (q + 1) : r * (q + 1) + (xcd - r) * q) + off; }
        const int nig = WGM * nN, gid = wgid / nig, fm = gid * WGM, gsz = (nM - fm) < WGM ? (nM - fm) : WGM;
        u.pm = fm + ((wgid % nig) % gsz); u.pn = (wgid % nig) / gsz; u.pb = u.pn; return true;
    }
    __device__ __forceinline__ void a_ready(const Unit&) const {}
    __device__ __forceinline__ void done(const Unit&) const {}
};
struct GroupedOrder {
    const PG8_LAS int* tile_e; int ntiles, nN, G, c;
    __device__ __forceinline__ bool next(int i, Unit& u) const { const int L = i * G + c; if (L >= ntiles * nN) return false; u.pm = L / nN; u.pn = L % nN; u.pb = tile_e[u.pm] * nN + u.pn; return true; }
    __device__ __forceinline__ void a_ready(const Unit&) const {}
    __device__ __forceinline__ void done(const Unit&) const {}
};
}

struct Frame {
    unsigned char* lds;
    unsigned* ctl;
    int tid, lane, wave, G, bid;
    const float *x, *g1, *w_in, *lq1, *lk1, *lq2, *lk2, *subg, *w_out, *g2, *wrg, *brg, *wre, *bre, *wg, *wu, *wd, *gf;
    float* out;
    unsigned char* ws;
};
using pg8::Unit;

struct DenseOrder {
    int nM, nN, G, c;
    __device__ __forceinline__ bool next(int i, Unit& u) const { const int L = i * G + c; if (L >= nM * nN) return false; u.pm = L / nN; u.pn = L % nN; u.pb = u.pn; return true; }
};
struct GroupedOrder {
    const int* tile_e; int ntiles, nN, G, c;
    __device__ __forceinline__ bool next(int i, Unit& u) const { const int L = i * G + c; if (L >= ntiles * nN) return false; u.pm = L / nN; u.pn = L % nN; u.pb = tile_e[u.pm] * nN + u.pn; return true; }
};

template <bool DUAL, class Sched, class Epi>
__device__ __forceinline__ void naive_gemm(Frame& F, const bf16* A, const bf16* Bt, int K, const Sched& S, const Epi& E) {
    float* As = (float*)F.lds; float* Bs = As + 32 * 68; float* Bs2 = Bs + 32 * 68;
    const int tid = F.tid, ty = tid >> 4, tx = tid & 15, lr = tid >> 3, lk = (tid & 7) * 4;
    Unit u;
    for (int i = 0; S.next(i, u); ++i) {
        for (int sm = 0; sm < 4; ++sm)
            for (int sn = 0; sn < (DUAL ? 2 : 4); ++sn) {
                float acc[2][4], acc2[2][4];
#pragma unroll
                for (int a = 0; a < 2; ++a)
#pragma unroll
                    for (int b = 0; b < 4; ++b) { acc[a][b] = 0.f; acc2[a][b] = 0.f; }
                const bf16* ap = A + (size_t)(256 * u.pm + 64 * sm + lr) * K + lk;
                const bf16* bp = Bt + (size_t)(256 * u.pb + 64 * sn + lr) * K + lk;
                for (int k0 = 0; k0 < K; k0 += 32) {
                    __syncthreads();
                    { const v2u w = *(const v2u*)(ap + k0); As[(lk + 0) * 68 + lr] = bflo(w.x); As[(lk + 1) * 68 + lr] = bfhi(w.x); As[(lk + 2) * 68 + lr] = bflo(w.y); As[(lk + 3) * 68 + lr] = bfhi(w.y); }
                    { const v2u w = *(const v2u*)(bp + k0); Bs[(lk + 0) * 68 + lr] = bflo(w.x); Bs[(lk + 1) * 68 + lr] = bfhi(w.x); Bs[(lk + 2) * 68 + lr] = bflo(w.y); Bs[(lk + 3) * 68 + lr] = bfhi(w.y); }
                    if (DUAL) { const v2u w = *(const v2u*)(bp + (size_t)128 * K + k0); Bs2[(lk + 0) * 68 + lr] = bflo(w.x); Bs2[(lk + 1) * 68 + lr] = bfhi(w.x); Bs2[(lk + 2) * 68 + lr] = bflo(w.y); Bs2[(lk + 3) * 68 + lr] = bfhi(w.y); }
                    __syncthreads();
#pragma unroll 8
                    for (int k = 0; k < 32; ++k) {
                        const float a0 = As[k * 68 + 2 * ty], a1 = As[k * 68 + 2 * ty + 1];
                        const f32x4 b = *(const f32x4*)(Bs + k * 68 + 4 * tx);
#pragma unroll
                        for (int j = 0; j < 4; ++j) { acc[0][j] += a0 * b[j]; acc[1][j] += a1 * b[j]; }
                        if (DUAL) { const f32x4 b2 = *(const f32x4*)(Bs2 + k * 68 + 4 * tx);
#pragma unroll
                            for (int j = 0; j < 4; ++j) { acc2[0][j] += a0 * b2[j]; acc2[1][j] += a1 * b2[j]; } }
                    }
                }
#pragma unroll
                for (int a = 0; a < 2; ++a)
#pragma unroll
                    for (int j = 0; j < 4; ++j) {
                        const int row = 256 * u.pm + 64 * sm + 2 * ty + a;
                        if (DUAL) E.elem(row, 128 * u.pn + 64 * sn + 4 * tx + j, silu_f(acc[a][j]) * acc2[a][j]);
                        else E.elem(row, 256 * u.pn + 64 * sn + 4 * tx + j, acc[a][j]);
                    }
            }
    }
    __syncthreads();
}
struct NEpiBf16 { bf16* O; int ldc; __device__ __forceinline__ void elem(int row, int col, float v) const { O[(size_t)row * ldc + col] = (bf16)f2bf(v); } };
struct NEpiResF32 { const float* base; float* O; int ldc; __device__ __forceinline__ void elem(int row, int col, float v) const { const size_t o = (size_t)row * ldc + col; O[o] = base[o] + v; } };
struct NEpiScatter { const int* stok; const float* sw; bf16* Y; __device__ __forceinline__ void elem(int row, int col, float v) const { const int tk = stok[row]; if (tk >= 0) Y[(size_t)tk * D + col] = (bf16)f2bf(v * sw[row]); } };

__device__ __forceinline__ void p0_transpose_item(const float* W, int K, int N, bf16* WT, int k0, int n0, int dstrow0, float scale, float* scr, int lane) {
#pragma unroll 8
    for (int i = 0; i < 32; ++i) { const int kk = 2 * i + (lane >> 5); scr[kk * 33 + (lane & 31)] = W[(size_t)(k0 + kk) * N + n0 + (lane & 31)] * scale; }
    LDS_WAIT(); asm volatile("" ::: "memory");
    const int c = lane & 7;
#pragma unroll
    for (int j = 0; j < 4; ++j) { const int n = (lane >> 3) + 8 * j; const float* s = scr + (8 * c) * 33 + n;
        v4u o; o.x = pk2(s[0 * 33], s[1 * 33]); o.y = pk2(s[2 * 33], s[3 * 33]); o.z = pk2(s[4 * 33], s[5 * 33]); o.w = pk2(s[6 * 33], s[7 * 33]);
        *(v4u*)(WT + (size_t)(dstrow0 + n) * K + k0 + 8 * c) = o; }
    LDS_WAIT(); asm volatile("" ::: "memory");
}
__device__ __forceinline__ void rms_row_to_bf16(const float* xrow, const float* g, bf16* orow, int lane) {
    const f32x4* xr = (const f32x4*)xrow + lane; const f32x4* gr = (const f32x4*)g + lane;
    f32x4 v[4]; float s = 0.f;
#pragma unroll
    for (int j = 0; j < 4; ++j) { v[j] = xr[64 * j]; s += (v[j].x * v[j].x + v[j].y * v[j].y) + (v[j].z * v[j].z + v[j].w * v[j].w); }
    const float rstd = 1.f / sqrtf(wave_sum(s) * (1.f / D) + EPS);
    unsigned long long* o8 = (unsigned long long*)orow + lane;
#pragma unroll
    for (int j = 0; j < 4; ++j) { const f32x4 gg = gr[64 * j];
        o8[64 * j] = (unsigned long long)pk2(v[j].x * rstd * gg.x, v[j].y * rstd * gg.y) | ((unsigned long long)pk2(v[j].z * rstd * gg.z, v[j].w * rstd * gg.w) << 32); }
}
__device__ __forceinline__ void p0_prologue(Frame& F) {
    float* scr = (float*)(F.lds + F.wave * 16384);
    const int gw = F.bid * NWAVES + F.wave, NGW = F.G * NWAVES;
    bf16* WinT = (bf16*)(F.ws + WS_WIN); bf16* WoutT = (bf16*)(F.ws + WS_WOUT); bf16* WguT = (bf16*)(F.ws + WS_WGU); bf16* WdT = (bf16*)(F.ws + WS_WD);
    constexpr int I_IN = 16 * 96, I_OUT = 16 * 32, I_E = 768, NITEMS = I_IN + I_OUT + NE * I_E;
    for (int it = gw; it < NITEMS; it += NGW) {
        int r = it;
        if (r < I_IN) { const int kb = r / 96, nb = r % 96, n0 = 32 * nb; const float sc = (n0 < C_KDA) ? C2 : ((n0 >= C_KR && n0 < C_VR) ? 0.125f : 1.f);
            p0_transpose_item(F.w_in, D, NIN, WinT, 64 * kb, n0, n0, sc, scr, F.lane); continue; }
        r -= I_IN;
        if (r < I_OUT) { const int kb = r / 32, nb = r % 32; p0_transpose_item(F.w_out, D, D, WoutT, 64 * kb, 32 * nb, 32 * nb, 1.f, scr, F.lane); continue; }
        r -= I_OUT;
        const int e = r / I_E; r %= I_E;
        if (r < 256) { const int kb = r / 16, nb = r % 16, n0 = 32 * nb; p0_transpose_item(F.wg + (size_t)e * D * HIDN, D, HIDN, WguT + (size_t)e * 1024 * D, 64 * kb, n0, 256 * (n0 >> 7) + (n0 & 127), 1.f, scr, F.lane); continue; }
        r -= 256;
        if (r < 256) { const int kb = r / 16, nb = r % 16, n0 = 32 * nb; p0_transpose_item(F.wu + (size_t)e * D * HIDN, D, HIDN, WguT + (size_t)e * 1024 * D, 64 * kb, n0, 256 * (n0 >> 7) + 128 + (n0 & 127), 1.f, scr, F.lane); continue; }
        r -= 256;
        { const int kb = r / 32, nb = r % 32; p0_transpose_item(F.wd + (size_t)e * HIDN * D, HIDN, D, WdT + (size_t)e * D * HIDN, 64 * kb, 32 * nb, 32 * nb, 1.f, scr, F.lane); }
    }
    float* WrT = (float*)(F.ws + WS_WRT);
    for (int i = F.bid * 512 + F.tid; i < NRT * D; i += F.G * 512) { const int c = i / D, k = i % D; WrT[i] = (c < 4) ? F.wrg[k * 4 + c] : F.wre[k * 32 + (c - 4)]; }
    bf16* XN1 = (bf16*)(F.ws + WS_A);
    for (int m = gw; m < T; m += NGW) rms_row_to_bf16(F.x + (size_t)m * D, F.g1, XN1 + (size_t)m * D, F.lane);
}

__device__ __forceinline__ float dot8(const v4u a, const v4u b) {
    return (bflo(a.x) * bflo(b.x) + bfhi(a.x) * bfhi(b.x)) + (bflo(a.y) * bflo(b.y) + bfhi(a.y) * bfhi(b.y)) + (bflo(a.z) * bflo(b.z) + bfhi(a.z) * bfhi(b.z)) + (bflo(a.w) * bflo(b.w) + bfhi(a.w) * bfhi(b.w));
}
__device__ __forceinline__ void naive_attn_unit(Frame& F, int h, int c, float lam, float slope2) {
    constexpr int QS = 136;
    bf16* Qs = (bf16*)F.lds; bf16* Ks = Qs + 64 * QS; float* Vs = (float*)(Ks + 64 * QS); float* Ps = Vs + 64 * 128;
    const bf16* PROJ = (const bf16*)(F.ws + WS_PROJ);
    const int tid = F.tid, q = tid >> 3, sub = tid & 7;
    const int qpos = 64 * c + q;
    __syncthreads();
    { const v4u* src = (const v4u*)(PROJ + (size_t)(64 * c + q) * NIN + C_QDA + h * 128 + sub * 16); v4u* dst = (v4u*)(Qs + q * QS + sub * 16); dst[0] = src[0]; dst[1] = src[1]; }
    float m0 = -1e30f, m1 = -1e30f, l0 = 0.f, l1 = 0.f, o0[16], o1[16];
#pragma unroll
    for (int i = 0; i < 16; ++i) { o0[i] = 0.f; o1[i] = 0.f; }
    for (int j = 0; j <= c; ++j) {
        __syncthreads();
        { const size_t row = (size_t)(64 * j + q) * NIN;
          const v4u* ks = (const v4u*)(PROJ + row + C_KDA + h * 128 + sub * 16); v4u* kd = (v4u*)(Ks + q * QS + sub * 16); kd[0] = ks[0]; kd[1] = ks[1];
          const v4u* vs = (const v4u*)(PROJ + row + C_VDA + h * 128 + sub * 16); const v4u a = vs[0], b = vs[1]; float* vd = Vs + q * 128 + sub * 16;
          vd[0] = bflo(a.x); vd[1] = bfhi(a.x); vd[2] = bflo(a.y); vd[3] = bfhi(a.y); vd[4] = bflo(a.z); vd[5] = bfhi(a.z); vd[6] = bflo(a.w); vd[7] = bfhi(a.w);
          vd[8] = bflo(b.x); vd[9] = bfhi(b.x); vd[10] = bflo(b.y); vd[11] = bfhi(b.y); vd[12] = bflo(b.z); vd[13] = bfhi(b.z); vd[14] = bflo(b.w); vd[15] = bfhi(b.w); }
        __syncthreads();
        float s0[8], s1[8];
#pragma unroll
        for (int kk = 0; kk < 8; ++kk) { s0[kk] = 0.f; s1[kk] = 0.f; }
#pragma unroll 1
        for (int d8 = 0; d8 < 8; ++d8) {
            const v4u qa = *(const v4u*)(Qs + q * QS + d8 * 8), qb = *(const v4u*)(Qs + q * QS + 64 + d8 * 8);
#pragma unroll
            for (int kk = 0; kk < 8; ++kk) { const int k = sub + 8 * kk;
                s0[kk] += dot8(qa, *(const v4u*)(Ks + k * QS + d8 * 8));
                if ((kk & 1) == 1) asm volatile("" ::: "memory"); }
#pragma unroll
            for (int kk = 0; kk < 8; ++kk) { const int k = sub + 8 * kk;
                s1[kk] += dot8(qb, *(const v4u*)(Ks + k * QS + 64 + d8 * 8));
                if ((kk & 1) == 1) asm volatile("" ::: "memory"); }
        }
#pragma unroll
        for (int kk = 0; kk < 8; ++kk) { const float dist = fabsf((float)(qpos - (64 * j + sub + 8 * kk))); s0[kk] -= slope2 * dist; s1[kk] -= slope2 * dist; }
        float t0 = s0[0], t1 = s1[0];
#pragma unroll
        for (int kk = 1; kk < 8; ++kk) { t0 = fmaxf(t0, s0[kk]); t1 = fmaxf(t1, s1[kk]); }
#pragma unroll
        for (int o = 1; o < 8; o <<= 1) { t0 = fmaxf(t0, __shfl_xor(t0, o)); t1 = fmaxf(t1, __shfl_xor(t1, o)); }
        const float mn0 = fmaxf(m0, t0), mn1 = fmaxf(m1, t1), al0 = exp2f(m0 - mn0), al1 = exp2f(m1 - mn1);
        m0 = mn0; m1 = mn1;
        float ps0 = 0.f, ps1 = 0.f;
#pragma unroll
        for (int kk = 0; kk < 8; ++kk) { const int k = sub + 8 * kk; const float p0 = exp2f(s0[kk] - mn0), p1 = exp2f(s1[kk] - mn1); ps0 += p0; ps1 += p1; Ps[q * 65 + k] = p0; Ps[64 * 65 + q * 65 + k] = p1; }
#pragma unroll
        for (int o = 1; o < 8; o <<= 1) { ps0 += __shfl_xor(ps0, o); ps1 += __shfl_xor(ps1, o); }
        l0 = l0 * al0 + ps0; l1 = l1 * al1 + ps1;
#pragma unroll
        for (int i = 0; i < 16; ++i) { o0[i] *= al0; o1[i] *= al1; }
        __syncthreads();
#pragma unroll 1
        for (int k = 0; k < 64; ++k) {
            const float p0 = Ps[q * 65 + k], p1 = Ps[64 * 65 + q * 65 + k];
            const float* vr = Vs + k * 128 + sub * 16;
#pragma unroll
            for (int i4 = 0; i4 < 4; ++i4) { const f32x4 v = *(const f32x4*)(vr + 4 * i4);
#pragma unroll
                for (int e = 0; e < 4; ++e) { o0[4 * i4 + e] += p0 * v[e]; o1[4 * i4 + e] += p1 * v[e]; } }
        }
    }
    const float r0 = 1.f / l0, r1 = lam / l1; float dv[16], ss = 0.f;
#pragma unroll
    for (int i = 0; i < 16; ++i) { dv[i] = o0[i] * r0 - o1[i] * r1; ss += dv[i] * dv[i]; }
#pragma unroll
    for (int o = 1; o < 8; o <<= 1) ss += __shfl_xor(ss, o);
    const float rstd = 1.f / sqrtf(ss * (1.f / 128.f) + EPS) * (1.f - LAMBDA_INIT);
    bf16* MIX = (bf16*)(F.ws + WS_A);
    unsigned w[8];
#pragma unroll
    for (int i = 0; i < 8; ++i) w[i] = pk2(dv[2 * i] * rstd * F.subg[sub * 16 + 2 * i], dv[2 * i + 1] * rstd * F.subg[sub * 16 + 2 * i + 1]);
    v4u* dst = (v4u*)(MIX + (size_t)qpos * D + h * 128 + sub * 16);
    dst[0] = (v4u){w[0], w[1], w[2], w[3]}; dst[1] = (v4u){w[4], w[5], w[6], w[7]};
}
namespace da {
using bf16x8 = __attribute__((ext_vector_type(8))) short;
using s16x4  = __attribute__((ext_vector_type(4))) short;
using f32x16 = __attribute__((ext_vector_type(16))) float;
using u32x4  = __attribute__((ext_vector_type(4))) unsigned;
constexpr int KVBLK = 64;
constexpr int SHM_V = KVBLK * 128 * 2, SHM_K = KVBLK * 128 * 2;
constexpr float THR = 8.f;
#ifndef DA_SDEPTH
#define DA_SDEPTH 1
#endif
#define DA_KSWZ(row, colB) ((row) * 256 + ((colB) ^ (((row) & 7) << 4)))
#define DA_SBAR() __builtin_amdgcn_sched_barrier(0)
__device__ __forceinline__ int crow(int r, int hi) { return (r & 3) + 8 * (r >> 2) + 4 * hi; }
__device__ __forceinline__ unsigned cvtpk(float lo, float hi) { unsigned r; asm volatile("v_cvt_pk_bf16_f32 %0, %1, %2" : "=v"(r) : "v"(lo), "v"(hi)); return r; }
__device__ __forceinline__ void partialSM(f32x16& p0, f32x16& p1, float& m_reg, float& mn, float& alpha, float dq, float nslope2, bool masked) {
#pragma unroll
  for (int r = 0; r < 16; ++r) { const float c = (float)((r & 3) + 8 * (r >> 2)); p0[r] = fmaf(nslope2, fabsf(dq - c), p0[r]); p1[r] = fmaf(nslope2, fabsf(dq - 32.f - c), p1[r]); }
  if (masked) {
#pragma unroll
    for (int r = 0; r < 16; ++r) { p0[r] = -INFINITY; p1[r] = -INFINITY; } }
  float pmax = p0[0];
#pragma unroll
  for (int r = 1; r < 16; ++r) pmax = fmaxf(pmax, p0[r]);
#pragma unroll
  for (int r = 0; r < 16; ++r) pmax = fmaxf(pmax, p1[r]);
  { auto rr = __builtin_amdgcn_permlane32_swap(__float_as_uint(pmax), __float_as_uint(pmax), false, false);
    pmax = fmaxf(__uint_as_float(rr[0]), __uint_as_float(rr[1])); }
  if (__builtin_expect(__all(pmax - m_reg <= THR), 1)) { mn = m_reg; alpha = 1.f; }
  else { mn = fmaxf(m_reg, pmax); alpha = __builtin_amdgcn_exp2f(m_reg - mn); m_reg = mn; }
#pragma unroll
  for (int r = 0; r < 16; ++r) { p0[r] -= mn; p1[r] -= mn; }
#pragma unroll
  for (int r = 0; r < 16; ++r) p0[r] = __builtin_amdgcn_exp2f(p0[r]);
}
__device__ __forceinline__ void finishSM(f32x16& p0, f32x16& p1, float alpha, float& l_reg, bf16x8& pa0, bf16x8& pa1, bf16x8& pa2, bf16x8& pa3) {
#pragma unroll
  for (int r = 0; r < 16; ++r) p1[r] = __builtin_amdgcn_exp2f(p1[r]);
  float ps = 0;
#pragma unroll
  for (int r = 0; r < 16; ++r) ps += p0[r];
#pragma unroll
  for (int r = 0; r < 16; ++r) ps += p1[r];
  { auto rr = __builtin_amdgcn_permlane32_swap(__float_as_uint(ps), __float_as_uint(ps), false, false);
    ps = __uint_as_float(rr[0]) + __uint_as_float(rr[1]); }
  l_reg = l_reg * alpha + ps;
#define DA_PK4(P, BASE, OUT) do { unsigned a0 = cvtpk(P[BASE + 0], P[BASE + 1]), a1 = cvtpk(P[BASE + 2], P[BASE + 3]);   \
    unsigned b0 = cvtpk(P[BASE + 4], P[BASE + 5]), b1 = cvtpk(P[BASE + 6], P[BASE + 7]);                              \
    auto r0 = __builtin_amdgcn_permlane32_swap(a0, b0, false, false); auto r1 = __builtin_amdgcn_permlane32_swap(a1, b1, false, false); \
    u32x4 w = {r0[0], r1[0], r0[1], r1[1]}; OUT = *reinterpret_cast<bf16x8*>(&w); } while (0)
  DA_PK4(p0, 0, pa0); DA_PK4(p0, 8, pa1); DA_PK4(p1, 0, pa2); DA_PK4(p1, 8, pa3);
#undef DA_PK4
}
__device__ __forceinline__ void qkt(f32x16& p0, f32x16& p1, const char* Ks, const bf16x8* qr, int r32, int hi, int mp) {
  p0 = f32x16{}; p1 = f32x16{};
#pragma unroll
  for (int d0 = 0; d0 < 4; ++d0) { const int cb = (mp * 64 + d0 * 16 + hi * 8) * 2;
    const bf16x8 b0 = *reinterpret_cast<const bf16x8*>(Ks + DA_KSWZ(r32, cb));
    const bf16x8 b1 = *reinterpret_cast<const bf16x8*>(Ks + DA_KSWZ(32 + r32, cb));
    p0 = __builtin_amdgcn_mfma_f32_32x32x16_bf16(b0, qr[d0], p0, 0, 0, 0);
    p1 = __builtin_amdgcn_mfma_f32_32x32x16_bf16(b1, qr[d0], p1, 0, 0, 0); }
}
__device__ __forceinline__ int v_st(int k, int c) { const int kk = (k & ~0xC) | ((k & 4) << 1) | ((k & 8) >> 1); return ((kk >> 3) * 4 + (c >> 5)) * 512 + ((kk & 7) * 32 + (c & 31)) * 2; }
__device__ __forceinline__ int v_rd_base(int lane) { return ((lane & 3) << 3) | (((lane >> 2) & 3) << 6) | (((lane >> 4) & 1) << 5) | (((lane >> 5) & 1) << 8); }
constexpr int v_rd_off(int d0, int ks, int half) { return d0 * 512 + ks * 4096 + half * 2048; }
template <int OFF> __device__ __forceinline__ s16x4 tr_read(int vb) {
  s16x4 r; asm volatile("ds_read_b64_tr_b16 %0, %1 offset:%2" : "=&v"(r) : "v"(vb), "i"(OFF) : "memory"); return r;
}
template <int D0> __device__ __forceinline__ void pv_one(f32x16& od, int vb, bf16x8 pa0, bf16x8 pa1, bf16x8 pa2, bf16x8 pa3) {
  const s16x4 l0 = tr_read<v_rd_off(D0, 0, 0)>(vb), h0 = tr_read<v_rd_off(D0, 0, 1)>(vb), l1 = tr_read<v_rd_off(D0, 1, 0)>(vb), h1 = tr_read<v_rd_off(D0, 1, 1)>(vb);
  const s16x4 l2 = tr_read<v_rd_off(D0, 2, 0)>(vb), h2 = tr_read<v_rd_off(D0, 2, 1)>(vb), l3 = tr_read<v_rd_off(D0, 3, 0)>(vb), h3 = tr_read<v_rd_off(D0, 3, 1)>(vb);
  asm volatile("s_waitcnt lgkmcnt(0)" ::: "memory"); DA_SBAR();
#define DA_PK(L, H) (bf16x8){L[0], L[1], L[2], L[3], H[0], H[1], H[2], H[3]}
  od = __builtin_amdgcn_mfma_f32_32x32x16_bf16(pa0, DA_PK(l0, h0), od, 0, 0, 0);
  od = __builtin_amdgcn_mfma_f32_32x32x16_bf16(pa1, DA_PK(l1, h1), od, 0, 0, 0);
  od = __builtin_amdgcn_mfma_f32_32x32x16_bf16(pa2, DA_PK(l2, h2), od, 0, 0, 0);
  od = __builtin_amdgcn_mfma_f32_32x32x16_bf16(pa3, DA_PK(l3, h3), od, 0, 0, 0);
#undef DA_PK
}
__device__ __forceinline__ void pv_d0(f32x16* o, int vb, bf16x8 pa0, bf16x8 pa1, bf16x8 pa2, bf16x8 pa3) {
  pv_one<0>(o[0], vb, pa0, pa1, pa2, pa3); pv_one<1>(o[1], vb, pa0, pa1, pa2, pa3); pv_one<2>(o[2], vb, pa0, pa1, pa2, pa3); pv_one<3>(o[3], vb, pa0, pa1, pa2, pa3);
}
__device__ __forceinline__ void attn_unit(const unsigned short* __restrict__ PROJ, unsigned short* __restrict__ MIX, const float* __restrict__ subg, int h, int u, float lam, float slope2, char* lds) {
  const int tid = threadIdx.x, wid = __builtin_amdgcn_readfirstlane(tid >> 6), lane = tid & 63, r32 = lane & 31, hi = lane >> 5, rg = wid & 3, mp = wid >> 2;
  const int q0 = 128 * u, NT = 2 * u + 2;
  constexpr long LDK = NIN;
  const char* kbase = (const char*)(PROJ + C_KDA + h * 128);
  char* V_lds = lds; char* K_lds = lds + 2 * SHM_V;
  float* ws = (float*)(lds + 2 * SHM_V + 2 * SHM_K) + wid * 64; float* li_l = ws; float* al_l = ws + 32;
  float m_reg = -1e30f, l_reg = 0; f32x16 o[4] = {}; bf16x8 qr[4];
  const int qpos = q0 + 32 * rg + r32;
  { const char* qb = (const char*)PROJ + ((size_t)(q0 + 32 * rg) * LDK + C_QDA + h * 128 + mp * 64) * 2;
    const unsigned qo = (unsigned)((r32 * (int)LDK + hi * 8) * 2);
#pragma unroll
    for (int d0 = 0; d0 < 4; ++d0) qr[d0] = *reinterpret_cast<const bf16x8*>(qb + qo + d0 * 32); }
  const float nslope2 = -slope2; const bool mask0 = rg < 2;
  const int sr = tid >> 4, sc = (tid & 15) * 8, vst0 = v_st(sr, sc), vst1 = v_st(32 + sr, sc);
  const unsigned voff = (unsigned)((sr * (int)LDK + sc) * 2);
  const int vb0 = (int)(uintptr_t)V_lds + v_rd_base(lane);
  struct { bf16x8 vs0, vs1, ks0, ks1; } sr_[DA_SDEPTH];
#define KOFF(jj) ((NT - 1 - (jj)) * KVBLK)
#define DQ(jj) ((float)(qpos - KOFF(jj) - 4 * hi))
#define SLOAD(i, k0) do { const char* tb_ = kbase + (size_t)(k0) * (size_t)(LDK * 2); \
    sr_[i].ks0 = *reinterpret_cast<const bf16x8*>(tb_ + voff); sr_[i].ks1 = *reinterpret_cast<const bf16x8*>(tb_ + 32 * LDK * 2 + voff); \
    sr_[i].vs0 = *reinterpret_cast<const bf16x8*>(tb_ + (C_VDA - C_KDA) * 2 + voff); sr_[i].vs1 = *reinterpret_cast<const bf16x8*>(tb_ + 32 * LDK * 2 + (C_VDA - C_KDA) * 2 + voff); } while (0)
#define SWRITE(b, i) do { *(bf16x8*)(V_lds + (b) * SHM_V + vst0) = sr_[i].vs0; *(bf16x8*)(V_lds + (b) * SHM_V + vst1) = sr_[i].vs1; const int kc = sc * 2;               \
    *(bf16x8*)(K_lds + (b) * SHM_K + DA_KSWZ(sr, kc)) = sr_[i].ks0; *(bf16x8*)(K_lds + (b) * SHM_K + DA_KSWZ(32 + sr, kc)) = sr_[i].ks1; } while (0)
#define SWAIT() do { if (DA_SDEPTH == 2) asm volatile("s_waitcnt vmcnt(4)" ::: "memory"); else asm volatile("s_waitcnt vmcnt(0)" ::: "memory"); } while (0)
#define RESC(a) do { if (__any((a) < 1.f)) { if (hi == 0) al_l[r32] = (a); asm volatile("s_waitcnt lgkmcnt(0)" ::: "memory"); \
    _Pragma("unroll") for (int d = 0; d < 4; ++d) _Pragma("unroll") for (int r = 0; r < 16; ++r) o[d][r] *= al_l[crow(r, hi)]; } } while (0)
  f32x16 pA0, pA1, pB0, pB1; float mnA, mnB, alA, alB; bf16x8 pa0, pa1, pa2, pa3;
  constexpr int SE = 0, SO = DA_SDEPTH - 1;
  __syncthreads();
  SLOAD(SE, KOFF(0)); asm volatile("s_waitcnt vmcnt(0)" ::: "memory"); SWRITE(0, SE); __syncthreads();
  qkt(pA0, pA1, K_lds, qr, r32, hi, mp); partialSM(pA0, pA1, m_reg, mnA, alA, DQ(0), nslope2, mask0);
  SLOAD(SO, KOFF(1)); if (DA_SDEPTH == 2) { if (2 < NT) SLOAD(SE, KOFF(2)); }
  SWAIT(); SWRITE(1, SO); __syncthreads();
  for (int j = 1; j + 1 < NT; j += 2) {
    DA_SBAR(); qkt(pB0, pB1, K_lds + SHM_K, qr, r32, hi, mp);
    finishSM(pA0, pA1, alA, l_reg, pa0, pa1, pa2, pa3); DA_SBAR();
    SLOAD(SO, KOFF(j + DA_SDEPTH)); DA_SBAR();
    pv_d0(o, vb0, pa0, pa1, pa2, pa3); partialSM(pB0, pB1, m_reg, mnB, alB, DQ(j), nslope2, false);
    __syncthreads(); SWAIT(); SWRITE(0, SE);
    RESC(alB); __syncthreads();
    DA_SBAR(); qkt(pA0, pA1, K_lds, qr, r32, hi, mp);
    finishSM(pB0, pB1, alB, l_reg, pa0, pa1, pa2, pa3); DA_SBAR();
    if (DA_SDEPTH == 1 || j + 3 < NT) SLOAD(SE, KOFF(j + 1 + DA_SDEPTH)); DA_SBAR();
    pv_d0(o, vb0 + SHM_V, pa0, pa1, pa2, pa3); partialSM(pA0, pA1, m_reg, mnA, alA, DQ(j + 1), nslope2, false);
    __syncthreads(); SWAIT(); SWRITE(1, SO);
    RESC(alA); __syncthreads();
  }
  DA_SBAR(); qkt(pB0, pB1, K_lds + SHM_K, qr, r32, hi, mp);
  finishSM(pA0, pA1, alA, l_reg, pa0, pa1, pa2, pa3); DA_SBAR();
  pv_d0(o, vb0, pa0, pa1, pa2, pa3); partialSM(pB0, pB1, m_reg, mnB, alB, DQ(NT - 1), nslope2, false);
  __syncthreads(); RESC(alB);
  finishSM(pB0, pB1, alB, l_reg, pa0, pa1, pa2, pa3); DA_SBAR();
  pv_d0(o, vb0 + SHM_V, pa0, pa1, pa2, pa3);
  if (hi == 0) li_l[r32] = l_reg; asm volatile("s_waitcnt lgkmcnt(0)" ::: "memory");
  float rli[16];
#pragma unroll
  for (int r = 0; r < 16; ++r) rli[r] = (mp ? lam : 1.f) * __builtin_amdgcn_rcpf(li_l[crow(r, hi)]);
  __syncthreads();
  int hi2 = hi, c32 = r32; asm volatile("" : "+v"(hi2), "+v"(c32));
  float* X1 = (float*)lds + (rg * 32) * 128;
  if (mp == 1) {
#pragma unroll
    for (int r = 0; r < 16; ++r)
#pragma unroll
      for (int d0 = 0; d0 < 4; ++d0) X1[crow(r, hi2) * 128 + d0 * 32 + c32] = o[d0][r] * rli[r];
  }
  __syncthreads();
  if (mp == 0) {
    float ss[16];
#pragma unroll
    for (int r = 0; r < 16; ++r) { float s = 0.f;
#pragma unroll
      for (int d0 = 0; d0 < 4; ++d0) { const float dv = o[d0][r] * rli[r] - X1[crow(r, hi2) * 128 + d0 * 32 + c32]; o[d0][r] = dv; s += dv * dv; }
      ss[r] = s; }
#pragma unroll
    for (int r = 0; r < 16; ++r) {
#pragma unroll
      for (int off = 1; off < 32; off <<= 1) ss[r] += __shfl_xor(ss[r], off);
      ss[r] = (1.f - LAMBDA_INIT) / sqrtf(ss[r] * (1.f / 128.f) + EPS); }
    float gsub[4];
#pragma unroll
    for (int d0 = 0; d0 < 4; ++d0) gsub[d0] = subg[d0 * 32 + c32];
    char* Ow = (char*)MIX + ((size_t)(q0 + 32 * rg) * D + h * 128) * 2;
#pragma unroll
    for (int r = 0; r < 16; ++r) { const unsigned oo = (unsigned)((crow(r, hi2) * D + c32) * 2);
#pragma unroll
      for (int d0 = 0; d0 < 4; ++d0) *(unsigned short*)(Ow + oo + d0 * 64) = (unsigned short)f2bf(o[d0][r] * ss[r] * gsub[d0]); }
  }
#undef KOFF
#undef DQ
#undef SLOAD
#undef SWRITE
#undef SWAIT
#undef RESC
}
}

__device__ __forceinline__ void p2_attention(Frame& F) {
    float a = 0.f, b = 0.f;
#pragma unroll 1
    for (int i = 0; i < 64; ++i) { a += F.lq1[i] * F.lk1[i]; b += F.lq2[i] * F.lk2[i]; }
    const float lam = __expf(a) - __expf(b) + LAMBDA_INIT;
#if USE_MFMA & 16
    const int vcu = (F.G % 8 == 0) ? (F.bid % 8) * (F.G / 8) + F.bid / 8 : F.bid;
    for (int p = vcu; p < 256; p += F.G) {
        const int h = p >> 6, s = p & 63;
        const float slope2 = exp2f(-2.f * (float)(h + 1)) * LOG2E;
#pragma unroll 1
        for (int rep = 0; rep < 2; ++rep) da::attn_unit((const bf16*)(F.ws + WS_PROJ), (bf16*)(F.ws + WS_A), F.subg, h, rep ? 127 - s : s, lam, slope2, (char*)F.lds);
    }
    __syncthreads();
#else
    for (int u = F.bid; u < 512; u += F.G) {
        const int h = u >> 7, s = u & 127;
        const float slope2 = exp2f(-2.f * (float)(h + 1)) * LOG2E;
#pragma unroll 1
        for (int rep = 0; rep < 2; ++rep) naive_attn_unit(F, h, rep ? 255 - s : s, lam, slope2);
    }
#endif
}

__device__ __forceinline__ float ret_lg(int h) { return log1pf(-exp2f(-5.f - (float)h)); }
__device__ __forceinline__ void p3_ret_kv(Frame& F) {
    float* Ks = (float*)F.lds; float* Vs = Ks + 64 * 64;
    const bf16* PROJ = (const bf16*)(F.ws + WS_PROJ); float* KV = F.out;
    const int tid = F.tid, r = tid >> 3, sub = tid & 7;
    for (int u = F.bid; u < 1024; u += F.G) {
        const int n = u >> 2, h = u & 3; const float lg = ret_lg(h);
        __syncthreads();
        { const size_t row = (size_t)(64 * n + r) * NIN; const float w = __expf(lg * (float)(63 - r));
          const v4u a = *(const v4u*)(PROJ + row + C_KR + h * 64 + sub * 8); float* kd = Ks + r * 64 + sub * 8;
          kd[0] = bflo(a.x) * w; kd[1] = bfhi(a.x) * w; kd[2] = bflo(a.y) * w; kd[3] = bfhi(a.y) * w; kd[4] = bflo(a.z) * w; kd[5] = bfhi(a.z) * w; kd[6] = bflo(a.w) * w; kd[7] = bfhi(a.w) * w;
          const v4u* vs = (const v4u*)(PROJ + row + C_VR + h * 128 + sub * 16); const v4u b = vs[0], c = vs[1]; float* vd = Vs + r * 128 + sub * 16;
          vd[0] = bflo(b.x); vd[1] = bfhi(b.x); vd[2] = bflo(b.y); vd[3] = bfhi(b.y); vd[4] = bflo(b.z); vd[5] = bfhi(b.z); vd[6] = bflo(b.w); vd[7] = bfhi(b.w);
          vd[8] = bflo(c.x); vd[9] = bfhi(c.x); vd[10] = bflo(c.y); vd[11] = bfhi(c.y); vd[12] = bflo(c.z); vd[13] = bfhi(c.z); vd[14] = bflo(c.w); vd[15] = bfhi(c.w); }
        __syncthreads();
        float acc[16];
#pragma unroll
        for (int i = 0; i < 16; ++i) acc[i] = 0.f;
        const int d = r;
        for (int s = 0; s < 64; ++s) { const float kv = Ks[s * 64 + d]; const float* vr = Vs + s * 128 + sub * 16;
#pragma unroll
            for (int i = 0; i < 16; ++i) acc[i] += kv * vr[i]; }
        float* dst = KV + ((size_t)(n * 4 + h) * 64 + d) * 128 + sub * 16;
#pragma unroll
        for (int i = 0; i < 16; ++i) dst[i] = acc[i];
    }
}
__device__ __forceinline__ void p4_ret_scan(Frame& F) {
    const float* KV = F.out; float* SP = F.out + (size_t)8 * 1024 * 1024;
    const int gid = F.bid * 512 + F.tid;
    if (gid < 32768) {
        const int h = gid >> 13; const float dec = __expf(ret_lg(h) * 64.f);
        float st = 0.f;
        for (int n = 0; n < 256; ++n) { const size_t o = (size_t)n * 32768 + gid; SP[o] = st; st = st * dec + KV[o]; }
    }
}
__device__ __forceinline__ void p5_ret_out(Frame& F) {
    float* Qs = (float*)F.lds; float* Ks = Qs + 64 * 65; float* Vs = Ks + 64 * 65; float* Ss = Vs + 64 * 128; float* Ps = Ss + 64 * 128;
    const bf16* PROJ = (const bf16*)(F.ws + WS_PROJ); const float* SP = F.out + (size_t)8 * 1024 * 1024; bf16* MIX = (bf16*)(F.ws + WS_A);
    const int tid = F.tid, r = tid >> 3, sub = tid & 7;
    for (int u = F.bid; u < 1024; u += F.G) {
        const int n = u >> 2, h = u & 3; const float lg = ret_lg(h);
        __syncthreads();
        { const size_t row = (size_t)(64 * n + r) * NIN;
          const v4u a = *(const v4u*)(PROJ + row + C_QR + h * 64 + sub * 8); float* qd = Qs + r * 65 + sub * 8;
          qd[0] = bflo(a.x); qd[1] = bfhi(a.x); qd[2] = bflo(a.y); qd[3] = bfhi(a.y); qd[4] = bflo(a.z); qd[5] = bfhi(a.z); qd[6] = bflo(a.w); qd[7] = bfhi(a.w);
          const v4u k = *(const v4u*)(PROJ + row + C_KR + h * 64 + sub * 8); float* kd = Ks + r * 65 + sub * 8;
          kd[0] = bflo(k.x); kd[1] = bfhi(k.x); kd[2] = bflo(k.y); kd[3] = bfhi(k.y); kd[4] = bflo(k.z); kd[5] = bfhi(k.z); kd[6] = bflo(k.w); kd[7] = bfhi(k.w);
          const v4u* vs = (const v4u*)(PROJ + row + C_VR + h * 128 + sub * 16); const v4u b = vs[0], c = vs[1]; float* vd = Vs + r * 128 + sub * 16;
          vd[0] = bflo(b.x); vd[1] = bfhi(b.x); vd[2] = bflo(b.y); vd[3] = bfhi(b.y); vd[4] = bflo(b.z); vd[5] = bfhi(b.z); vd[6] = bflo(b.w); vd[7] = bfhi(b.w);
          vd[8] = bflo(c.x); vd[9] = bfhi(c.x); vd[10] = bflo(c.y); vd[11] = bfhi(c.y); vd[12] = bflo(c.z); vd[13] = bfhi(c.z); vd[14] = bflo(c.w); vd[15] = bfhi(c.w);
          const float* sp = SP + ((size_t)(n * 4 + h) * 64 + r) * 128 + sub * 16; float* sd = Ss + r * 128 + sub * 16;
#pragma unroll
          for (int i = 0; i < 16; ++i) sd[i] = sp[i]; }
        __syncthreads();
#pragma unroll 1
        for (int jj = 0; jj < 8; ++jj) { const int j = sub + 8 * jj; float s = 0.f;
#pragma unroll 8
            for (int d = 0; d < 64; ++d) s += Qs[r * 65 + d] * Ks[j * 65 + d];
            Ps[r * 65 + j] = (j <= r) ? s * __expf(lg * (float)(r - j)) : 0.f; }
        __syncthreads();
        float acc[16];
#pragma unroll
        for (int i = 0; i < 16; ++i) acc[i] = 0.f;
#pragma unroll 2
        for (int j = 0; j < 64; ++j) { const float p = Ps[r * 65 + j]; const float* vr = Vs + j * 128 + sub * 16;
#pragma unroll
            for (int i = 0; i < 16; ++i) acc[i] += p * vr[i]; }
        const float qd = __expf(lg * (float)(r + 1));
#pragma unroll 2
        for (int d = 0; d < 64; ++d) { const float qv = Qs[r * 65 + d] * qd; const float* sr = Ss + d * 128 + sub * 16;
#pragma unroll
            for (int i = 0; i < 16; ++i) acc[i] += qv * sr[i]; }
        float ss = 0.f;
#pragma unroll
        for (int i = 0; i < 16; ++i) ss += acc[i] * acc[i];
#pragma unroll
        for (int o = 1; o < 8; o <<= 1) ss += __shfl_xor(ss, o);
        const float rstd = 1.f / sqrtf(ss * (1.f / 128.f) + EPS);
        const size_t row = (size_t)(64 * n + r);
        const v4u* gs = (const v4u*)(PROJ + row * NIN + C_GR + h * 128 + sub * 16); const v4u ga = gs[0], gb = gs[1];
        const float gv[16] = {bflo(ga.x), bfhi(ga.x), bflo(ga.y), bfhi(ga.y), bflo(ga.z), bfhi(ga.z), bflo(ga.w), bfhi(ga.w), bflo(gb.x), bfhi(gb.x), bflo(gb.y), bfhi(gb.y), bflo(gb.z), bfhi(gb.z), bflo(gb.w), bfhi(gb.w)};
        unsigned w[8];
#pragma unroll
        for (int i = 0; i < 8; ++i) w[i] = pk2(silu_f(gv[2 * i]) * acc[2 * i] * rstd, silu_f(gv[2 * i + 1]) * acc[2 * i + 1] * rstd);
        v4u* dst = (v4u*)(MIX + row * D + 512 + h * 128 + sub * 16);
        dst[0] = (v4u){w[0], w[1], w[2], w[3]}; dst[1] = (v4u){w[4], w[5], w[6], w[7]};
    }
}

__device__ __forceinline__ void p7_route(Frame& F) {
    const float* H = F.out; bf16* XN2 = (bf16*)(F.ws + WS_A); const float* WrT = (const float*)(F.ws + WS_WRT);
    int* tok_e = (int*)(F.ws + WS_TOK + TK_E); int* tok_pos = (int*)(F.ws + WS_TOK + TK_POS); float* tok_w = (float*)(F.ws + WS_TOK + TK_W);
    const int gw = F.bid * NWAVES + F.wave, NGW = F.G * NWAVES, lane = F.lane;
    for (int t = gw; t < T; t += NGW) {
        const f32x4* xr = (const f32x4*)(H + (size_t)t * D) + lane; const f32x4* gr = (const f32x4*)F.g2 + lane;
        f32x4 v[4]; float s = 0.f;
#pragma unroll
        for (int j = 0; j < 4; ++j) { v[j] = xr[64 * j]; s += (v[j].x * v[j].x + v[j].y * v[j].y) + (v[j].z * v[j].z + v[j].w * v[j].w); }
        const float rstd = 1.f / sqrtf(wave_sum(s) * (1.f / D) + EPS);
        unsigned long long* o8 = (unsigned long long*)(XN2 + (size_t)t * D) + lane;
#pragma unroll
        for (int j = 0; j < 4; ++j) { const f32x4 gg = gr[64 * j]; v[j].x *= rstd * gg.x; v[j].y *= rstd * gg.y; v[j].z *= rstd * gg.z; v[j].w *= rstd * gg.w;
            o8[64 * j] = (unsigned long long)pk2(v[j].x, v[j].y) | ((unsigned long long)pk2(v[j].z, v[j].w) << 32); }
        float lg[4];
#pragma unroll
        for (int c = 0; c < 4; ++c) { const f32x4* wr = (const f32x4*)(WrT + (size_t)c * D) + lane; float p = 0.f;
#pragma unroll
            for (int j = 0; j < 4; ++j) { const f32x4 w = wr[64 * j]; p += (v[j].x * w.x + v[j].y * w.y) + (v[j].z * w.z + v[j].w * w.w); }
            lg[c] = wave_sum(p) + F.brg[c]; }
        int grp = 0; float gm = lg[0];
#pragma unroll
        for (int c = 1; c < 4; ++c) if (lg[c] > gm) { gm = lg[c]; grp = c; }
        float gs = 0.f;
#pragma unroll
        for (int c = 0; c < 4; ++c) gs += __expf(lg[c] - gm);
        const float gtop = 1.f / gs;
        float el[8];
#pragma unroll
        for (int i = 0; i < 8; ++i) { const f32x4* wr = (const f32x4*)(WrT + (size_t)(4 + grp * 8 + i) * D) + lane; float p = 0.f;
#pragma unroll
            for (int j = 0; j < 4; ++j) { const f32x4 w = wr[64 * j]; p += (v[j].x * w.x + v[j].y * w.y) + (v[j].z * w.z + v[j].w * w.w); }
            el[i] = wave_sum(p) + F.bre[grp * 8 + i]; }
        int i1 = 0; float v1 = el[0];
#pragma unroll
        for (int i = 1; i < 8; ++i) if (el[i] > v1) { v1 = el[i]; i1 = i; }
        int i2 = -1; float v2 = -3.0e38f;
#pragma unroll
        for (int i = 0; i < 8; ++i) if (i != i1 && el[i] > v2) { v2 = el[i]; i2 = i; }
        const float ex = __expf(v2 - v1), w1 = 1.f / (1.f + ex), w2 = ex / (1.f + ex);
        if (lane == 0) {
            const int e1 = grp * 8 + i1, e2 = grp * 8 + i2;
            const int p1 = (int)__hip_atomic_fetch_add(F.ctl + CW_CNT + 64 * e1, 1u, RLX_AGENT);
            const int p2 = (int)__hip_atomic_fetch_add(F.ctl + CW_CNT + 64 * e2, 1u, RLX_AGENT);
            tok_e[2 * t] = e1; tok_e[2 * t + 1] = e2; tok_pos[2 * t] = p1; tok_pos[2 * t + 1] = p2; tok_w[2 * t] = gtop * w1; tok_w[2 * t + 1] = gtop * w2;
        }
    }
}
__device__ __forceinline__ int build_tiles(Frame& F) {
    int* tile_e = (int*)(F.lds + TILEE_OFF); int* base = tile_e + 192; int* cnts = base + 32; int* nt = cnts + 32;
    __syncthreads();
    if (F.tid == 0) { int tiles = 0;
        for (int e = 0; e < NE; ++e) { const int c = (int)__hip_atomic_load(F.ctl + CW_CNT + 64 * e, RLX_AGENT); cnts[e] = c; base[e] = tiles * 256; const int n = (c + 255) >> 8; for (int i = 0; i < n; ++i) tile_e[tiles + i] = e; tiles += n; }
        nt[0] = tiles; }
    __syncthreads();
    return nt[0];
}
__device__ __forceinline__ void p8_permute(Frame& F) {
    (void)build_tiles(F);
    const int* base = (const int*)(F.lds + TILEE_OFF) + 192; const int* cnts = base + 32;
    const bf16* XN2 = (const bf16*)(F.ws + WS_A); bf16* XS = (bf16*)(F.ws + WS_PROJ);
    const int* tok_e = (const int*)(F.ws + WS_TOK + TK_E); const int* tok_pos = (const int*)(F.ws + WS_TOK + TK_POS); const float* tok_w = (const float*)(F.ws + WS_TOK + TK_W);
    int* stok = (int*)(F.ws + WS_TOK + TK_STOK); float* sw = (float*)(F.ws + WS_TOK + TK_SW);
    const int gw = F.bid * NWAVES + F.wave, NGW = F.G * NWAVES, lane = F.lane;
    for (int s = gw; s < NSLOT; s += NGW) {
        const int t = s >> 1, e = tok_e[s], dest = base[e] + tok_pos[s];
        const v4u* src = (const v4u*)(XN2 + (size_t)t * D) + lane; v4u* dst = (v4u*)(XS + (size_t)dest * D) + lane;
        dst[0] = src[0]; dst[64] = src[64];
        if (lane == 0) { stok[dest] = s; sw[dest] = tok_w[s]; }
    }
    for (int i = gw; i < NE * 256; i += NGW) { const int e = i >> 8, r = i & 255, c = cnts[e], padn = ((c + 255) & ~255) - c;
        if (r < padn) { const int dest = base[e] + c + r; v4u* dst = (v4u*)(XS + (size_t)dest * D) + lane; dst[0] = (v4u){0u, 0u, 0u, 0u}; dst[64] = (v4u){0u, 0u, 0u, 0u}; if (lane == 0) { stok[dest] = -1; sw[dest] = 0.f; } } }
}
__device__ __forceinline__ void p11_final(Frame& F) {
    const bf16* Y = (const bf16*)(F.ws + WS_WGU);
    const int gw = F.bid * NWAVES + F.wave, NGW = F.G * NWAVES, lane = F.lane;
    for (int t = gw; t < T; t += NGW) {
        f32x4* xr = (f32x4*)(F.out + (size_t)t * D) + lane; const f32x4* gr = (const f32x4*)F.gf + lane;
        const v2u* y0 = (const v2u*)(Y + (size_t)(2 * t) * D) + lane; const v2u* y1 = (const v2u*)(Y + (size_t)(2 * t + 1) * D) + lane;
        f32x4 v[4]; float s = 0.f;
#pragma unroll
        for (int j = 0; j < 4; ++j) { v[j] = xr[64 * j]; const v2u a = y0[64 * j], b = y1[64 * j];
            v[j].x += bflo(a.x) + bflo(b.x); v[j].y += bfhi(a.x) + bfhi(b.x); v[j].z += bflo(a.y) + bflo(b.y); v[j].w += bfhi(a.y) + bfhi(b.y);
            s += (v[j].x * v[j].x + v[j].y * v[j].y) + (v[j].z * v[j].z + v[j].w * v[j].w); }
        const float rstd = 1.f / sqrtf(wave_sum(s) * (1.f / D) + EPS);
#pragma unroll
        for (int j = 0; j < 4; ++j) { const f32x4 gg = gr[64 * j]; xr[64 * j] = (f32x4){v[j].x * rstd * gg.x, v[j].y * rstd * gg.y, v[j].z * rstd * gg.z, v[j].w * rstd * gg.w}; }
    }
}

struct Args { const float* in[18]; float* out; unsigned char* ws; int ph_lo, ph_hi; };
__global__ void __launch_bounds__(NWAVES * 64, 2) fwd_kernel(Args args) {
    extern __shared__ __attribute__((aligned(16))) unsigned char lds[];
    Frame F;
    F.lds = lds; F.tid = threadIdx.x; F.lane = F.tid & 63; F.wave = __builtin_amdgcn_readfirstlane(F.tid >> 6); F.G = gridDim.x; F.bid = blockIdx.x;
    F.ws = args.ws; F.ctl = (unsigned*)(args.ws + WS_CTL); F.out = args.out;
    F.x = args.in[0]; F.g1 = args.in[1]; F.w_in = args.in[2]; F.lq1 = args.in[3]; F.lk1 = args.in[4]; F.lq2 = args.in[5]; F.lk2 = args.in[6]; F.subg = args.in[7];
    F.w_out = args.in[8]; F.g2 = args.in[9]; F.wrg = args.in[10]; F.brg = args.in[11]; F.wre = args.in[12]; F.bre = args.in[13]; F.wg = args.in[14]; F.wu = args.in[15]; F.wd = args.in[16]; F.gf = args.in[17];
    volatile LAS unsigned* MISC = (volatile LAS unsigned*)((LAS unsigned char*)lds + MISC_OFF);
    for (int u = F.tid; u < (LDS_BYTES - LDSCTL_OFF) / 4; u += NWAVES * 64) ((LAS unsigned*)((LAS unsigned char*)lds + LDSCTL_OFF))[u] = 0u;
    __syncthreads();
    const int lo = args.ph_lo, hi = args.ph_hi;
    const int vcu = (F.G % 8 == 0) ? (F.bid % 8) * (F.G / 8) + F.bid / 8 : F.bid;
    XcdBarrier bar; bar.bar = F.ctl + CW_BAR; bar.x = 0; bar.st = nullptr;
    if (hi - lo > 1) bar = xcd_barrier_post(F.ctl + CW_BAR, MISC + 8);
#ifndef PH_MASK
#define PH_MASK 0xFFFF
#endif
#define IN(k) (((PH_MASK >> (k)) & 1) && lo <= (k) && (k) < hi)
#define SEAM(k) do { if (IN(k) && IN((k) + 1)) xcd_barrier(bar); } while (0)
    if (IN(0)) { p0_prologue(F); } SEAM(0);
    if (IN(1)) {
        if (USE_MFMA & 1) { pg8::Gemm g{(const bf16*)(F.ws + WS_A), (const bf16*)(F.ws + WS_WIN), T, NIN, D}; pg8::StaticOrder S; S.init(T, NIN, F.G, F.bid);
            pg8::EpiBf16Plain E{(bf16*)(F.ws + WS_PROJ), NIN}; pg8::gemm_phase<pg8::EpiBf16Plain, pg8::StaticOrder, true, true>((LAS unsigned char*)lds, g, S, E); }
        else { DenseOrder S{T / 256, NIN / 256, F.G, F.bid}; NEpiBf16 E{(bf16*)(F.ws + WS_PROJ), NIN};
            naive_gemm<false>(F, (const bf16*)(F.ws + WS_A), (const bf16*)(F.ws + WS_WIN), D, S, E); } } SEAM(1);
    if (IN(2)) { p3_ret_kv(F); } SEAM(2);
    if (IN(3)) { p4_ret_scan(F); p2_attention(F); } SEAM(3);
    if (IN(4)) { p5_ret_out(F); } SEAM(4);
    if (IN(5)) {
        if (USE_MFMA & 2) { pg8::Gemm g{(const bf16*)(F.ws + WS_A), (const bf16*)(F.ws + WS_WOUT), T, D, D}; pg8::StaticOrder S; S.init(T, D, F.G, F.bid);
            pg8::EpiResF32 E{F.x, F.out, D}; pg8::gemm_phase<pg8::EpiResF32, pg8::StaticOrder, true, true>((LAS unsigned char*)lds, g, S, E); }
        else { DenseOrder S{T / 256, D / 256, F.G, F.bid}; NEpiResF32 E{F.x, F.out, D};
            naive_gemm<false>(F, (const bf16*)(F.ws + WS_A), (const bf16*)(F.ws + WS_WOUT), D, S, E); } } SEAM(5);
    if (IN(6)) { p7_route(F); } SEAM(6);
    if (IN(7)) { p8_permute(F); } SEAM(7);
    if (IN(8)) { const int nt = build_tiles(F);
        if (USE_MFMA & 4) { pg8::Gemm g{(const bf16*)(F.ws + WS_PROJ), (const bf16*)(F.ws + WS_WGU), NPAD, 1024, D}; pg8::GroupedOrder S{(const LAS int*)((LAS unsigned char*)lds + TILEE_OFF), nt, 4, F.G, vcu};
            pg8::EpiSwiglu E{(bf16*)(F.ws + WS_A), HIDN}; pg8::gemm_phase<pg8::EpiSwiglu, pg8::GroupedOrder, true, true>((LAS unsigned char*)lds, g, S, E); }
        else { GroupedOrder S{(const int*)(F.lds + TILEE_OFF), nt, 4, F.G, F.bid}; NEpiBf16 E{(bf16*)(F.ws + WS_A), HIDN};
            naive_gemm<true>(F, (const bf16*)(F.ws + WS_PROJ), (const bf16*)(F.ws + WS_WGU), D, S, E); } } SEAM(8);
    if (IN(9)) { const int nt = build_tiles(F);
        if (USE_MFMA & 8) { pg8::Gemm g{(const bf16*)(F.ws + WS_A), (const bf16*)(F.ws + WS_WD), NPAD, 1024, HIDN}; pg8::GroupedOrder S{(const LAS int*)((LAS unsigned char*)lds + TILEE_OFF), nt, 4, F.G, vcu};
            pg8::EpiScatter E{(const int*)(F.ws + WS_TOK + TK_STOK), (const float*)(F.ws + WS_TOK + TK_SW), (bf16*)(F.ws + WS_WGU), D};
            pg8::gemm_phase<pg8::EpiScatter, pg8::GroupedOrder, true, true>((LAS unsigned char*)lds, g, S, E); }
        else { GroupedOrder S{(const int*)(F.lds + TILEE_OFF), nt, 4, F.G, F.bid};
            NEpiScatter E{(const int*)(F.ws + WS_TOK + TK_STOK), (const float*)(F.ws + WS_TOK + TK_SW), (bf16*)(F.ws + WS_WGU)};
            naive_gemm<false>(F, (const bf16*)(F.ws + WS_A), (const bf16*)(F.ws + WS_WD), HIDN, S, E); } } SEAM(9);
    if (IN(10)) { p11_final(F); }
#undef IN
#undef SEAM
}

extern "C" void kernel_launch(void* const* d_in, const int* in_sizes, int n_in, void* d_out, int out_size, void* d_ws, size_t ws_size, hipStream_t stream) {
    static int grid = 0;
    if (grid == 0) {
        if (n_in != 18 || in_sizes[0] != T * D || out_size != T * D || ws_size < WS_END) { fprintf(stderr, "kernel_launch: shape mismatch n_in %d in0 %d out %d ws %zu\n", n_in, n_in > 0 ? in_sizes[0] : -1, out_size, ws_size); grid = -1; return; }
        int dev = 0, cus = 0, per_cu = 0;
        if (hipGetDevice(&dev) != hipSuccess || hipDeviceGetAttribute(&cus, hipDeviceAttributeMultiprocessorCount, dev) != hipSuccess) { grid = -1; return; }
        if (hipFuncSetAttribute((const void*)fwd_kernel, hipFuncAttributeMaxDynamicSharedMemorySize, LDS_BYTES) != hipSuccess) { fprintf(stderr, "kernel_launch: hipFuncSetAttribute failed\n"); grid = -1; return; }
        if (hipOccupancyMaxActiveBlocksPerMultiprocessor(&per_cu, (const void*)fwd_kernel, NWAVES * 64, LDS_BYTES) != hipSuccess || per_cu < 1) fprintf(stderr, "kernel_launch: occupancy query says %d\n", per_cu);
        (void)hipGetLastError();
        grid = cus;
    }
    if (grid < 0) return;
    (void)hipMemsetAsync((char*)d_ws + WS_CTL, 0, CTL_ZERO_BYTES, stream);
    Args a{};
    for (int i = 0; i < 18; ++i) a.in[i] = (const float*)d_in[i];
    a.out = (float*)d_out; a.ws = (unsigned char*)d_ws;
#if MK_ONE_LAUNCH
    a.ph_lo = 0; a.ph_hi = NPHASE;
    hipLaunchKernelGGL(fwd_kernel, dim3(grid), dim3(NWAVES * 64), LDS_BYTES, stream, a);
#else
    for (int p = 0; p < NPHASE; ++p) { a.ph_lo = p; a.ph_hi = p + 1; hipLaunchKernelGGL(fwd_kernel, dim3(grid), dim3(NWAVES * 64), LDS_BYTES, stream, a); }
#endif
}
```

```cpp
#include <hip/hip_runtime.h>
#include <cstdio>
#include <cstdint>

#ifndef USE_MFMA
#define USE_MFMA 0x1F
#endif
#ifndef MK_ONE_LAUNCH
#define MK_ONE_LAUNCH 1
#endif

constexpr int T = 16384, D = 1024, NIN = 3072;
constexpr int C_QDA = 0, C_KDA = 512, C_VDA = 1024, C_QR = 1536, C_KR = 1792, C_VR = 2048, C_GR = 2560;
constexpr int NE = 32, HIDN = 512, NSLOT = 2 * T, MAXTILES = NSLOT / 256 + NE, NPAD = MAXTILES * 256;
constexpr int NRT = 36;
constexpr float EPS = 1e-6f;
constexpr float LOG2E = 1.4426950408889634f;
constexpr float C2 = 0.125f * LOG2E;
constexpr float LAMBDA_INIT = 0.2f;
constexpr int NPHASE = 11;

constexpr size_t MiB = 1u << 20;
constexpr size_t WS_CTL = 0, CTL_ZERO_BYTES = 1 * MiB;
constexpr size_t WS_WRT = 1 * MiB;
constexpr size_t WS_WIN = 2 * MiB;
constexpr size_t WS_WOUT = 8 * MiB;
constexpr size_t WS_WGU = 10 * MiB;
constexpr size_t WS_WD = 74 * MiB;
constexpr size_t WS_A = 106 * MiB;
constexpr size_t WS_PROJ = 146 * MiB;
constexpr size_t WS_TOK = 242 * MiB;
constexpr size_t WS_END = 244 * MiB;
constexpr int PSLOTS = 1280;
constexpr size_t WS_PARTO = WS_WGU;
constexpr size_t WS_PARTS = WS_WGU + 80 * MiB;
constexpr int CW_BAR = 4096;
constexpr int CW_CNT = 1024;
constexpr int CW_NORM = 3072;
constexpr int CW_QHEAD = 3136;
constexpr size_t TK_E = 0, TK_POS = 128 * 1024, TK_W = 256 * 1024, TK_STOK = 384 * 1024, TK_SW = 384 * 1024 + 160 * 1024;

constexpr int RING_BYTES = 131072;
constexpr int ITEM_OFF = 98304;
constexpr int LDSCTL_OFF = RING_BYTES, MISC_OFF = LDSCTL_OFF + 320, TILEE_OFF = LDSCTL_OFF + 1024;
constexpr int LDS_BYTES = 147456;
constexpr int NWAVES = 8;

#define GAS __attribute__((address_space(1)))
#define LAS __attribute__((address_space(3)))
typedef unsigned short bf16;
typedef unsigned v4u __attribute__((ext_vector_type(4)));
typedef unsigned v2u __attribute__((ext_vector_type(2)));
typedef float f32x4 __attribute__((ext_vector_type(4)));
#define RLX_AGENT __ATOMIC_RELAXED, __HIP_MEMORY_SCOPE_AGENT
#define LDS_WAIT() asm volatile("s_waitcnt lgkmcnt(0)" ::: "memory")

__device__ __forceinline__ unsigned f2bf(float f) { unsigned u = __builtin_bit_cast(unsigned, f); return (u + 0x7fffu + ((u >> 16) & 1u)) >> 16; }
__device__ __forceinline__ unsigned pk2(float lo, float hi) { return f2bf(lo) | (f2bf(hi) << 16); }
__device__ __forceinline__ float bflo(unsigned w) { return __builtin_bit_cast(float, w << 16); }
__device__ __forceinline__ float bfhi(unsigned w) { return __builtin_bit_cast(float, w & 0xffff0000u); }
__device__ __forceinline__ float bf2f(bf16 b) { return __builtin_bit_cast(float, (unsigned)b << 16); }
__device__ __forceinline__ float wave_sum(float v) {
#pragma unroll
    for (int o = 1; o < 64; o <<= 1) v += __shfl_xor(v, o);
    return v;
}
__device__ __forceinline__ float silu_f(float v) { return v / (1.f + __expf(-v)); }

#define XB_TMO      128
#define XB_XCNT(j)  (256  + 64 * (j))
#define XB_XSUB(j)  (1280 + 64 * (j))
#define XB_XGEN(j)  (2304 + 64 * (j))
#define XB_TOP      3328
#define XB_TOPGEN   3392
#define XCD_BAR_WORDS 3456
#define XB_SPIN_CAP (1u << 18)
__device__ __forceinline__ unsigned xb_ld(unsigned* p)              { return __hip_atomic_load(p, __ATOMIC_RELAXED, __HIP_MEMORY_SCOPE_AGENT); }
__device__ __forceinline__ unsigned xb_add(unsigned* p, unsigned v) { return __hip_atomic_fetch_add(p, v, __ATOMIC_RELAXED, __HIP_MEMORY_SCOPE_AGENT); }
__device__ __forceinline__ unsigned xb_xcc_id() { return (unsigned)__builtin_amdgcn_s_getreg((3 << 11) | 20) & 0xFu; }
#define XB_SPIN(cond, bar) do { unsigned _sp = 0; while (cond) { __builtin_amdgcn_s_sleep(1); \
    if ((++_sp & 255u) == 0u) { if (xb_ld(&(bar)[XB_TMO])) break; if (_sp > XB_SPIN_CAP) { atomicAdd(&(bar)[XB_TMO], 1u); break; } } } } while (0)
struct XcdBarrier { unsigned* bar; unsigned x; volatile LAS unsigned* st; };
__device__ __forceinline__ XcdBarrier xcd_barrier_post(unsigned* bar, volatile LAS unsigned* st) {
    XcdBarrier b; b.bar = bar; b.x = xb_xcc_id(); b.st = st;
    if (threadIdx.x == 0) (void)xb_add(&bar[XB_XCNT(b.x)], 1u);
    return b;
}
__device__ __forceinline__ void xcd_barrier_complete(unsigned* bar, unsigned x, unsigned& nloc, unsigned& nx) {
    const unsigned G = gridDim.x * gridDim.y * gridDim.z;
    unsigned sum, cnt, mine, sp = 0u;
    for (;;) {
        sum = 0u; cnt = 0u; mine = 0u;
#pragma unroll
        for (unsigned j = 0; j < 16; ++j) { const unsigned c = xb_ld(&bar[XB_XCNT(j)]); sum += c; cnt += (c > 0u) ? 1u : 0u; mine = (j == x) ? c : mine; }
        if (sum == G) break;
        __builtin_amdgcn_s_sleep(1);
        if ((++sp & 255u) == 0u) { if (xb_ld(&bar[XB_TMO])) break; if (sp > XB_SPIN_CAP) { atomicAdd(&bar[XB_TMO], 1u); break; } }
    }
    nloc = mine > 0u ? mine : 1u; nx = cnt > 0u ? cnt : 1u;
}
__device__ __forceinline__ void xcd_barrier(const XcdBarrier& b) {
    asm volatile("s_waitcnt vmcnt(0)" ::: "memory");
    __syncthreads();
    if (threadIdx.x == 0) {
        unsigned* bar = b.bar;
        __builtin_amdgcn_s_waitcnt(0);
        unsigned nloc = b.st[0], nx = b.st[1];
        if (nloc == 0u) { xcd_barrier_complete(bar, b.x, nloc, nx); b.st[0] = nloc; b.st[1] = nx; }
        const unsigned old = xb_add(&bar[XB_XSUB(b.x)], 1u);
        const unsigned gen = old / nloc;
        if (old + 1u == (gen + 1u) * nloc) {
            __builtin_amdgcn_fence(__ATOMIC_RELEASE, "agent");
            asm volatile("s_waitcnt vmcnt(0)" ::: "memory");
            const unsigned og = xb_add(&bar[XB_TOP], 1u);
            const unsigned tg = og / nx;
            if (og + 1u == (tg + 1u) * nx) xb_add(&bar[XB_TOPGEN], 1u);
            else XB_SPIN(xb_ld(&bar[XB_TOPGEN]) == tg, bar);
            __builtin_amdgcn_fence(__ATOMIC_ACQUIRE, "agent");
            xb_add(&bar[XB_XGEN(b.x)], 1u);
            asm volatile("s_waitcnt vmcnt(0)" ::: "memory");
        } else {
            XB_SPIN(xb_ld(&bar[XB_XGEN(b.x)]) == gen, bar);
            __builtin_amdgcn_fence(__ATOMIC_ACQUIRE, "agent");
            asm volatile("s_waitcnt vmcnt(0)" ::: "memory");
        }
    }
    __syncthreads();
}

namespace pg8 {
#define PG8_LAS __attribute__((address_space(3)))
typedef unsigned short bf16_t;
typedef short bf16x8 __attribute__((ext_vector_type(8)));
typedef float f32x4 __attribute__((ext_vector_type(4)));
typedef unsigned u32x4 __attribute__((ext_vector_type(4)));
constexpr int BM = 256, BK = 64, HALF = 128, HTB = HALF * BK * 2  , STAGE_BYTES = 8 * HTB, NXCD = 8, WGM = 8;

__host__ __device__ __forceinline__ int lds_byte(int r, int c) { const int st = (r >> 4) * 2 + (c >> 5), rr = r & 15, cc = c & 31, ob = rr * 64 + cc * 2; return st * 1024 + (ob ^ (((ob >> 9) & 1) << 5)); }
__host__ __device__ __forceinline__ void stage_rc(int b, int& R, int& C) { const int st = b / 1024, sb = b % 1024, swz = sb ^ (((sb >> 9) & 1) << 5); R = (st >> 1) * 16 + swz / 64; C = (st & 1) * 32 + (swz % 64) / 2; }
__host__ __device__ __forceinline__ int perm32(int rho) { const int n = rho >> 4, i = rho & 15; return 8 * (i >> 2) + 4 * n + (i & 3); }

struct Unit { int pm, pn, pb; };
struct Gemm { const bf16_t* A; const bf16_t* Bt; int M, N, K; };
__device__ __forceinline__ unsigned cvt_pk_bf16(float lo, float hi) { unsigned r; asm volatile("v_cvt_pk_bf16_f32 %0, %1, %2" : "=v"(r) : "v"(lo), "v"(hi)); return r; }
template <class Epi, class Sched, bool ALIGN_EPI = false, bool SP2 = false>
__device__ __forceinline__ void gemm_phase(PG8_LAS unsigned char* lds, const Gemm g, const Sched& S, const Epi& E) {
    const int tid = threadIdx.x, wid = __builtin_amdgcn_readfirstlane(tid >> 6), lane = tid & 63, wr = wid >> 2, wc = wid & 3, fr = lane & 15, fq = lane >> 4;
    const int K = g.K, nt = K / BK;
    unsigned voffA[2], voffB[2];
#pragma unroll
    for (int i = 0; i < 2; ++i) { int R, C; stage_rc(tid * 16 + i * 8192, R, C); const int Rb = Epi::PERM ? ((R & ~31) + perm32(R & 31)) : R;
        voffA[i] = (unsigned)(R * K + C) * 2u; voffB[i] = (unsigned)(Rb * K + C) * 2u; }
    const size_t kstep = (size_t)(BK * 2);
    const size_t hstep = (size_t)HALF * K * 2;
    const size_t tstep = 2 * hstep;
    const unsigned ldsw = (unsigned)wid * 1024u;
    const int aoff = lds_byte(wr * 64 + fr, fq * 8), boff = lds_byte(wc * 32 + fr, fq * 8);
#define PG8_SA(b, h) (((b) * 2 + (h)) * HTB)
#define PG8_SB(b, h) ((4 + (b) * 2 + (h)) * HTB)
#define PG8_STAGE(bufoff, gbase, voff) do { _Pragma("unroll") for (int _i = 0; _i < 2; ++_i) \
        __builtin_amdgcn_global_load_lds((const unsigned*)((const char*)(gbase) + (voff)[_i]), (PG8_LAS unsigned*)(lds + (bufoff) + ldsw + _i * 8192), 16, 0, 0); } while (0)
#define PG8_LDA(dst, b, h) do { _Pragma("unroll") for (int m = 0; m < 4; ++m) _Pragma("unroll") for (int k = 0; k < 2; ++k) dst[m][k] = *(const PG8_LAS bf16x8*)(lds + PG8_SA(b, h) + aoff + m * 2048 + k * 1024); } while (0)
#define PG8_LDB(dst, b, h) do { _Pragma("unroll") for (int n = 0; n < 2; ++n) _Pragma("unroll") for (int k = 0; k < 2; ++k) dst[n][k] = *(const PG8_LAS bf16x8*)(lds + PG8_SB(b, h) + boff + n * 2048 + k * 1024); } while (0)
#define PG8_MMA(ai, bj, At, Bt) do { __builtin_amdgcn_s_setprio(1); _Pragma("unroll") for (int m = 0; m < 4; ++m) _Pragma("unroll") for (int n = 0; n < 2; ++n) _Pragma("unroll") for (int k = 0; k < 2; ++k) \
        acc[ai][bj][m][n] = __builtin_amdgcn_mfma_f32_16x16x32_bf16(Bt[n][k], At[m][k], acc[ai][bj][m][n], 0, 0, 0); __builtin_amdgcn_s_setprio(0); } while (0)
#define PG8_WAIT_V(n) asm volatile("s_waitcnt vmcnt(" #n ")" ::: "memory")
#define PG8_WAIT_L(n) asm volatile("s_waitcnt lgkmcnt(" #n ")" ::: "memory")
#define PG8_BAR __builtin_amdgcn_s_barrier()
#define PG8_SCHED __builtin_amdgcn_sched_barrier(0)
    Unit cur, nxt; int ui = 0;
    if (!S.next(0, cur)) return;
    f32x4 acc[2][2][4][2];
#pragma unroll
    for (int a = 0; a < 2; ++a)
#pragma unroll
        for (int b = 0; b < 2; ++b)
#pragma unroll
            for (int m = 0; m < 4; ++m)
#pragma unroll
                for (int n = 0; n < 2; ++n) acc[a][b][m][n] = (f32x4){0.f, 0.f, 0.f, 0.f};
    bf16x8 At[4][2], B0[2][2], B1[2][2];
    const char* cA = (const char*)g.A + (size_t)cur.pm * tstep; const char* cB = (const char*)g.Bt + (size_t)cur.pb * tstep;
    S.a_ready(cur);
    if constexpr (SP2) {
        PG8_STAGE(PG8_SB(0, 0), cB, voffB); PG8_STAGE(PG8_SB(0, 1), cB + hstep, voffB); PG8_STAGE(PG8_SA(0, 0), cA, voffA); PG8_STAGE(PG8_SA(0, 1), cA + hstep, voffA);
        if (wr == 1) PG8_BAR;
        PG8_WAIT_V(2); PG8_BAR;
        PG8_STAGE(PG8_SB(1, 0), cB + kstep, voffB); PG8_STAGE(PG8_SA(1, 0), cA + kstep, voffA); PG8_STAGE(PG8_SB(1, 1), cB + hstep + kstep, voffB);
        PG8_WAIT_V(6); PG8_BAR;
    } else {
        PG8_STAGE(PG8_SB(0, 0), cB, voffB); PG8_STAGE(PG8_SA(0, 0), cA, voffA); PG8_STAGE(PG8_SB(0, 1), cB + hstep, voffB); PG8_STAGE(PG8_SA(0, 1), cA + hstep, voffA);
        if (wr == 1) PG8_BAR;
        PG8_WAIT_V(4); PG8_BAR;
        PG8_STAGE(PG8_SB(1, 0), cB + kstep, voffB); PG8_STAGE(PG8_SA(1, 0), cA + kstep, voffA); PG8_STAGE(PG8_SB(1, 1), cB + hstep + kstep, voffB);
        PG8_WAIT_V(6); PG8_BAR;
    }
    for (;;) {
        const bool has_next = S.next(ui + 1, nxt);
        const char* nA = has_next ? (const char*)g.A + (size_t)nxt.pm * tstep : cA; const char* nB = has_next ? (const char*)g.Bt + (size_t)nxt.pb * tstep : cB;
        for (int t = 0; t < nt; t += 2) {
            const bool last = (t == nt - 2);
            const char* a1 = cA + (size_t)(t + 1) * kstep;
            const char* a2 = last ? nA : cA + (size_t)(t + 2) * kstep; const char* b2 = last ? nB : cB + (size_t)(t + 2) * kstep;
            const char* a3 = a2 + kstep; const char* b3 = b2 + kstep;
            if (last && has_next) S.a_ready(nxt);
            if constexpr (SP2) {
            PG8_LDB(B0, 0, 0); PG8_LDB(B1, 0, 1); PG8_SCHED; PG8_LDA(At, 0, 0); PG8_STAGE(PG8_SA(1, 1), a1 + hstep, voffA);
            PG8_WAIT_V(8); PG8_WAIT_L(0); PG8_BAR; PG8_MMA(0, 0, At, B0); PG8_MMA(0, 1, At, B1); PG8_BAR; PG8_SCHED;
            PG8_LDA(At, 0, 1); PG8_STAGE(PG8_SB(0, 0), b2, voffB); PG8_STAGE(PG8_SB(0, 1), b2 + hstep, voffB); PG8_STAGE(PG8_SA(0, 0), a2, voffA);
            PG8_WAIT_V(8); PG8_WAIT_L(0); PG8_BAR; PG8_MMA(1, 0, At, B0); PG8_MMA(1, 1, At, B1); PG8_BAR; PG8_SCHED;
            PG8_LDB(B0, 1, 0); PG8_LDB(B1, 1, 1); PG8_SCHED; PG8_LDA(At, 1, 0); PG8_STAGE(PG8_SA(0, 1), a2 + hstep, voffA);
            PG8_WAIT_V(8); PG8_WAIT_L(0); PG8_BAR; PG8_MMA(0, 0, At, B0); PG8_MMA(0, 1, At, B1); PG8_BAR; PG8_SCHED;
            PG8_LDA(At, 1, 1); PG8_STAGE(PG8_SB(1, 0), b3, voffB); PG8_STAGE(PG8_SB(1, 1), b3 + hstep, voffB); PG8_STAGE(PG8_SA(1, 0), a3, voffA);
            PG8_WAIT_V(8); PG8_WAIT_L(0); PG8_BAR; PG8_MMA(1, 0, At, B0); PG8_MMA(1, 1, At, B1); PG8_BAR; PG8_SCHED;
            } else {
            PG8_LDB(B0, 0, 0); PG8_SCHED; PG8_LDA(At, 0, 0); PG8_STAGE(PG8_SA(1, 1), a1 + hstep, voffA);
            PG8_WAIT_L(8); PG8_BAR; PG8_WAIT_L(0); PG8_MMA(0, 0, At, B0); PG8_BAR; PG8_SCHED;
            PG8_LDB(B1, 0, 1); PG8_STAGE(PG8_SB(0, 0), b2, voffB);
            PG8_BAR; PG8_WAIT_L(0); PG8_MMA(0, 1, At, B1); PG8_BAR;
            PG8_LDA(At, 0, 1); PG8_STAGE(PG8_SA(0, 0), a2, voffA);
            PG8_BAR; PG8_WAIT_L(0); PG8_MMA(1, 0, At, B0); PG8_BAR; PG8_SCHED;
            PG8_STAGE(PG8_SB(0, 1), b2 + hstep, voffB);
            PG8_WAIT_V(6); PG8_BAR; PG8_MMA(1, 1, At, B1); PG8_BAR;
            PG8_LDB(B0, 1, 0); PG8_SCHED; PG8_LDA(At, 1, 0); PG8_STAGE(PG8_SA(0, 1), a2 + hstep, voffA);
            PG8_WAIT_L(8); PG8_BAR; PG8_WAIT_L(0); PG8_MMA(0, 0, At, B0); PG8_BAR; PG8_SCHED;
            PG8_LDB(B1, 1, 1); PG8_STAGE(PG8_SB(1, 0), b3, voffB);
            PG8_BAR; PG8_WAIT_L(0); PG8_MMA(0, 1, At, B1); PG8_BAR;
            PG8_LDA(At, 1, 1); PG8_STAGE(PG8_SA(1, 0), a3, voffA);
            PG8_BAR; PG8_WAIT_L(0); PG8_MMA(1, 0, At, B0); PG8_BAR; PG8_SCHED;
            PG8_STAGE(PG8_SB(1, 1), b3 + hstep, voffB);
            PG8_WAIT_V(6); PG8_BAR; PG8_MMA(1, 1, At, B1); PG8_BAR;
            }
        }
        if constexpr (ALIGN_EPI) { if (wr == 0) PG8_BAR; }
        if constexpr (!Epi::AFTER_DRAIN) { E(acc, cur, wr, wc, fr, fq); S.done(cur); }
        if (!has_next) break;
#pragma unroll
        for (int a = 0; a < 2; ++a)
#pragma unroll
            for (int b = 0; b < 2; ++b)
#pragma unroll
                for (int m = 0; m < 4; ++m)
#pragma unroll
                    for (int n = 0; n < 2; ++n) acc[a][b][m][n] = (f32x4){0.f, 0.f, 0.f, 0.f};
        cur = nxt; cA = nA; cB = nB; ++ui;
        if constexpr (ALIGN_EPI) { if (wr == 1) PG8_BAR; }
    }
    PG8_WAIT_V(0);
    if constexpr (!ALIGN_EPI) { if (wr == 0) PG8_BAR; }
    PG8_BAR;
    if constexpr (Epi::AFTER_DRAIN) { E.fused(acc, cur, wr, wc, fr, fq, lds, wid, lane); S.done(cur); }
#undef PG8_SA
#undef PG8_SB
#undef PG8_STAGE
#undef PG8_LDA
#undef PG8_LDB
#undef PG8_MMA
#undef PG8_WAIT_V
#undef PG8_WAIT_L
#undef PG8_BAR
#undef PG8_SCHED
}

struct EpiBf16Plain {
    static constexpr bool PERM = true, AFTER_DRAIN = false;
    bf16_t* O; int ldc;
    __device__ __forceinline__ void operator()(const f32x4 (&acc)[2][2][4][2], const Unit& u, int wr, int wc, int fr, int fq) const {
        const int row0 = u.pm * BM + wr * 64 + fr, col0 = u.pn * BM + wc * 32 + 8 * fq;
#pragma unroll
        for (int ai = 0; ai < 2; ++ai)
#pragma unroll
            for (int m = 0; m < 4; ++m) { bf16_t* rowp = O + (size_t)(row0 + ai * HALF + m * 16) * ldc + col0;
#pragma unroll
                for (int bj = 0; bj < 2; ++bj) { const f32x4 v0 = acc[ai][bj][m][0], v1 = acc[ai][bj][m][1];
                    u32x4 w; w.x = cvt_pk_bf16(v0[0], v0[1]); w.y = cvt_pk_bf16(v0[2], v0[3]); w.z = cvt_pk_bf16(v1[0], v1[1]); w.w = cvt_pk_bf16(v1[2], v1[3]);
                    *(u32x4*)(rowp + bj * HALF) = w; } }
    }
};
struct EpiBf16Norm {
    static constexpr bool PERM = true, AFTER_DRAIN = false;
    bf16_t* O; int ldc; unsigned* norm;
    __device__ __forceinline__ void operator()(const f32x4 (&acc)[2][2][4][2], const Unit& u, int wr, int wc, int fr, int fq) const {
        const int row0 = u.pm * BM + wr * 64 + fr, col0 = u.pn * BM + wc * 32 + 8 * fq;
#pragma unroll
        for (int ai = 0; ai < 2; ++ai)
#pragma unroll
            for (int m = 0; m < 4; ++m) { bf16_t* rowp = O + (size_t)(row0 + ai * HALF + m * 16) * ldc + col0;
#pragma unroll
                for (int bj = 0; bj < 2; ++bj) { const f32x4 v0 = acc[ai][bj][m][0], v1 = acc[ai][bj][m][1];
                    u32x4 w; w.x = cvt_pk_bf16(v0[0], v0[1]); w.y = cvt_pk_bf16(v0[2], v0[3]); w.z = cvt_pk_bf16(v1[0], v1[1]); w.w = cvt_pk_bf16(v1[2], v1[3]);
                    *(u32x4*)(rowp + bj * HALF) = w; } }
        if (u.pn < 4) {
#pragma unroll
            for (int bj = 0; bj < 2; ++bj) { float mx = 0.f;
#pragma unroll
                for (int ai = 0; ai < 2; ++ai)
#pragma unroll
                    for (int m = 0; m < 4; ++m) { const f32x4 a = acc[ai][bj][m][0], b = acc[ai][bj][m][1];
                        float ssq = (a[0] * a[0] + a[1] * a[1]) + (a[2] * a[2] + a[3] * a[3]) + (b[0] * b[0] + b[1] * b[1]) + (b[2] * b[2] + b[3] * b[3]);
                        ssq += __shfl_xor(ssq, 16); ssq += __shfl_xor(ssq, 32); mx = fmaxf(mx, ssq); }
#pragma unroll
                for (int o = 1; o < 16; o <<= 1) mx = fmaxf(mx, __shfl_xor(mx, o));
                if ((threadIdx.x & 63) == 0) __hip_atomic_fetch_max(norm + (4 * u.pn + 2 * bj + (wc >> 1)) * 2 + (wc & 1), __float_as_uint(mx), __ATOMIC_RELAXED, __HIP_MEMORY_SCOPE_AGENT); }
        }
    }
};
struct EpiResF32 {
    static constexpr bool PERM = false, AFTER_DRAIN = false;
    const float* base; float* C; int ldc;
    __device__ __forceinline__ void operator()(const f32x4 (&acc)[2][2][4][2], const Unit& u, int wr, int wc, int fr, int fq) const {
        const int row0 = u.pm * BM + wr * 64 + fr, col0 = u.pn * BM + wc * 32 + 4 * fq;
#pragma unroll
        for (int ai = 0; ai < 2; ++ai)
#pragma unroll
            for (int m = 0; m < 4; ++m) { const size_t off = (size_t)(row0 + ai * HALF + m * 16) * ldc + col0;
                f32x4 b[2][2];
#pragma unroll
                for (int bj = 0; bj < 2; ++bj)
#pragma unroll
                    for (int n = 0; n < 2; ++n) b[bj][n] = *(const f32x4*)(base + off + bj * HALF + n * 16);
#pragma unroll
                for (int bj = 0; bj < 2; ++bj)
#pragma unroll
                    for (int n = 0; n < 2; ++n) *(f32x4*)(C + off + bj * HALF + n * 16) = b[bj][n] + acc[ai][bj][m][n];
                if (m & 1) asm volatile("" ::: "memory"); }
    }
};
__device__ __forceinline__ float silu_mul(float g, float u) { return g * u * __builtin_amdgcn_rcpf(1.f + __expf(-g)); }
struct EpiSwiglu {
    static constexpr bool PERM = true, AFTER_DRAIN = false;
    bf16_t* H; int ldh;
    __device__ __forceinline__ void operator()(const f32x4 (&acc)[2][2][4][2], const Unit& u, int wr, int wc, int fr, int fq) const {
        const int row0 = u.pm * BM + wr * 64 + fr, col0 = u.pn * HALF + wc * 32 + 8 * fq;
#pragma unroll
        for (int ai = 0; ai < 2; ++ai)
#pragma unroll
            for (int m = 0; m < 4; ++m) { const f32x4 g0 = acc[ai][0][m][0], g1 = acc[ai][0][m][1], u0 = acc[ai][1][m][0], u1 = acc[ai][1][m][1];
                u32x4 w; w.x = cvt_pk_bf16(silu_mul(g0[0], u0[0]), silu_mul(g0[1], u0[1])); w.y = cvt_pk_bf16(silu_mul(g0[2], u0[2]), silu_mul(g0[3], u0[3]));
                w.z = cvt_pk_bf16(silu_mul(g1[0], u1[0]), silu_mul(g1[1], u1[1])); w.w = cvt_pk_bf16(silu_mul(g1[2], u1[2]), silu_mul(g1[3], u1[3]));
                *(u32x4*)(H + (size_t)(row0 + ai * HALF + m * 16) * ldh + col0) = w; }
    }
};
struct EpiScatter {
    static constexpr bool PERM = true, AFTER_DRAIN = false;
    const int* stok; const float* sw; bf16_t* Y; int ldy;
    __device__ __forceinline__ void operator()(const f32x4 (&acc)[2][2][4][2], const Unit& u, int wr, int wc, int fr, int fq) const {
        const int row0 = u.pm * BM + wr * 64 + fr, col0 = u.pn * BM + wc * 32 + 8 * fq;
#pragma unroll
        for (int ai = 0; ai < 2; ++ai)
#pragma unroll
            for (int m = 0; m < 4; ++m) { const int row = row0 + ai * HALF + m * 16; const int tk = stok[row]; const float s = sw[row];
                if (tk >= 0) { bf16_t* rowp = Y + (size_t)tk * ldy + col0;
#pragma unroll
                    for (int bj = 0; bj < 2; ++bj) { const f32x4 v0 = acc[ai][bj][m][0] * s, v1 = acc[ai][bj][m][1] * s;
                        u32x4 w; w.x = cvt_pk_bf16(v0[0], v0[1]); w.y = cvt_pk_bf16(v0[2], v0[3]); w.z = cvt_pk_bf16(v1[0], v1[1]); w.w = cvt_pk_bf16(v1[2], v1[3]);
                        *(u32x4*)(rowp + bj * HALF) = w; } } }
    }
};
struct StaticOrder {
    int nM, nN, nwg, G, c;
    __device__ void init(int M, int N, int G_, int c_) { nM = M / BM; nN = N / BM; nwg = nM * nN; G = G_; c = c_; }
    __device__ bool next(int i, Unit& u) const {
        const long L = (long)i * G + c; if (L >= nwg) return false;
        int wgid = (int)L; { const int q = nwg / NXCD, r = nwg % NXCD, xcd = wgid % NXCD, off = wgid / NXCD; wgid = (xcd < r ? xcd * (q + 1) : r * (q + 1) + (xcd - r) * q) + off; }
        const int nig = WGM * nN, gid = wgid / nig, fm = gid * WGM, gsz = (nM - fm) < WGM ? (nM - fm) : WGM;
        u.pm = fm + ((wgid % nig) % gsz); u.pn = (wgid % nig) / gsz; u.pb = u.pn; return true;
    }
    __device__ __forceinline__ void a_ready(const Unit&) const {}
    __device__ __forceinline__ void done(const Unit&) const {}
};
struct GroupedOrder {
    const PG8_LAS int* tile_e; int ntiles, nN, G, c;
    __device__ __forceinline__ bool next(int i, Unit& u) const { const int L = i * G + c; if (L >= ntiles * nN) return false; u.pm = L / nN; u.pn = L % nN; u.pb = tile_e[u.pm] * nN + u.pn; return true; }
    __device__ __forceinline__ void a_ready(const Unit&) const {}
    __device__ __forceinline__ void done(const Unit&) const {}
};
}

struct Frame {
    unsigned char* lds;
    unsigned* ctl;
    int tid, lane, wave, G, bid;
    const float *x, *g1, *w_in, *lq1, *lk1, *lq2, *lk2, *subg, *w_out, *g2, *wrg, *brg, *wre, *bre, *wg, *wu, *wd, *gf;
    float* out;
    unsigned char* ws;
};
using pg8::Unit;

struct DenseOrder {
    int nM, nN, G, c;
    __device__ __forceinline__ bool next(int i, Unit& u) const { const int L = i * G + c; if (L >= nM * nN) return false; u.pm = L / nN; u.pn = L % nN; u.pb = u.pn; return true; }
};
struct GroupedOrder {
    const int* tile_e; int ntiles, nN, G, c;
    __device__ __forceinline__ bool next(int i, Unit& u) const { const int L = i * G + c; if (L >= ntiles * nN) return false; u.pm = L / nN; u.pn = L % nN; u.pb = tile_e[u.pm] * nN + u.pn; return true; }
};

template <bool DUAL, class Sched, class Epi>
__device__ __forceinline__ void naive_gemm(Frame& F, const bf16* A, const bf16* Bt, int K, const Sched& S, const Epi& E) {
    float* As = (float*)F.lds; float* Bs = As + 32 * 68; float* Bs2 = Bs + 32 * 68;
    const int tid = F.tid, ty = tid >> 4, tx = tid & 15, lr = tid >> 3, lk = (tid & 7) * 4;
    Unit u;
    for (int i = 0; S.next(i, u); ++i) {
        for (int sm = 0; sm < 4; ++sm)
            for (int sn = 0; sn < (DUAL ? 2 : 4); ++sn) {
                float acc[2][4], acc2[2][4];
#pragma unroll
                for (int a = 0; a < 2; ++a)
#pragma unroll
                    for (int b = 0; b < 4; ++b) { acc[a][b] = 0.f; acc2[a][b] = 0.f; }
                const bf16* ap = A + (size_t)(256 * u.pm + 64 * sm + lr) * K + lk;
                const bf16* bp = Bt + (size_t)(256 * u.pb + 64 * sn + lr) * K + lk;
                for (int k0 = 0; k0 < K; k0 += 32) {
                    __syncthreads();
                    { const v2u w = *(const v2u*)(ap + k0); As[(lk + 0) * 68 + lr] = bflo(w.x); As[(lk + 1) * 68 + lr] = bfhi(w.x); As[(lk + 2) * 68 + lr] = bflo(w.y); As[(lk + 3) * 68 + lr] = bfhi(w.y); }
                    { const v2u w = *(const v2u*)(bp + k0); Bs[(lk + 0) * 68 + lr] = bflo(w.x); Bs[(lk + 1) * 68 + lr] = bfhi(w.x); Bs[(lk + 2) * 68 + lr] = bflo(w.y); Bs[(lk + 3) * 68 + lr] = bfhi(w.y); }
                    if (DUAL) { const v2u w = *(const v2u*)(bp + (size_t)128 * K + k0); Bs2[(lk + 0) * 68 + lr] = bflo(w.x); Bs2[(lk + 1) * 68 + lr] = bfhi(w.x); Bs2[(lk + 2) * 68 + lr] = bflo(w.y); Bs2[(lk + 3) * 68 + lr] = bfhi(w.y); }
                    __syncthreads();
#pragma unroll 8
                    for (int k = 0; k < 32; ++k) {
                        const float a0 = As[k * 68 + 2 * ty], a1 = As[k * 68 + 2 * ty + 1];
                        const f32x4 b = *(const f32x4*)(Bs + k * 68 + 4 * tx);
#pragma unroll
                        for (int j = 0; j < 4; ++j) { acc[0][j] += a0 * b[j]; acc[1][j] += a1 * b[j]; }
                        if (DUAL) { const f32x4 b2 = *(const f32x4*)(Bs2 + k * 68 + 4 * tx);
#pragma unroll
                            for (int j = 0; j < 4; ++j) { acc2[0][j] += a0 * b2[j]; acc2[1][j] += a1 * b2[j]; } }
                    }
                }
#pragma unroll
                for (int a = 0; a < 2; ++a)
#pragma unroll
                    for (int j = 0; j < 4; ++j) {
                        const int row = 256 * u.pm + 64 * sm + 2 * ty + a;
                        if (DUAL) E.elem(row, 128 * u.pn + 64 * sn + 4 * tx + j, silu_f(acc[a][j]) * acc2[a][j]);
                        else E.elem(row, 256 * u.pn + 64 * sn + 4 * tx + j, acc[a][j]);
                    }
            }
    }
    __syncthreads();
}
struct NEpiBf16 { bf16* O; int ldc; __device__ __forceinline__ void elem(int row, int col, float v) const { O[(size_t)row * ldc + col] = (bf16)f2bf(v); } };
struct NEpiResF32 { const float* base; float* O; int ldc; __device__ __forceinline__ void elem(int row, int col, float v) const { const size_t o = (size_t)row * ldc + col; O[o] = base[o] + v; } };
struct NEpiScatter { const int* stok; const float* sw; bf16* Y; __device__ __forceinline__ void elem(int row, int col, float v) const { const int tk = stok[row]; if (tk >= 0) Y[(size_t)tk * D + col] = (bf16)f2bf(v * sw[row]); } };

__device__ __forceinline__ void p0_transpose_item(const float* W, int K, int N, bf16* WT, int k0, int n0, int dstrow0, float scale, float* scr, int lane) {
#pragma unroll 8
    for (int i = 0; i < 32; ++i) { const int kk = 2 * i + (lane >> 5); scr[kk * 33 + (lane & 31)] = W[(size_t)(k0 + kk) * N + n0 + (lane & 31)] * scale; }
    LDS_WAIT(); asm volatile("" ::: "memory");
    const int c = lane & 7;
#pragma unroll
    for (int j = 0; j < 4; ++j) { const int n = (lane >> 3) + 8 * j; const float* s = scr + (8 * c) * 33 + n;
        v4u o; o.x = pk2(s[0 * 33], s[1 * 33]); o.y = pk2(s[2 * 33], s[3 * 33]); o.z = pk2(s[4 * 33], s[5 * 33]); o.w = pk2(s[6 * 33], s[7 * 33]);
        *(v4u*)(WT + (size_t)(dstrow0 + n) * K + k0 + 8 * c) = o; }
    LDS_WAIT(); asm volatile("" ::: "memory");
}
__device__ __forceinline__ void rms_row_to_bf16(const float* xrow, const float* g, bf16* orow, int lane) {
    const f32x4* xr = (const f32x4*)xrow + lane; const f32x4* gr = (const f32x4*)g + lane;
    f32x4 v[4]; float s = 0.f;
#pragma unroll
    for (int j = 0; j < 4; ++j) { v[j] = xr[64 * j]; s += (v[j].x * v[j].x + v[j].y * v[j].y) + (v[j].z * v[j].z + v[j].w * v[j].w); }
    const float rstd = 1.f / sqrtf(wave_sum(s) * (1.f / D) + EPS);
    unsigned long long* o8 = (unsigned long long*)orow + lane;
#pragma unroll
    for (int j = 0; j < 4; ++j) { const f32x4 gg = gr[64 * j];
        o8[64 * j] = (unsigned long long)pk2(v[j].x * rstd * gg.x, v[j].y * rstd * gg.y) | ((unsigned long long)pk2(v[j].z * rstd * gg.z, v[j].w * rstd * gg.w) << 32); }
}
__device__ __forceinline__ void p0_prologue(Frame& F) {
    float* scr = (float*)(F.lds + F.wave * 16384);
    const int gw = F.bid * NWAVES + F.wave, NGW = F.G * NWAVES;
    bf16* WinT = (bf16*)(F.ws + WS_WIN); bf16* WoutT = (bf16*)(F.ws + WS_WOUT);
    constexpr int I_IN = 16 * 96, I_OUT = 16 * 32, NITEMS = I_IN + I_OUT;
    for (int it = gw; it < NITEMS; it += NGW) {
        int r = it;
        if (r < I_IN) { const int kb = r / 96, nb = r % 96, n0 = 32 * nb; const float sc = (n0 < C_KDA) ? C2 : ((n0 >= C_KR && n0 < C_VR) ? 0.125f : 1.f);
            p0_transpose_item(F.w_in, D, NIN, WinT, 64 * kb, n0, n0, sc, scr, F.lane); continue; }
        r -= I_IN;
        { const int kb = r / 32, nb = r % 32; p0_transpose_item(F.w_out, D, D, WoutT, 64 * kb, 32 * nb, 32 * nb, 1.f, scr, F.lane); }
    }
    float* WrT = (float*)(F.ws + WS_WRT);
    for (int i = F.bid * 512 + F.tid; i < NRT * D; i += F.G * 512) { const int c = i / D, k = i % D; WrT[i] = (c < 4) ? F.wrg[k * 4 + c] : F.wre[k * 32 + (c - 4)]; }
    bf16* XN1 = (bf16*)(F.ws + WS_A);
    for (int m = gw; m < T; m += NGW) rms_row_to_bf16(F.x + (size_t)m * D, F.g1, XN1 + (size_t)m * D, F.lane);
}

__device__ __forceinline__ void convert_experts(Frame& F) {
    float* scr = (float*)(F.lds + F.wave * 16384);
    const int gw = F.bid * NWAVES + F.wave, NGW = F.G * NWAVES;
    bf16* WguT = (bf16*)(F.ws + WS_WGU); bf16* WdT = (bf16*)(F.ws + WS_WD);
    constexpr int I_E = 768;
    for (int it = gw; it < NE * I_E; it += NGW) {
        const int e = it / I_E; int r = it % I_E;
        if (r < 256) { const int kb = r / 16, nb = r % 16, n0 = 32 * nb; p0_transpose_item(F.wg + (size_t)e * D * HIDN, D, HIDN, WguT + (size_t)e * 1024 * D, 64 * kb, n0, 256 * (n0 >> 7) + (n0 & 127), 1.f, scr, F.lane); continue; }
        r -= 256;
        if (r < 256) { const int kb = r / 16, nb = r % 16, n0 = 32 * nb; p0_transpose_item(F.wu + (size_t)e * D * HIDN, D, HIDN, WguT + (size_t)e * 1024 * D, 64 * kb, n0, 256 * (n0 >> 7) + 128 + (n0 & 127), 1.f, scr, F.lane); continue; }
        r -= 256;
        { const int kb = r / 32, nb = r % 32; p0_transpose_item(F.wd + (size_t)e * HIDN * D, HIDN, D, WdT + (size_t)e * D * HIDN, 64 * kb, 32 * nb, 32 * nb, 1.f, scr, F.lane); }
    }
}

namespace da {
using bf16x8 = __attribute__((ext_vector_type(8))) short;
using s16x4  = __attribute__((ext_vector_type(4))) short;
using f32x16 = __attribute__((ext_vector_type(16))) float;
using u32x4  = __attribute__((ext_vector_type(4))) unsigned;
constexpr int KVBLK = 64;
constexpr int SHM_V = KVBLK * 128 * 2, SHM_K = KVBLK * 128 * 2;
constexpr float THR = 8.f;
#ifndef DA_SDEPTH
#define DA_SDEPTH 1
#endif
#define DA_KSWZ(row, colB) ((row) * 256 + ((colB) ^ (((row) & 7) << 4)))
#define DA_SBAR() __builtin_amdgcn_sched_barrier(0)
__device__ __forceinline__ int crow(int r, int hi) { return (r & 3) + 8 * (r >> 2) + 4 * hi; }
__device__ __forceinline__ unsigned cvtpk(float lo, float hi) { unsigned r; asm volatile("v_cvt_pk_bf16_f32 %0, %1, %2" : "=v"(r) : "v"(lo), "v"(hi)); return r; }
__device__ __forceinline__ void partialSM(f32x16& p0, f32x16& p1, float& m_reg, float& mn, float& alpha, float dq, float nslope2, bool masked) {
#pragma unroll
  for (int r = 0; r < 16; ++r) { const float c = (float)((r & 3) + 8 * (r >> 2)); p0[r] = fmaf(nslope2, fabsf(dq - c), p0[r]); p1[r] = fmaf(nslope2, fabsf(dq - 32.f - c), p1[r]); }
  if (masked) {
#pragma unroll
    for (int r = 0; r < 16; ++r) { p0[r] = -INFINITY; p1[r] = -INFINITY; } }
  float pmax = p0[0];
#pragma unroll
  for (int r = 1; r < 16; ++r) pmax = fmaxf(pmax, p0[r]);
#pragma unroll
  for (int r = 0; r < 16; ++r) pmax = fmaxf(pmax, p1[r]);
  { auto rr = __builtin_amdgcn_permlane32_swap(__float_as_uint(pmax), __float_as_uint(pmax), false, false);
    pmax = fmaxf(__uint_as_float(rr[0]), __uint_as_float(rr[1])); }
  if (__builtin_expect(__all(pmax - m_reg <= THR), 1)) { mn = m_reg; alpha = 1.f; }
  else { mn = fmaxf(m_reg, pmax); alpha = __builtin_amdgcn_exp2f(m_reg - mn); m_reg = mn; }
#pragma unroll
  for (int r = 0; r < 16; ++r) { p0[r] -= mn; p1[r] -= mn; }
#pragma unroll
  for (int r = 0; r < 16; ++r) p0[r] = __builtin_amdgcn_exp2f(p0[r]);
}
__device__ __forceinline__ void finishSM(f32x16& p0, f32x16& p1, float alpha, float& l_reg, bf16x8& pa0, bf16x8& pa1, bf16x8& pa2, bf16x8& pa3) {
#pragma unroll
  for (int r = 0; r < 16; ++r) p1[r] = __builtin_amdgcn_exp2f(p1[r]);
  float ps = 0;
#pragma unroll
  for (int r = 0; r < 16; ++r) ps += p0[r];
#pragma unroll
  for (int r = 0; r < 16; ++r) ps += p1[r];
  { auto rr = __builtin_amdgcn_permlane32_swap(__float_as_uint(ps), __float_as_uint(ps), false, false);
    ps = __uint_as_float(rr[0]) + __uint_as_float(rr[1]); }
  l_reg = l_reg * alpha + ps;
#define DA_PK4(P, BASE, OUT) do { unsigned a0 = cvtpk(P[BASE + 0], P[BASE + 1]), a1 = cvtpk(P[BASE + 2], P[BASE + 3]);   \
    unsigned b0 = cvtpk(P[BASE + 4], P[BASE + 5]), b1 = cvtpk(P[BASE + 6], P[BASE + 7]);                              \
    auto r0 = __builtin_amdgcn_permlane32_swap(a0, b0, false, false); auto r1 = __builtin_amdgcn_permlane32_swap(a1, b1, false, false); \
    u32x4 w = {r0[0], r1[0], r0[1], r1[1]}; OUT = *reinterpret_cast<bf16x8*>(&w); } while (0)
  DA_PK4(p0, 0, pa0); DA_PK4(p0, 8, pa1); DA_PK4(p1, 0, pa2); DA_PK4(p1, 8, pa3);
#undef DA_PK4
}
__device__ __forceinline__ void qkt(f32x16& p0, f32x16& p1, const char* Ks, const bf16x8* qr, int r32, int hi, int mp) {
  p0 = f32x16{}; p1 = f32x16{};
#pragma unroll
  for (int d0 = 0; d0 < 4; ++d0) { const int cb = (mp * 64 + d0 * 16 + hi * 8) * 2;
    const bf16x8 b0 = *reinterpret_cast<const bf16x8*>(Ks + DA_KSWZ(r32, cb));
    const bf16x8 b1 = *reinterpret_cast<const bf16x8*>(Ks + DA_KSWZ(32 + r32, cb));
    p0 = __builtin_amdgcn_mfma_f32_32x32x16_bf16(b0, qr[d0], p0, 0, 0, 0);
    p1 = __builtin_amdgcn_mfma_f32_32x32x16_bf16(b1, qr[d0], p1, 0, 0, 0); }
}
__device__ __forceinline__ int v_st(int k, int c) { const int kk = (k & ~0xC) | ((k & 4) << 1) | ((k & 8) >> 1); return ((kk >> 3) * 4 + (c >> 5)) * 512 + ((kk & 7) * 32 + (c & 31)) * 2; }
__device__ __forceinline__ int v_rd_base(int lane) { return ((lane & 3) << 3) | (((lane >> 2) & 3) << 6) | (((lane >> 4) & 1) << 5) | (((lane >> 5) & 1) << 8); }
constexpr int v_rd_off(int d0, int ks, int half) { return d0 * 512 + ks * 4096 + half * 2048; }
template <int OFF> __device__ __forceinline__ s16x4 tr_read(int vb) {
  s16x4 r; asm volatile("ds_read_b64_tr_b16 %0, %1 offset:%2" : "=&v"(r) : "v"(vb), "i"(OFF) : "memory"); return r;
}
template <int D0> __device__ __forceinline__ void pv_one(f32x16& od, int vb, bf16x8 pa0, bf16x8 pa1, bf16x8 pa2, bf16x8 pa3) {
  const s16x4 l0 = tr_read<v_rd_off(D0, 0, 0)>(vb), h0 = tr_read<v_rd_off(D0, 0, 1)>(vb), l1 = tr_read<v_rd_off(D0, 1, 0)>(vb), h1 = tr_read<v_rd_off(D0, 1, 1)>(vb);
  const s16x4 l2 = tr_read<v_rd_off(D0, 2, 0)>(vb), h2 = tr_read<v_rd_off(D0, 2, 1)>(vb), l3 = tr_read<v_rd_off(D0, 3, 0)>(vb), h3 = tr_read<v_rd_off(D0, 3, 1)>(vb);
  asm volatile("s_waitcnt lgkmcnt(0)" ::: "memory"); DA_SBAR();
#define DA_PK(L, H) (bf16x8){L[0], L[1], L[2], L[3], H[0], H[1], H[2], H[3]}
  od = __builtin_amdgcn_mfma_f32_32x32x16_bf16(pa0, DA_PK(l0, h0), od, 0, 0, 0);
  od = __builtin_amdgcn_mfma_f32_32x32x16_bf16(pa1, DA_PK(l1, h1), od, 0, 0, 0);
  od = __builtin_amdgcn_mfma_f32_32x32x16_bf16(pa2, DA_PK(l2, h2), od, 0, 0, 0);
  od = __builtin_amdgcn_mfma_f32_32x32x16_bf16(pa3, DA_PK(l3, h3), od, 0, 0, 0);
#undef DA_PK
}
__device__ __forceinline__ void pv_d0(f32x16* o, int vb, bf16x8 pa0, bf16x8 pa1, bf16x8 pa2, bf16x8 pa3) {
  pv_one<0>(o[0], vb, pa0, pa1, pa2, pa3); pv_one<1>(o[1], vb, pa0, pa1, pa2, pa3); pv_one<2>(o[2], vb, pa0, pa1, pa2, pa3); pv_one<3>(o[3], vb, pa0, pa1, pa2, pa3);
}
__device__ __forceinline__ void attn_piece(const unsigned short* __restrict__ PROJ, unsigned short* __restrict__ MIX, const float* __restrict__ subg, unsigned short* __restrict__ PO, float* __restrict__ PS, int h, int u, int jlo, int jhi, int slot, float lam, float slope2, char* lds) {
  const int tid = threadIdx.x, wid = __builtin_amdgcn_readfirstlane(tid >> 6), lane = tid & 63, r32 = lane & 31, hi = lane >> 5, rg = wid & 3, mp = wid >> 2;
  const int q0 = 128 * u, NT = 2 * u + 2;
  constexpr int LDK = NIN;
  const char* kbase = (const char*)(PROJ + C_KDA + h * 128);
  char* V_lds = lds; char* K_lds = lds + 3 * SHM_V;
  LAS char* V_l3 = (LAS char*)lds; LAS char* K_l3 = (LAS char*)lds + 3 * SHM_V;
  float* ws = (float*)(lds + 3 * SHM_V + 2 * SHM_K) + wid * 64; float* li_l = ws; float* al_l = ws + 32;
  float m_reg = -1e30f, l_reg = 0; f32x16 o[4] = {}; bf16x8 qr[4];
  const int qpos = q0 + 32 * rg + r32;
  { const char* qb = (const char*)PROJ + ((size_t)(q0 + 32 * rg) * LDK + C_QDA + h * 128 + mp * 64) * 2;
    const unsigned qo = (unsigned)((r32 * LDK + hi * 8) * 2);
#pragma unroll
    for (int d0 = 0; d0 < 4; ++d0) qr[d0] = *reinterpret_cast<const bf16x8*>(qb + qo + d0 * 32); }
  const float nslope2 = -slope2; const bool mask0 = (rg < 2) && (jlo == 0);
  const int vb0 = (int)(uintptr_t)V_lds + v_rd_base(lane);
  int kb_cur = 0, vs_cur = 0;
#define DQ(jj) ((float)(qpos - (NT - 1 - (jj)) * KVBLK - 4 * hi))
#define DMA_TILE(jj, kbo, vso) do { const char* gt_ = kbase + (size_t)(NT - 1 - (jj)) * (size_t)(KVBLK * LDK * 2); int l_ = lane; asm volatile("" : "+v"(l_)); \
    _Pragma("unroll") for (int i_ = 0; i_ < 2; ++i_) { \
      const int row_ = 8 * wid + 4 * i_ + (l_ >> 4), c_ = (l_ & 15) ^ (row_ & 7); \
      const int st_ = 4 * wid + 2 * i_ + (l_ >> 5), kk_ = 8 * (st_ >> 2) + ((l_ & 31) >> 2), k_ = (kk_ & ~0xC) | ((kk_ & 4) << 1) | ((kk_ & 8) >> 1), cc_ = 32 * (st_ & 3) + 8 * (l_ & 3); \
      __builtin_amdgcn_global_load_lds((const unsigned*)(gt_ + (unsigned)(row_ * LDK * 2 + c_ * 16)), (LAS unsigned*)(K_l3 + (kbo) + wid * 2048 + i_ * 1024), 16, 0, 0); \
      __builtin_amdgcn_global_load_lds((const unsigned*)(gt_ + (unsigned)(k_ * LDK * 2 + cc_ * 2 + (C_VDA - C_KDA) * 2)), (LAS unsigned*)(V_l3 + (vso) + wid * 2048 + i_ * 1024), 16, 0, 0); } } while (0)
#define STEP_SYNC() do { asm volatile("s_waitcnt vmcnt(0)" ::: "memory"); __syncthreads(); } while (0)
#define RESC(a) do { if (__any((a) < 1.f)) { if (hi == 0) al_l[r32] = (a); asm volatile("s_waitcnt lgkmcnt(0)" ::: "memory"); \
    _Pragma("unroll") for (int d = 0; d < 4; ++d) _Pragma("unroll") for (int r = 0; r < 16; ++r) o[d][r] *= al_l[crow(r, hi)]; } } while (0)
#define NEXT_K(x) ((x) ^ SHM_K)
#define NEXT_V(x) ((x) == 2 * SHM_V ? 0 : (x) + SHM_V)
  f32x16 pA0, pA1, pB0, pB1; float mnA, mnB, alA, alB; bf16x8 pa0, pa1, pa2, pa3;
  __syncthreads();
  DMA_TILE(jlo, 0, 0); STEP_SYNC();
  if (jlo + 1 < jhi) DMA_TILE(jlo + 1, SHM_K, SHM_V);
  qkt(pA0, pA1, K_lds, qr, r32, hi, mp); partialSM(pA0, pA1, m_reg, mnA, alA, DQ(jlo), nslope2, mask0);
  STEP_SYNC();
#define STEP(X0, X1, mnX, alX, Y0, Y1, alY, jj) do { \
    const int kb_n = NEXT_K(kb_cur), vs_n = NEXT_V(vs_cur); \
    if ((jj) + 1 < jhi) DMA_TILE((jj) + 1, kb_cur, NEXT_V(vs_n));        \
    DA_SBAR(); qkt(X0, X1, K_lds + kb_n, qr, r32, hi, mp); \
    finishSM(Y0, Y1, alY, l_reg, pa0, pa1, pa2, pa3); DA_SBAR(); \
    pv_d0(o, vb0 + vs_cur, pa0, pa1, pa2, pa3); partialSM(X0, X1, m_reg, mnX, alX, DQ(jj), nslope2, false); \
    STEP_SYNC(); RESC(alX); kb_cur = kb_n; vs_cur = vs_n; } while (0)
  int jj = jlo + 1;
  while (jj + 1 < jhi) { STEP(pB0, pB1, mnB, alB, pA0, pA1, alA, jj); STEP(pA0, pA1, mnA, alA, pB0, pB1, alB, jj + 1); jj += 2; }
  if (jj < jhi) { STEP(pB0, pB1, mnB, alB, pA0, pA1, alA, jj);
    finishSM(pB0, pB1, alB, l_reg, pa0, pa1, pa2, pa3); DA_SBAR(); pv_d0(o, vb0 + vs_cur, pa0, pa1, pa2, pa3); }
  else { finishSM(pA0, pA1, alA, l_reg, pa0, pa1, pa2, pa3); DA_SBAR(); pv_d0(o, vb0 + vs_cur, pa0, pa1, pa2, pa3); }
#undef STEP
  if (hi == 0) li_l[r32] = l_reg; asm volatile("s_waitcnt lgkmcnt(0)" ::: "memory");
  float rli[16];
  if (slot >= 0) {
#pragma unroll
    for (int r = 0; r < 16; ++r) { const float lv = li_l[crow(r, hi)]; rli[r] = lv > 0.f ? __builtin_amdgcn_rcpf(lv) : 0.f; }
    int hi3 = hi, c33 = r32; asm volatile("" : "+v"(hi3), "+v"(c33));
    char* Pw = (char*)PO + ((size_t)((slot * 2 + mp) * 128 + 32 * rg) * 128) * 2;
#pragma unroll
    for (int r = 0; r < 16; ++r) { const unsigned oo = (unsigned)((crow(r, hi3) * 128 + c33) * 2);
#pragma unroll
      for (int d0 = 0; d0 < 4; ++d0) *(unsigned short*)(Pw + oo + d0 * 64) = (unsigned short)f2bf(o[d0][r] * rli[r]); }
    if (hi3 == 0) { float* st = PS + ((size_t)(slot * 2 + mp) * 128 + 32 * rg + c33) * 2; st[0] = m_reg; st[1] = l_reg; }
    return;
  }
#pragma unroll
  for (int r = 0; r < 16; ++r) rli[r] = (mp ? lam : 1.f) * __builtin_amdgcn_rcpf(li_l[crow(r, hi)]);
  __syncthreads();
  int hi2 = hi, c32 = r32; asm volatile("" : "+v"(hi2), "+v"(c32));
  float* X1 = (float*)lds + (rg * 32) * 128;
  if (mp == 1) {
#pragma unroll
    for (int r = 0; r < 16; ++r)
#pragma unroll
      for (int d0 = 0; d0 < 4; ++d0) X1[crow(r, hi2) * 128 + d0 * 32 + c32] = o[d0][r] * rli[r];
  }
  __syncthreads();
  if (mp == 0) {
    float ss[16];
#pragma unroll
    for (int r = 0; r < 16; ++r) { float s = 0.f;
#pragma unroll
      for (int d0 = 0; d0 < 4; ++d0) { const float dv = o[d0][r] * rli[r] - X1[crow(r, hi2) * 128 + d0 * 32 + c32]; o[d0][r] = dv; s += dv * dv; }
      ss[r] = s; }
#pragma unroll
    for (int r = 0; r < 16; ++r) {
#pragma unroll
      for (int off = 1; off < 32; off <<= 1) ss[r] += __shfl_xor(ss[r], off);
      ss[r] = (1.f - LAMBDA_INIT) / sqrtf(ss[r] * (1.f / 128.f) + EPS); }
    float gsub[4];
#pragma unroll
    for (int d0 = 0; d0 < 4; ++d0) gsub[d0] = subg[d0 * 32 + c32];
    char* Ow = (char*)MIX + ((size_t)(q0 + 32 * rg) * D + h * 128) * 2;
#pragma unroll
    for (int r = 0; r < 16; ++r) { const unsigned oo = (unsigned)((crow(r, hi2) * D + c32) * 2);
#pragma unroll
      for (int d0 = 0; d0 < 4; ++d0) *(unsigned short*)(Ow + oo + d0 * 64) = (unsigned short)f2bf(o[d0][r] * ss[r] * gsub[d0]); }
  }
#undef DQ
#undef DMA_TILE
#undef STEP_SYNC
#undef RESC
#undef NEXT_K
#undef NEXT_V
}

constexpr float SKIP_TH = 40.f;
struct ItemTab { int* hdr; int* NP; int* SOFF; int* TA; int* TB; int* SC; };
__device__ __forceinline__ ItemTab item_ptrs(char* lds) { ItemTab t; t.hdr = (int*)(lds + ITEM_OFF); t.NP = t.hdr + 16; t.SOFF = t.NP + 512; t.TA = t.SOFF + 512; t.TB = t.TA + 1536; t.SC = t.TB + 1536; return t; }
__device__ __forceinline__ int block_scan_incl(int v, int* sc, int tid) {
  sc[tid] = v; __syncthreads();
  for (int off = 1; off < 512; off <<= 1) { const int a = tid >= off ? sc[tid - off] : 0; __syncthreads(); sc[tid] += a; __syncthreads(); }
  return sc[tid];
}
__device__ __forceinline__ void build_items(const unsigned* norm, char* lds) {
  const ItemTab T = item_ptrs(lds); const int tid = threadIdx.x;
  __syncthreads();
  if (tid < 4) { float B = 0.f;
    for (int m = 0; m < 2; ++m) { const int qb = tid * 2 + m;
      const float q2 = __uint_as_float(__hip_atomic_load(norm + qb * 2, RLX_AGENT)) + __uint_as_float(__hip_atomic_load(norm + qb * 2 + 1, RLX_AGENT));
      const float k2 = __uint_as_float(__hip_atomic_load(norm + (8 + qb) * 2, RLX_AGENT)) + __uint_as_float(__hip_atomic_load(norm + (8 + qb) * 2 + 1, RLX_AGENT));
      B = fmaxf(B, sqrtf(q2 * k2)); }
    B *= 1.02f;
    const float slope2 = exp2f(-2.f * (float)(tid + 1)) * LOG2E, dw = (2.f * B + SKIP_TH) / slope2;
    float jf = ceilf((dw + 127.f) * (1.f / 64.f)) + 1.f; jf = fminf(fmaxf(jf, 3.f), 256.f);
    T.hdr[4 + tid] = (int)jf; }
  __syncthreads();
  const int h = 3 - (tid >> 7), u = 127 - (tid & 127);
  const int J = min(2 * u + 2, T.hdr[4 + h]);
  const int total = block_scan_incl(J, T.SC, tid); __syncthreads();
  const int tot = T.SC[511]; __syncthreads();
  const int pmax = max(24, (tot + 767) / 768), np = (J + pmax - 1) / pmax;
  const int off = block_scan_incl(np, T.SC, tid) - np; __syncthreads();
  const int N = T.SC[511]; __syncthreads();
  const int so = block_scan_incl(np > 1 ? np : 0, T.SC, tid) - (np > 1 ? np : 0); __syncthreads();
  (void)total;
  T.NP[tid] = np; T.SOFF[tid] = np > 1 ? so : -1;
  for (int k = 0; k < np; ++k) { T.TA[off + k] = h | (u << 2) | (k << 9) | (np << 13); T.TB[off + k] = np > 1 ? so + k : -1; }
  if (tid == 0) { T.hdr[0] = N; T.hdr[1] = pmax; }
  __syncthreads();
}
__device__ __forceinline__ void attn_combine_unit(const unsigned short* __restrict__ PO, const float* __restrict__ PS, unsigned short* __restrict__ MIX, const float* __restrict__ subg, int h, int u, int np, int slot0, float lam) {
  const int tid = threadIdx.x, row = tid >> 2, cq = tid & 3;
  float val[2][32];
#pragma unroll
  for (int mp = 0; mp < 2; ++mp) {
    float mmax = -1e30f;
    for (int p = 0; p < np; ++p) mmax = fmaxf(mmax, PS[((size_t)((slot0 + p) * 2 + mp) * 128 + row) * 2]);
    float W = 0.f;
#pragma unroll
    for (int i = 0; i < 32; ++i) val[mp][i] = 0.f;
    for (int p = 0; p < np; ++p) { const float* st = PS + ((size_t)((slot0 + p) * 2 + mp) * 128 + row) * 2; const float w = st[1] * exp2f(st[0] - mmax); W += w;
      const v4u* src = (const v4u*)(PO + ((size_t)((slot0 + p) * 2 + mp) * 128 + row) * 128 + 32 * cq);
#pragma unroll
      for (int c = 0; c < 4; ++c) { const v4u a = src[c]; float* d = &val[mp][8 * c];
        d[0] += w * bflo(a.x); d[1] += w * bfhi(a.x); d[2] += w * bflo(a.y); d[3] += w * bfhi(a.y); d[4] += w * bflo(a.z); d[5] += w * bfhi(a.z); d[6] += w * bflo(a.w); d[7] += w * bfhi(a.w); } }
    const float rw = (mp ? lam : 1.f) / W;
#pragma unroll
    for (int i = 0; i < 32; ++i) val[mp][i] *= rw; }
  float ss = 0.f;
#pragma unroll
  for (int i = 0; i < 32; ++i) { val[0][i] -= val[1][i]; ss += val[0][i] * val[0][i]; }
  ss += __shfl_xor(ss, 1); ss += __shfl_xor(ss, 2);
  const float rstd = (1.f - LAMBDA_INIT) / sqrtf(ss * (1.f / 128.f) + EPS);
  unsigned w[16];
#pragma unroll
  for (int i = 0; i < 16; ++i) w[i] = pk2(val[0][2 * i] * rstd * subg[32 * cq + 2 * i], val[0][2 * i + 1] * rstd * subg[32 * cq + 2 * i + 1]);
  v4u* dst = (v4u*)(MIX + (size_t)(128 * u + row) * D + h * 128 + 32 * cq);
#pragma unroll
  for (int c = 0; c < 4; ++c) dst[c] = (v4u){w[4 * c], w[4 * c + 1], w[4 * c + 2], w[4 * c + 3]};
}
}


__device__ __forceinline__ void p2_attention(Frame& F) {
    float a = 0.f, b = 0.f;
#pragma unroll 1
    for (int i = 0; i < 64; ++i) { a += F.lq1[i] * F.lk1[i]; b += F.lq2[i] * F.lk2[i]; }
    const float lam = __expf(a) - __expf(b) + LAMBDA_INIT;
    da::build_items(F.ctl + CW_NORM, (char*)F.lds);
    const da::ItemTab IT = da::item_ptrs((char*)F.lds);
    const int N = IT.hdr[0];
    for (;;) {
        __syncthreads();
        if (F.tid == 0) IT.hdr[8] = (int)__hip_atomic_fetch_add(F.ctl + CW_QHEAD, 1u, RLX_AGENT);
        __syncthreads();
        const int it = IT.hdr[8];
        if (it >= N) break;
        const int a = IT.TA[it], slot = IT.TB[it], h = a & 3, u = (a >> 2) & 127, k = (a >> 9) & 15, np = (a >> 13) & 15;
        const int J = min(2 * u + 2, IT.hdr[4 + h]);
        const float slope2 = exp2f(-2.f * (float)(h + 1)) * LOG2E;
        da::attn_piece((const bf16*)(F.ws + WS_PROJ), (bf16*)(F.ws + WS_A), F.subg, (bf16*)(F.ws + WS_PARTO), (float*)(F.ws + WS_PARTS), h, u, (k * J) / np, ((k + 1) * J) / np, slot, lam, slope2, (char*)F.lds);
    }
    __syncthreads();
}
__device__ __forceinline__ void p4_attn_combine(Frame& F) {
    float a = 0.f, b = 0.f;
#pragma unroll 1
    for (int i = 0; i < 64; ++i) { a += F.lq1[i] * F.lk1[i]; b += F.lq2[i] * F.lk2[i]; }
    const float lam = __expf(a) - __expf(b) + LAMBDA_INIT;
    da::build_items(F.ctl + CW_NORM, (char*)F.lds);
    const da::ItemTab IT = da::item_ptrs((char*)F.lds);
    for (int t = F.bid; t < 512; t += F.G) { const int np = IT.NP[t];
        if (np > 1) da::attn_combine_unit((const bf16*)(F.ws + WS_PARTO), (const float*)(F.ws + WS_PARTS), (bf16*)(F.ws + WS_A), F.subg, 3 - (t >> 7), 127 - (t & 127), np, IT.SOFF[t], lam); }
    __syncthreads();
}

namespace ret {
using da::bf16x8; using da::s16x4; using da::f32x16; using da::u32x4; using da::crow; using da::cvtpk; using da::v_st; using da::v_rd_base;
constexpr int KIMG = 8192, VIMG = 16384;
__device__ __forceinline__ int k_st(int k, int c) { const int kk = (k & ~0xC) | ((k & 4) << 1) | ((k & 8) >> 1); return ((kk >> 3) * 2 + (c >> 5)) * 512 + ((kk & 7) * 32 + (c & 31)) * 2; }
template <int OFF> __device__ __forceinline__ s16x4 tr_read(int vb) { s16x4 r; asm volatile("ds_read_b64_tr_b16 %0, %1 offset:%2" : "=&v"(r) : "v"(vb), "i"(OFF) : "memory"); return r; }
#define RT_PK(L, H) (bf16x8){L[0], L[1], L[2], L[3], H[0], H[1], H[2], H[3]}
#define RT_WAITL() do { asm volatile("s_waitcnt lgkmcnt(0)" ::: "memory"); __builtin_amdgcn_sched_barrier(0); } while (0)
__device__ __forceinline__ float lg2gamma(int h) { return log2f(1.f - exp2f(-5.f - (float)h)); }
__device__ __forceinline__ bf16x8 packS(const f32x16& S, int s) {
  u32x4 w; const int b = 8 * s; w.x = cvtpk(S[b + 0], S[b + 1]); w.y = cvtpk(S[b + 2], S[b + 3]); w.z = cvtpk(S[b + 4], S[b + 5]); w.w = cvtpk(S[b + 6], S[b + 7]); return __builtin_bit_cast(bf16x8, w); }
__device__ __forceinline__ bf16x8 scale8(bf16x8 v, float w) {
  u32x4 u = __builtin_bit_cast(u32x4, v), o;
  o.x = cvtpk(bflo(u.x) * w, bfhi(u.x) * w); o.y = cvtpk(bflo(u.y) * w, bfhi(u.y) * w); o.z = cvtpk(bflo(u.z) * w, bfhi(u.z) * w); o.w = cvtpk(bflo(u.w) * w, bfhi(u.w) * w);
  return __builtin_bit_cast(bf16x8, o); }

__device__ __forceinline__ void sweep_unit(const unsigned short* __restrict__ PROJ, float* __restrict__ OL, float* __restrict__ E, int g, int h, char* lds) {
  const int tid = threadIdx.x, wid = __builtin_amdgcn_readfirstlane(tid >> 6), lane = tid & 63, r32 = lane & 31, hi = lane >> 5, tq = wid & 1, dvq = wid >> 1;
  const float lg2 = lg2gamma(h), dec64 = exp2f(lg2 * 64.f);
  const int iq = 32 * tq + r32;
  f32x16 S0 = {}, S1 = {};
  char* Kimg = lds; char* Vimg = lds + KIMG;
  const int krow = tid >> 3, kch = (tid & 7) * 8, sr = tid >> 4, sc = (tid & 15) * 8;
  const float kdec = exp2f(lg2 * (float)(63 - krow));
  const int kst = k_st(krow, kch), vst0 = v_st(sr, sc), vst1 = v_st(32 + sr, sc);
  const int vbV = (int)(uintptr_t)Vimg + v_rd_base(lane) + dvq * 512, vbK = (int)(uintptr_t)Kimg + v_rd_base(lane);
  const int U = g * 4 + h;
#pragma unroll 1
  for (int c = 0; c < 4; ++c) {
    const int tok0 = 256 * g + 64 * c;
    const char* pb = (const char*)PROJ + (size_t)tok0 * (NIN * 2);
    __syncthreads();
    { const bf16x8 kv = *reinterpret_cast<const bf16x8*>(pb + (unsigned)((krow * NIN + C_KR + h * 64 + kch) * 2));
      const bf16x8 v0 = *reinterpret_cast<const bf16x8*>(pb + (unsigned)((sr * NIN + C_VR + h * 128 + sc) * 2));
      const bf16x8 v1 = *reinterpret_cast<const bf16x8*>(pb + (unsigned)(((32 + sr) * NIN + C_VR + h * 128 + sc) * 2));
      *(bf16x8*)(Kimg + kst) = scale8(kv, kdec); *(bf16x8*)(Vimg + vst0) = v0; *(bf16x8*)(Vimg + vst1) = v1; }
    bf16x8 kf0[4], kf1[4], qr[4], qp[2][2];
    { const unsigned ko = (unsigned)((r32 * NIN + C_KR + h * 64 + hi * 8) * 2), qo = (unsigned)((iq * NIN + C_QR + h * 64 + hi * 8) * 2), qpo = (unsigned)((iq * NIN + C_QR + h * 64 + hi * 4) * 2);
#pragma unroll
      for (int d0 = 0; d0 < 4; ++d0) { kf0[d0] = *reinterpret_cast<const bf16x8*>(pb + ko + d0 * 32); qr[d0] = *reinterpret_cast<const bf16x8*>(pb + qo + d0 * 32);
        kf1[d0] = tq ? *reinterpret_cast<const bf16x8*>(pb + ko + 32 * NIN * 2 + d0 * 32) : bf16x8{}; }
#pragma unroll
      for (int t = 0; t < 2; ++t)
#pragma unroll
        for (int s = 0; s < 2; ++s) { const v2u a = *reinterpret_cast<const v2u*>(pb + qpo + (32 * t + 16 * s) * 2), b = *reinterpret_cast<const v2u*>(pb + qpo + (32 * t + 16 * s + 8) * 2);
          const u32x4 w = {a.x, a.y, b.x, b.y}; qp[t][s] = __builtin_bit_cast(bf16x8, w); } }
    f32x16 p0 = {}, p1 = {};
#pragma unroll
    for (int d0 = 0; d0 < 4; ++d0) p0 = __builtin_amdgcn_mfma_f32_32x32x16_bf16(kf0[d0], qr[d0], p0, 0, 0, 0);
    if (tq) {
#pragma unroll
      for (int d0 = 0; d0 < 4; ++d0) p1 = __builtin_amdgcn_mfma_f32_32x32x16_bf16(kf1[d0], qr[d0], p1, 0, 0, 0); }
#pragma unroll
    for (int r = 0; r < 16; ++r) { const int d = iq - crow(r, hi), d1 = d - 32;
      p0[r] = d >= 0 ? p0[r] * __builtin_amdgcn_exp2f(lg2 * (float)d) : 0.f; p1[r] = d1 >= 0 ? p1[r] * __builtin_amdgcn_exp2f(lg2 * (float)d1) : 0.f; }
    bf16x8 pa0, pa1, pa2, pa3;
#define RT_PK4(P, BASE, OUT) do { unsigned a0 = cvtpk(P[BASE + 0], P[BASE + 1]), a1 = cvtpk(P[BASE + 2], P[BASE + 3]);   \
    unsigned b0 = cvtpk(P[BASE + 4], P[BASE + 5]), b1 = cvtpk(P[BASE + 6], P[BASE + 7]);                              \
    auto r0 = __builtin_amdgcn_permlane32_swap(a0, b0, false, false); auto r1 = __builtin_amdgcn_permlane32_swap(a1, b1, false, false); \
    u32x4 w = {r0[0], r1[0], r0[1], r1[1]}; OUT = __builtin_bit_cast(bf16x8, w); } while (0)
    RT_PK4(p0, 0, pa0); RT_PK4(p0, 8, pa1); RT_PK4(p1, 0, pa2); RT_PK4(p1, 8, pa3);
#undef RT_PK4
    __syncthreads();
    const s16x4 vl0 = tr_read<0 * 4096>(vbV), vh0 = tr_read<0 * 4096 + 2048>(vbV), vl1 = tr_read<1 * 4096>(vbV), vh1 = tr_read<1 * 4096 + 2048>(vbV);
    const s16x4 vl2 = tr_read<2 * 4096>(vbV), vh2 = tr_read<2 * 4096 + 2048>(vbV), vl3 = tr_read<3 * 4096>(vbV), vh3 = tr_read<3 * 4096 + 2048>(vbV);
    RT_WAITL();
    const bf16x8 vf0 = RT_PK(vl0, vh0), vf1 = RT_PK(vl1, vh1), vf2 = RT_PK(vl2, vh2), vf3 = RT_PK(vl3, vh3);
    f32x16 oa = {}, xa = {};
    oa = __builtin_amdgcn_mfma_f32_32x32x16_bf16(pa0, vf0, oa, 0, 0, 0); oa = __builtin_amdgcn_mfma_f32_32x32x16_bf16(pa1, vf1, oa, 0, 0, 0);
    if (tq) { oa = __builtin_amdgcn_mfma_f32_32x32x16_bf16(pa2, vf2, oa, 0, 0, 0); oa = __builtin_amdgcn_mfma_f32_32x32x16_bf16(pa3, vf3, oa, 0, 0, 0); }
    xa = __builtin_amdgcn_mfma_f32_32x32x16_bf16(qp[0][0], packS(S0, 0), xa, 0, 0, 0); xa = __builtin_amdgcn_mfma_f32_32x32x16_bf16(qp[0][1], packS(S0, 1), xa, 0, 0, 0);
    xa = __builtin_amdgcn_mfma_f32_32x32x16_bf16(qp[1][0], packS(S1, 0), xa, 0, 0, 0); xa = __builtin_amdgcn_mfma_f32_32x32x16_bf16(qp[1][1], packS(S1, 1), xa, 0, 0, 0);
    { float* ol = OL + ((size_t)(((U * 4 + c) * 2 + tq) * 4 + dvq) * 16) * 64 + lane;
#pragma unroll
      for (int r = 0; r < 16; ++r) ol[r * 64] = oa[r] + __builtin_amdgcn_exp2f(lg2 * (float)(32 * tq + crow(r, hi) + 1)) * xa[r]; }
#pragma unroll
    for (int r = 0; r < 16; ++r) { S0[r] *= dec64; S1[r] *= dec64; }
    { const s16x4 l0 = tr_read<0 * 2048>(vbK), h0 = tr_read<0 * 2048 + 1024>(vbK), l1 = tr_read<1 * 2048>(vbK), h1 = tr_read<1 * 2048 + 1024>(vbK);
      const s16x4 l2 = tr_read<2 * 2048>(vbK), h2 = tr_read<2 * 2048 + 1024>(vbK), l3 = tr_read<3 * 2048>(vbK), h3 = tr_read<3 * 2048 + 1024>(vbK);
      RT_WAITL();
      S0 = __builtin_amdgcn_mfma_f32_32x32x16_bf16(RT_PK(l0, h0), vf0, S0, 0, 0, 0); S0 = __builtin_amdgcn_mfma_f32_32x32x16_bf16(RT_PK(l1, h1), vf1, S0, 0, 0, 0);
      S0 = __builtin_amdgcn_mfma_f32_32x32x16_bf16(RT_PK(l2, h2), vf2, S0, 0, 0, 0); S0 = __builtin_amdgcn_mfma_f32_32x32x16_bf16(RT_PK(l3, h3), vf3, S0, 0, 0, 0); }
    { const s16x4 l0 = tr_read<512 + 0 * 2048>(vbK), h0 = tr_read<512 + 0 * 2048 + 1024>(vbK), l1 = tr_read<512 + 1 * 2048>(vbK), h1 = tr_read<512 + 1 * 2048 + 1024>(vbK);
      const s16x4 l2 = tr_read<512 + 2 * 2048>(vbK), h2 = tr_read<512 + 2 * 2048 + 1024>(vbK), l3 = tr_read<512 + 3 * 2048>(vbK), h3 = tr_read<512 + 3 * 2048 + 1024>(vbK);
      RT_WAITL();
      S1 = __builtin_amdgcn_mfma_f32_32x32x16_bf16(RT_PK(l0, h0), vf0, S1, 0, 0, 0); S1 = __builtin_amdgcn_mfma_f32_32x32x16_bf16(RT_PK(l1, h1), vf1, S1, 0, 0, 0);
      S1 = __builtin_amdgcn_mfma_f32_32x32x16_bf16(RT_PK(l2, h2), vf2, S1, 0, 0, 0); S1 = __builtin_amdgcn_mfma_f32_32x32x16_bf16(RT_PK(l3, h3), vf3, S1, 0, 0, 0); }
  }
  if (tq == 0) { float* e = E + (size_t)U * 8192 + 32 * dvq + r32;
#pragma unroll
    for (int r = 0; r < 16; ++r) { e[(crow(r, hi)) * 128] = S0[r]; e[(32 + crow(r, hi)) * 128] = S1[r]; } }
}

__device__ __forceinline__ void out_unit(const unsigned short* __restrict__ PROJ, const float* __restrict__ OL, const float* __restrict__ E, unsigned short* __restrict__ MIX, int g, int h, char* lds) {
  const int tid = threadIdx.x, wid = __builtin_amdgcn_readfirstlane(tid >> 6), lane = tid & 63, r32 = lane & 31, hi = lane >> 5, c = wid >> 1, tq = wid & 1;
  const float lg2 = lg2gamma(h);
  const int U = g * 4 + h;
  __syncthreads();
  { const f32x4* cg = (const f32x4*)(E + (size_t)U * 8192) + tid;
#pragma unroll
    for (int i = 0; i < 4; ++i) { const f32x4 a = cg[512 * i]; const int flat = 4 * (tid + 512 * i), dk = flat >> 7, col = flat & 127;
      *(v2u*)(lds + v_st(dk, col)) = (v2u){cvtpk(a.x, a.y), cvtpk(a.z, a.w)}; } }
  __syncthreads();
  const int tok0 = 256 * g + 64 * c + 32 * tq;
  bf16x8 qr[4];
  { const char* qb = (const char*)PROJ + ((size_t)tok0 * NIN + C_QR + h * 64) * 2; const unsigned qo = (unsigned)((r32 * NIN + hi * 8) * 2);
#pragma unroll
    for (int d0 = 0; d0 < 4; ++d0) qr[d0] = *reinterpret_cast<const bf16x8*>(qb + qo + d0 * 32); }
  f32x16 o[4] = {};
  da::pv_d0(o, (int)(uintptr_t)lds + v_rd_base(lane), qr[0], qr[1], qr[2], qr[3]);
  float ss[16];
  { const float* ol = OL + ((size_t)((U * 4 + c) * 2 + tq) * 4 * 16) * 64 + lane;
#pragma unroll
    for (int r = 0; r < 16; ++r) { const float qd = __builtin_amdgcn_exp2f(lg2 * (float)(64 * c + 32 * tq + crow(r, hi) + 1)); float s = 0.f;
#pragma unroll
      for (int d0 = 0; d0 < 4; ++d0) { const float v = ol[(d0 * 16 + r) * 64] + qd * o[d0][r]; o[d0][r] = v; s += v * v; }
      ss[r] = s; } }
#pragma unroll
  for (int r = 0; r < 16; ++r) {
#pragma unroll
    for (int off = 1; off < 32; off <<= 1) ss[r] += __shfl_xor(ss[r], off);
    ss[r] = 1.f / sqrtf(ss[r] * (1.f / 128.f) + EPS); }
  const char* gb = (const char*)PROJ + ((size_t)tok0 * NIN + C_GR + h * 128) * 2; char* ob = (char*)MIX + ((size_t)tok0 * D + 512 + h * 128) * 2;
#pragma unroll
  for (int r = 0; r < 16; ++r) { const unsigned go = (unsigned)((crow(r, hi) * NIN + r32) * 2), oo = (unsigned)((crow(r, hi) * D + r32) * 2);
#pragma unroll
    for (int d0 = 0; d0 < 4; ++d0) { const float gv = bf2f(*(const unsigned short*)(gb + go + d0 * 64));
      *(unsigned short*)(ob + oo + d0 * 64) = (unsigned short)f2bf(silu_f(gv) * o[d0][r] * ss[r]); } }
}

__device__ __forceinline__ void carry_phase(const float* __restrict__ E, float* __restrict__ C, int bid, int G, char* lds) {
  const int tid = threadIdx.x, cl = tid & 127, seg = tid >> 7;
  float* tot = (float*)lds;
  for (int blk = bid; blk < 256; blk += G) {
    const int ch = blk * 128 + cl, h = ch >> 13, elem = ch & 8191;
    const float dec = exp2f(lg2gamma(h) * 256.f), dec16 = exp2f(lg2gamma(h) * 4096.f);
    float e[16], P[16];
#pragma unroll
    for (int k = 0; k < 16; ++k) e[k] = E[(size_t)((16 * seg + k) * 4 + h) * 8192 + elem];
    float st = 0.f;
#pragma unroll
    for (int k = 0; k < 16; ++k) { P[k] = st; st = st * dec + e[k]; }
    __syncthreads();
    tot[seg * 128 + cl] = st;
    __syncthreads();
    float cin = 0.f;
    for (int s2 = 0; s2 < seg; ++s2) cin = cin * dec16 + tot[s2 * 128 + cl];
    float w = 1.f;
#pragma unroll
    for (int k = 0; k < 16; ++k) { C[(size_t)((16 * seg + k) * 4 + h) * 8192 + elem] = P[k] + w * cin; w *= dec; }
  }
  __syncthreads();
}
#undef RT_PK
#undef RT_WAITL
}

__device__ __forceinline__ void p7_route(Frame& F) {
    const float* H = F.out; bf16* XN2 = (bf16*)(F.ws + WS_A); const float* WrT = (const float*)(F.ws + WS_WRT);
    int* tok_e = (int*)(F.ws + WS_TOK + TK_E); int* tok_pos = (int*)(F.ws + WS_TOK + TK_POS); float* tok_w = (float*)(F.ws + WS_TOK + TK_W);
    const int gw = F.bid * NWAVES + F.wave, NGW = F.G * NWAVES, lane = F.lane;
    for (int t = gw; t < T; t += NGW) {
        const f32x4* xr = (const f32x4*)(H + (size_t)t * D) + lane; const f32x4* gr = (const f32x4*)F.g2 + lane;
        f32x4 v[4]; float s = 0.f;
#pragma unroll
        for (int j = 0; j < 4; ++j) { v[j] = xr[64 * j]; s += (v[j].x * v[j].x + v[j].y * v[j].y) + (v[j].z * v[j].z + v[j].w * v[j].w); }
        const float rstd = 1.f / sqrtf(wave_sum(s) * (1.f / D) + EPS);
        unsigned long long* o8 = (unsigned long long*)(XN2 + (size_t)t * D) + lane;
#pragma unroll
        for (int j = 0; j < 4; ++j) { const f32x4 gg = gr[64 * j]; v[j].x *= rstd * gg.x; v[j].y *= rstd * gg.y; v[j].z *= rstd * gg.z; v[j].w *= rstd * gg.w;
            o8[64 * j] = (unsigned long long)pk2(v[j].x, v[j].y) | ((unsigned long long)pk2(v[j].z, v[j].w) << 32); }
        float lg[4];
#pragma unroll
        for (int c = 0; c < 4; ++c) { const f32x4* wr = (const f32x4*)(WrT + (size_t)c * D) + lane; float p = 0.f;
#pragma unroll
            for (int j = 0; j < 4; ++j) { const f32x4 w = wr[64 * j]; p += (v[j].x * w.x + v[j].y * w.y) + (v[j].z * w.z + v[j].w * w.w); }
            lg[c] = wave_sum(p) + F.brg[c]; }
        int grp = 0; float gm = lg[0];
#pragma unroll
        for (int c = 1; c < 4; ++c) if (lg[c] > gm) { gm = lg[c]; grp = c; }
        float gs = 0.f;
#pragma unroll
        for (int c = 0; c < 4; ++c) gs += __expf(lg[c] - gm);
        const float gtop = 1.f / gs;
        float el[8];
#pragma unroll
        for (int i = 0; i < 8; ++i) { const f32x4* wr = (const f32x4*)(WrT + (size_t)(4 + grp * 8 + i) * D) + lane; float p = 0.f;
#pragma unroll
            for (int j = 0; j < 4; ++j) { const f32x4 w = wr[64 * j]; p += (v[j].x * w.x + v[j].y * w.y) + (v[j].z * w.z + v[j].w * w.w); }
            el[i] = wave_sum(p) + F.bre[grp * 8 + i]; }
        int i1 = 0; float v1 = el[0];
#pragma unroll
        for (int i = 1; i < 8; ++i) if (el[i] > v1) { v1 = el[i]; i1 = i; }
        int i2 = -1; float v2 = -3.0e38f;
#pragma unroll
        for (int i = 0; i < 8; ++i) if (i != i1 && el[i] > v2) { v2 = el[i]; i2 = i; }
        const float ex = __expf(v2 - v1), w1 = 1.f / (1.f + ex), w2 = ex / (1.f + ex);
        if (lane == 0) {
            const int e1 = grp * 8 + i1, e2 = grp * 8 + i2;
            const int p1 = (int)__hip_atomic_fetch_add(F.ctl + CW_CNT + 64 * e1, 1u, RLX_AGENT);
            const int p2 = (int)__hip_atomic_fetch_add(F.ctl + CW_CNT + 64 * e2, 1u, RLX_AGENT);
            tok_e[2 * t] = e1; tok_e[2 * t + 1] = e2; tok_pos[2 * t] = p1; tok_pos[2 * t + 1] = p2; tok_w[2 * t] = gtop * w1; tok_w[2 * t + 1] = gtop * w2;
        }
    }
}
__device__ __forceinline__ int build_tiles(Frame& F) {
    int* tile_e = (int*)(F.lds + TILEE_OFF); int* base = tile_e + 192; int* cnts = base + 32; int* nt = cnts + 32;
    __syncthreads();
    if (F.tid == 0) { int tiles = 0;
        for (int e = 0; e < NE; ++e) { const int c = (int)__hip_atomic_load(F.ctl + CW_CNT + 64 * e, RLX_AGENT); cnts[e] = c; base[e] = tiles * 256; const int n = (c + 255) >> 8; for (int i = 0; i < n; ++i) tile_e[tiles + i] = e; tiles += n; }
        nt[0] = tiles; }
    __syncthreads();
    return nt[0];
}
__device__ __forceinline__ void p8_permute(Frame& F) {
    (void)build_tiles(F);
    const int* base = (const int*)(F.lds + TILEE_OFF) + 192; const int* cnts = base + 32;
    const bf16* XN2 = (const bf16*)(F.ws + WS_A); bf16* XS = (bf16*)(F.ws + WS_PROJ);
    const int* tok_e = (const int*)(F.ws + WS_TOK + TK_E); const int* tok_pos = (const int*)(F.ws + WS_TOK + TK_POS); const float* tok_w = (const float*)(F.ws + WS_TOK + TK_W);
    int* stok = (int*)(F.ws + WS_TOK + TK_STOK); float* sw = (float*)(F.ws + WS_TOK + TK_SW);
    const int gw = F.bid * NWAVES + F.wave, NGW = F.G * NWAVES, lane = F.lane;
    for (int s = gw; s < NSLOT; s += NGW) {
        const int t = s >> 1, e = tok_e[s], dest = base[e] + tok_pos[s];
        const v4u* src = (const v4u*)(XN2 + (size_t)t * D) + lane; v4u* dst = (v4u*)(XS + (size_t)dest * D) + lane;
        dst[0] = src[0]; dst[64] = src[64];
        if (lane == 0) { stok[dest] = s; sw[dest] = tok_w[s]; }
    }
    for (int i = gw; i < NE * 256; i += NGW) { const int e = i >> 8, r = i & 255, c = cnts[e], padn = ((c + 255) & ~255) - c;
        if (r < padn) { const int dest = base[e] + c + r; v4u* dst = (v4u*)(XS + (size_t)dest * D) + lane; dst[0] = (v4u){0u, 0u, 0u, 0u}; dst[64] = (v4u){0u, 0u, 0u, 0u}; if (lane == 0) { stok[dest] = -1; sw[dest] = 0.f; } } }
}
__device__ __forceinline__ void p11_final(Frame& F) {
    const bf16* Y = (const bf16*)(F.ws + WS_WGU);
    const int gw = F.bid * NWAVES + F.wave, NGW = F.G * NWAVES, lane = F.lane;
    for (int t = gw; t < T; t += NGW) {
        f32x4* xr = (f32x4*)(F.out + (size_t)t * D) + lane; const f32x4* gr = (const f32x4*)F.gf + lane;
        const v2u* y0 = (const v2u*)(Y + (size_t)(2 * t) * D) + lane; const v2u* y1 = (const v2u*)(Y + (size_t)(2 * t + 1) * D) + lane;
        f32x4 v[4]; float s = 0.f;
#pragma unroll
        for (int j = 0; j < 4; ++j) { v[j] = xr[64 * j]; const v2u a = y0[64 * j], b = y1[64 * j];
            v[j].x += bflo(a.x) + bflo(b.x); v[j].y += bfhi(a.x) + bfhi(b.x); v[j].z += bflo(a.y) + bflo(b.y); v[j].w += bfhi(a.y) + bfhi(b.y);
            s += (v[j].x * v[j].x + v[j].y * v[j].y) + (v[j].z * v[j].z + v[j].w * v[j].w); }
        const float rstd = 1.f / sqrtf(wave_sum(s) * (1.f / D) + EPS);
#pragma unroll
        for (int j = 0; j < 4; ++j) { const f32x4 gg = gr[64 * j]; xr[64 * j] = (f32x4){v[j].x * rstd * gg.x, v[j].y * rstd * gg.y, v[j].z * rstd * gg.z, v[j].w * rstd * gg.w}; }
    }
}

struct Args { const float* in[18]; float* out; unsigned char* ws; int ph_lo, ph_hi; };
__global__ void __launch_bounds__(NWAVES * 64, 2) fwd_kernel(Args args) {
    extern __shared__ __attribute__((aligned(16))) unsigned char lds[];
    Frame F;
    F.lds = lds; F.tid = threadIdx.x; F.lane = F.tid & 63; F.wave = __builtin_amdgcn_readfirstlane(F.tid >> 6); F.G = gridDim.x; F.bid = blockIdx.x;
    F.ws = args.ws; F.ctl = (unsigned*)(args.ws + WS_CTL); F.out = args.out;
    F.x = args.in[0]; F.g1 = args.in[1]; F.w_in = args.in[2]; F.lq1 = args.in[3]; F.lk1 = args.in[4]; F.lq2 = args.in[5]; F.lk2 = args.in[6]; F.subg = args.in[7];
    F.w_out = args.in[8]; F.g2 = args.in[9]; F.wrg = args.in[10]; F.brg = args.in[11]; F.wre = args.in[12]; F.bre = args.in[13]; F.wg = args.in[14]; F.wu = args.in[15]; F.wd = args.in[16]; F.gf = args.in[17];
    volatile LAS unsigned* MISC = (volatile LAS unsigned*)((LAS unsigned char*)lds + MISC_OFF);
    for (int u = F.tid; u < (LDS_BYTES - LDSCTL_OFF) / 4; u += NWAVES * 64) ((LAS unsigned*)((LAS unsigned char*)lds + LDSCTL_OFF))[u] = 0u;
    __syncthreads();
    const int lo = args.ph_lo, hi = args.ph_hi;
    const int vcu = (F.G % 8 == 0) ? (F.bid % 8) * (F.G / 8) + F.bid / 8 : F.bid;
    XcdBarrier bar; bar.bar = F.ctl + CW_BAR; bar.x = 0; bar.st = nullptr;
    if (hi - lo > 1) bar = xcd_barrier_post(F.ctl + CW_BAR, MISC + 8);
#ifndef PH_MASK
#define PH_MASK 0xFFFF
#endif
#define IN(k) (((PH_MASK >> (k)) & 1) && lo <= (k) && (k) < hi)
#define SEAM(k) do { if (IN(k) && IN((k) + 1)) xcd_barrier(bar); } while (0)
#ifndef REP_MASK
#define REP_MASK 0
#endif
#define PH_BEGIN(k) if (IN(k)) { _Pragma("unroll 1") for (int rep_ = 0; rep_ < 1 + ((REP_MASK >> (k)) & 1); ++rep_) { if (rep_) xcd_barrier(bar);
#define PH_END(k) } } SEAM(k);
    PH_BEGIN(0) { p0_prologue(F); } PH_END(0)
    PH_BEGIN(1) {
        if (USE_MFMA & 1) { pg8::Gemm g{(const bf16*)(F.ws + WS_A), (const bf16*)(F.ws + WS_WIN), T, NIN, D}; pg8::StaticOrder S; S.init(T, NIN, F.G, F.bid);
            pg8::EpiBf16Norm E{(bf16*)(F.ws + WS_PROJ), NIN, F.ctl + CW_NORM}; pg8::gemm_phase<pg8::EpiBf16Norm, pg8::StaticOrder, true, true>((LAS unsigned char*)lds, g, S, E); }
        else { DenseOrder S{T / 256, NIN / 256, F.G, F.bid}; NEpiBf16 E{(bf16*)(F.ws + WS_PROJ), NIN};
            naive_gemm<false>(F, (const bf16*)(F.ws + WS_A), (const bf16*)(F.ws + WS_WIN), D, S, E); } } PH_END(1)
    PH_BEGIN(2) {
#ifndef SWEEP_REP
#define SWEEP_REP 1
#endif
#pragma unroll 1
        for (int srep = 0; srep < SWEEP_REP; ++srep)
        for (int uu = vcu; uu < 256; uu += F.G) ret::sweep_unit((const bf16*)(F.ws + WS_PROJ), F.out, F.out + (size_t)8 * 1024 * 1024, uu >> 2, uu & 3, (char*)F.lds);
        p2_attention(F); } PH_END(2)
    PH_BEGIN(3) { ret::carry_phase(F.out + (size_t)8 * 1024 * 1024, F.out + (size_t)10 * 1024 * 1024, F.bid, F.G, (char*)F.lds); } PH_END(3)
    PH_BEGIN(4) {
        for (int uu = vcu; uu < 256; uu += F.G) ret::out_unit((const bf16*)(F.ws + WS_PROJ), F.out, F.out + (size_t)10 * 1024 * 1024, (bf16*)(F.ws + WS_A), uu >> 2, uu & 3, (char*)F.lds);
        __syncthreads(); p4_attn_combine(F); } PH_END(4)
    PH_BEGIN(5) {
        if (USE_MFMA & 2) { pg8::Gemm g{(const bf16*)(F.ws + WS_A), (const bf16*)(F.ws + WS_WOUT), T, D, D}; pg8::StaticOrder S; S.init(T, D, F.G, F.bid);
            pg8::EpiResF32 E{F.x, F.out, D}; pg8::gemm_phase<pg8::EpiResF32, pg8::StaticOrder, true, true>((LAS unsigned char*)lds, g, S, E); }
        else { DenseOrder S{T / 256, D / 256, F.G, F.bid}; NEpiResF32 E{F.x, F.out, D};
            naive_gemm<false>(F, (const bf16*)(F.ws + WS_A), (const bf16*)(F.ws + WS_WOUT), D, S, E); } } PH_END(5)
    PH_BEGIN(6) { p7_route(F); convert_experts(F); } PH_END(6)
    PH_BEGIN(7) { p8_permute(F); } PH_END(7)
    PH_BEGIN(8) { const int nt = build_tiles(F);
        if (USE_MFMA & 4) { pg8::Gemm g{(const bf16*)(F.ws + WS_PROJ), (const bf16*)(F.ws + WS_WGU), NPAD, 1024, D}; pg8::GroupedOrder S{(const LAS int*)((LAS unsigned char*)lds + TILEE_OFF), nt, 4, F.G, vcu};
            pg8::EpiSwiglu E{(bf16*)(F.ws + WS_A), HIDN}; pg8::gemm_phase<pg8::EpiSwiglu, pg8::GroupedOrder, true, true>((LAS unsigned char*)lds, g, S, E); }
        else { GroupedOrder S{(const int*)(F.lds + TILEE_OFF), nt, 4, F.G, F.bid}; NEpiBf16 E{(bf16*)(F.ws + WS_A), HIDN};
            naive_gemm<true>(F, (const bf16*)(F.ws + WS_PROJ), (const bf16*)(F.ws + WS_WGU), D, S, E); } } PH_END(8)
    PH_BEGIN(9) { const int nt = build_tiles(F);
        if (USE_MFMA & 8) { pg8::Gemm g{(const bf16*)(F.ws + WS_A), (const bf16*)(F.ws + WS_WD), NPAD, 1024, HIDN}; pg8::GroupedOrder S{(const LAS int*)((LAS unsigned char*)lds + TILEE_OFF), nt, 4, F.G, vcu};
            pg8::EpiScatter E{(const int*)(F.ws + WS_TOK + TK_STOK), (const float*)(F.ws + WS_TOK + TK_SW), (bf16*)(F.ws + WS_WGU), D};
            pg8::gemm_phase<pg8::EpiScatter, pg8::GroupedOrder, true, true>((LAS unsigned char*)lds, g, S, E); }
        else { GroupedOrder S{(const int*)(F.lds + TILEE_OFF), nt, 4, F.G, F.bid};
            NEpiScatter E{(const int*)(F.ws + WS_TOK + TK_STOK), (const float*)(F.ws + WS_TOK + TK_SW), (bf16*)(F.ws + WS_WGU)};
            naive_gemm<false>(F, (const bf16*)(F.ws + WS_A), (const bf16*)(F.ws + WS_WD), HIDN, S, E); } } PH_END(9)
    PH_BEGIN(10) { p11_final(F); } } }
#undef IN
#undef SEAM
}

extern "C" void kernel_launch(void* const* d_in, const int* in_sizes, int n_in, void* d_out, int out_size, void* d_ws, size_t ws_size, hipStream_t stream) {
    static int grid = 0;
    if (grid == 0) {
        if (n_in != 18 || in_sizes[0] != T * D || out_size != T * D || ws_size < WS_END) { fprintf(stderr, "kernel_launch: shape mismatch n_in %d in0 %d out %d ws %zu\n", n_in, n_in > 0 ? in_sizes[0] : -1, out_size, ws_size); grid = -1; return; }
        int dev = 0, cus = 0, per_cu = 0;
        if (hipGetDevice(&dev) != hipSuccess || hipDeviceGetAttribute(&cus, hipDeviceAttributeMultiprocessorCount, dev) != hipSuccess) { grid = -1; return; }
        if (hipFuncSetAttribute((const void*)fwd_kernel, hipFuncAttributeMaxDynamicSharedMemorySize, LDS_BYTES) != hipSuccess) { fprintf(stderr, "kernel_launch: hipFuncSetAttribute failed\n"); grid = -1; return; }
        if (hipOccupancyMaxActiveBlocksPerMultiprocessor(&per_cu, (const void*)fwd_kernel, NWAVES * 64, LDS_BYTES) != hipSuccess || per_cu < 1) fprintf(stderr, "kernel_launch: occupancy query says %d\n", per_cu);
        (void)hipGetLastError();
        grid = cus;
    }
    if (grid < 0) return;
    (void)hipMemsetAsync((char*)d_ws + WS_CTL, 0, CTL_ZERO_BYTES, stream);
    Args a{};
    for (int i = 0; i < 18; ++i) a.in[i] = (const float*)d_in[i];
    a.out = (float*)d_out; a.ws = (unsigned char*)d_ws;
#if MK_ONE_LAUNCH
    a.ph_lo = 0; a.ph_hi = NPHASE;
    hipLaunchKernelGGL(fwd_kernel, dim3(grid), dim3(NWAVES * 64), LDS_BYTES, stream, a);
#else
    for (int p = 0; p < NPHASE; ++p) { a.ph_lo = p; a.ph_hi = p + 1; hipLaunchKernelGGL(fwd_kernel, dim3(grid), dim3(NWAVES * 64), LDS_BYTES, stream, a); }
#endif
}
```

```cpp
#include <hip/hip_runtime.h>
#include <cstdio>
#include <cstdint>

#ifndef USE_MFMA
#define USE_MFMA 0x1F
#endif
#ifndef MK_ONE_LAUNCH
#define MK_ONE_LAUNCH 1
#endif

constexpr int T = 16384, D = 1024, NIN = 3072;
constexpr int C_QDA = 0, C_KDA = 512, C_VDA = 1024, C_QR = 1536, C_KR = 1792, C_VR = 2048, C_GR = 2560;
constexpr int NE = 32, HIDN = 512, NSLOT = 2 * T, MAXTILES = NSLOT / 256 + NE, NPAD = MAXTILES * 256;
constexpr int NRT = 36;
constexpr float EPS = 1e-6f;
constexpr float LOG2E = 1.4426950408889634f;
constexpr float C2 = 0.125f * LOG2E;
constexpr float LAMBDA_INIT = 0.2f;
constexpr int NPHASE = 10;

constexpr size_t MiB = 1u << 20;
constexpr size_t WS_CTL = 0, CTL_ZERO_BYTES = 1 * MiB;
constexpr size_t WS_WRT = 1 * MiB;
constexpr size_t WS_WIN = 2 * MiB;
constexpr size_t WS_WOUT = 8 * MiB;
constexpr size_t WS_WGU = 10 * MiB;
constexpr size_t WS_WD = 74 * MiB;
constexpr size_t WS_A = 106 * MiB;
constexpr size_t WS_PROJ = 146 * MiB;
constexpr size_t WS_TOK = 242 * MiB;
constexpr size_t WS_STOK = 244 * MiB;
constexpr size_t WS_SW = 246 * MiB;
constexpr size_t WS_END = 248 * MiB;
constexpr int PSLOTS = 1280;
constexpr size_t WS_PARTO = WS_WGU;
constexpr size_t WS_PARTS = WS_WGU + 80 * MiB;
constexpr int CW_BAR = 4096;
constexpr int CW_CNT = 1024;
constexpr int CW_NORM = 3072;
constexpr int CW_QHEAD = 3136;
constexpr size_t TK_E = 0, TK_POS = 128 * 1024, TK_W = 256 * 1024, TK_STOK = 384 * 1024, TK_SW = 384 * 1024 + 160 * 1024;

constexpr int RING_BYTES = 131072;
constexpr int ITEM_OFF = 98304;
constexpr int LDSCTL_OFF = RING_BYTES, MISC_OFF = LDSCTL_OFF + 320, TILEE_OFF = LDSCTL_OFF + 1024;
constexpr int LDS_BYTES = 147456;
constexpr int NWAVES = 8;

#define GAS __attribute__((address_space(1)))
#define LAS __attribute__((address_space(3)))
typedef unsigned short bf16;
typedef unsigned v4u __attribute__((ext_vector_type(4)));
typedef unsigned v2u __attribute__((ext_vector_type(2)));
typedef float f32x4 __attribute__((ext_vector_type(4)));
#define RLX_AGENT __ATOMIC_RELAXED, __HIP_MEMORY_SCOPE_AGENT
#define LDS_WAIT() asm volatile("s_waitcnt lgkmcnt(0)" ::: "memory")

__device__ __forceinline__ unsigned f2bf(float f) { unsigned u = __builtin_bit_cast(unsigned, f); return (u + 0x7fffu + ((u >> 16) & 1u)) >> 16; }
__device__ __forceinline__ unsigned pk2(float lo, float hi) { return f2bf(lo) | (f2bf(hi) << 16); }
__device__ __forceinline__ float bflo(unsigned w) { return __builtin_bit_cast(float, w << 16); }
__device__ __forceinline__ float bfhi(unsigned w) { return __builtin_bit_cast(float, w & 0xffff0000u); }
__device__ __forceinline__ float bf2f(bf16 b) { return __builtin_bit_cast(float, (unsigned)b << 16); }
__device__ __forceinline__ float wave_sum(float v) {
#pragma unroll
    for (int o = 1; o < 64; o <<= 1) v += __shfl_xor(v, o);
    return v;
}
__device__ __forceinline__ float silu_f(float v) { return v / (1.f + __expf(-v)); }

#define XB_TMO      128
#define XB_XCNT(j)  (256  + 64 * (j))
#define XB_XSUB(j)  (1280 + 64 * (j))
#define XB_XGEN(j)  (2304 + 64 * (j))
#define XB_TOP      3328
#define XB_TOPGEN   3392
#define XCD_BAR_WORDS 3456
#define XB_SPIN_CAP (1u << 18)
__device__ __forceinline__ unsigned xb_ld(unsigned* p)              { return __hip_atomic_load(p, __ATOMIC_RELAXED, __HIP_MEMORY_SCOPE_AGENT); }
__device__ __forceinline__ unsigned xb_add(unsigned* p, unsigned v) { return __hip_atomic_fetch_add(p, v, __ATOMIC_RELAXED, __HIP_MEMORY_SCOPE_AGENT); }
__device__ __forceinline__ unsigned xb_xcc_id() { return (unsigned)__builtin_amdgcn_s_getreg((3 << 11) | 20) & 0xFu; }
#define XB_SPIN(cond, bar) do { unsigned _sp = 0; while (cond) { __builtin_amdgcn_s_sleep(1); \
    if ((++_sp & 255u) == 0u) { if (xb_ld(&(bar)[XB_TMO])) break; if (_sp > XB_SPIN_CAP) { atomicAdd(&(bar)[XB_TMO], 1u); break; } } } } while (0)
struct XcdBarrier { unsigned* bar; unsigned x; volatile LAS unsigned* st; };
__device__ __forceinline__ XcdBarrier xcd_barrier_post(unsigned* bar, volatile LAS unsigned* st) {
    XcdBarrier b; b.bar = bar; b.x = xb_xcc_id(); b.st = st;
    if (threadIdx.x == 0) (void)xb_add(&bar[XB_XCNT(b.x)], 1u);
    return b;
}
__device__ __forceinline__ void xcd_barrier_complete(unsigned* bar, unsigned x, unsigned& nloc, unsigned& nx) {
    const unsigned G = gridDim.x * gridDim.y * gridDim.z;
    unsigned sum, cnt, mine, sp = 0u;
    for (;;) {
        sum = 0u; cnt = 0u; mine = 0u;
#pragma unroll
        for (unsigned j = 0; j < 16; ++j) { const unsigned c = xb_ld(&bar[XB_XCNT(j)]); sum += c; cnt += (c > 0u) ? 1u : 0u; mine = (j == x) ? c : mine; }
        if (sum == G) break;
        __builtin_amdgcn_s_sleep(1);
        if ((++sp & 255u) == 0u) { if (xb_ld(&bar[XB_TMO])) break; if (sp > XB_SPIN_CAP) { atomicAdd(&bar[XB_TMO], 1u); break; } }
    }
    nloc = mine > 0u ? mine : 1u; nx = cnt > 0u ? cnt : 1u;
}
__device__ __forceinline__ void xcd_barrier(const XcdBarrier& b) {
    asm volatile("s_waitcnt vmcnt(0)" ::: "memory");
    __syncthreads();
    if (threadIdx.x == 0) {
        unsigned* bar = b.bar;
        __builtin_amdgcn_s_waitcnt(0);
        unsigned nloc = b.st[0], nx = b.st[1];
        if (nloc == 0u) { xcd_barrier_complete(bar, b.x, nloc, nx); b.st[0] = nloc; b.st[1] = nx; }
        const unsigned old = xb_add(&bar[XB_XSUB(b.x)], 1u);
        const unsigned gen = old / nloc;
        if (old + 1u == (gen + 1u) * nloc) {
            __builtin_amdgcn_fence(__ATOMIC_RELEASE, "agent");
            asm volatile("s_waitcnt vmcnt(0)" ::: "memory");
            const unsigned og = xb_add(&bar[XB_TOP], 1u);
            const unsigned tg = og / nx;
            if (og + 1u == (tg + 1u) * nx) xb_add(&bar[XB_TOPGEN], 1u);
            else XB_SPIN(xb_ld(&bar[XB_TOPGEN]) == tg, bar);
            __builtin_amdgcn_fence(__ATOMIC_ACQUIRE, "agent");
            xb_add(&bar[XB_XGEN(b.x)], 1u);
            asm volatile("s_waitcnt vmcnt(0)" ::: "memory");
        } else {
            XB_SPIN(xb_ld(&bar[XB_XGEN(b.x)]) == gen, bar);
            __builtin_amdgcn_fence(__ATOMIC_ACQUIRE, "agent");
            asm volatile("s_waitcnt vmcnt(0)" ::: "memory");
        }
    }
    __syncthreads();
}

namespace pg8 {
#define PG8_LAS __attribute__((address_space(3)))
typedef unsigned short bf16_t;
typedef short bf16x8 __attribute__((ext_vector_type(8)));
typedef float f32x4 __attribute__((ext_vector_type(4)));
typedef unsigned u32x4 __attribute__((ext_vector_type(4)));
constexpr int BM = 256, BK = 64, HALF = 128, HTB = HALF * BK * 2  , STAGE_BYTES = 8 * HTB, NXCD = 8, WGM = 8;

__host__ __device__ __forceinline__ int lds_byte(int r, int c) { const int st = (r >> 4) * 2 + (c >> 5), rr = r & 15, cc = c & 31, ob = rr * 64 + cc * 2; return st * 1024 + (ob ^ (((ob >> 9) & 1) << 5)); }
__host__ __device__ __forceinline__ void stage_rc(int b, int& R, int& C) { const int st = b / 1024, sb = b % 1024, swz = sb ^ (((sb >> 9) & 1) << 5); R = (st >> 1) * 16 + swz / 64; C = (st & 1) * 32 + (swz % 64) / 2; }
__host__ __device__ __forceinline__ int perm32(int rho) { const int n = rho >> 4, i = rho & 15; return 8 * (i >> 2) + 4 * n + (i & 3); }

struct Unit { int pm, pn, pb; };
struct Gemm { const bf16_t* A; const bf16_t* Bt; int M, N, K; };
__device__ __forceinline__ unsigned cvt_pk_bf16(float lo, float hi) { unsigned r; asm volatile("v_cvt_pk_bf16_f32 %0, %1, %2" : "=v"(r) : "v"(lo), "v"(hi)); return r; }
template <class Epi, class Sched, bool ALIGN_EPI = false, bool SP2 = false>
__device__ __forceinline__ void gemm_phase(PG8_LAS unsigned char* lds, const Gemm g, const Sched& S, const Epi& E) {
    const int tid = threadIdx.x, wid = __builtin_amdgcn_readfirstlane(tid >> 6), lane = tid & 63, wr = wid >> 2, wc = wid & 3, fr = lane & 15, fq = lane >> 4;
    const int K = g.K, nt = K / BK;
    unsigned voffB[2]; int RA[2]; unsigned colA[2];
#pragma unroll
    for (int i = 0; i < 2; ++i) { int R, C; stage_rc(tid * 16 + i * 8192, R, C); const int Rb = Epi::PERM ? ((R & ~31) + perm32(R & 31)) : R;
        RA[i] = R; colA[i] = (unsigned)C * 2u; voffB[i] = (unsigned)(Rb * K + C) * 2u; }
    unsigned cv0[2], cv1[2], nv0[2], nv1[2];
#define PG8_VA(d0, d1, un) do { _Pragma("unroll") for (int i_ = 0; i_ < 2; ++i_) { d0[i_] = (unsigned)S.arow(un, 0, RA[i_]) * (unsigned)(K * 2) + colA[i_]; d1[i_] = (unsigned)S.arow(un, 1, RA[i_]) * (unsigned)(K * 2) + colA[i_]; } } while (0)
    const size_t kstep = (size_t)(BK * 2);
    const size_t hstep = (size_t)HALF * K * 2;
    const size_t tstep = 2 * hstep;
    const unsigned ldsw = (unsigned)wid * 1024u;
    const int aoff = lds_byte(wr * 64 + fr, fq * 8), boff = lds_byte(wc * 32 + fr, fq * 8);
#define PG8_SA(b, h) (((b) * 2 + (h)) * HTB)
#define PG8_SB(b, h) ((4 + (b) * 2 + (h)) * HTB)
#define PG8_STAGE(bufoff, gbase, voff) do { _Pragma("unroll") for (int _i = 0; _i < 2; ++_i) \
        __builtin_amdgcn_global_load_lds((const unsigned*)((const char*)(gbase) + (voff)[_i]), (PG8_LAS unsigned*)(lds + (bufoff) + ldsw + _i * 8192), 16, 0, 0); } while (0)
#define PG8_LDA(dst, b, h) do { _Pragma("unroll") for (int m = 0; m < 4; ++m) _Pragma("unroll") for (int k = 0; k < 2; ++k) dst[m][k] = *(const PG8_LAS bf16x8*)(lds + PG8_SA(b, h) + aoff + m * 2048 + k * 1024); } while (0)
#define PG8_LDB(dst, b, h) do { _Pragma("unroll") for (int n = 0; n < 2; ++n) _Pragma("unroll") for (int k = 0; k < 2; ++k) dst[n][k] = *(const PG8_LAS bf16x8*)(lds + PG8_SB(b, h) + boff + n * 2048 + k * 1024); } while (0)
#define PG8_MMA(ai, bj, At, Bt) do { __builtin_amdgcn_s_setprio(1); _Pragma("unroll") for (int m = 0; m < 4; ++m) _Pragma("unroll") for (int n = 0; n < 2; ++n) _Pragma("unroll") for (int k = 0; k < 2; ++k) \
        acc[ai][bj][m][n] = __builtin_amdgcn_mfma_f32_16x16x32_bf16(Bt[n][k], At[m][k], acc[ai][bj][m][n], 0, 0, 0); __builtin_amdgcn_s_setprio(0); } while (0)
#define PG8_WAIT_V(n) asm volatile("s_waitcnt vmcnt(" #n ")" ::: "memory")
#define PG8_WAIT_L(n) asm volatile("s_waitcnt lgkmcnt(" #n ")" ::: "memory")
#define PG8_BAR __builtin_amdgcn_s_barrier()
#define PG8_SCHED __builtin_amdgcn_sched_barrier(0)
    Unit cur, nxt; int ui = 0;
    if (!S.next(0, cur)) return;
    f32x4 acc[2][2][4][2];
#pragma unroll
    for (int a = 0; a < 2; ++a)
#pragma unroll
        for (int b = 0; b < 2; ++b)
#pragma unroll
            for (int m = 0; m < 4; ++m)
#pragma unroll
                for (int n = 0; n < 2; ++n) acc[a][b][m][n] = (f32x4){0.f, 0.f, 0.f, 0.f};
    bf16x8 At[4][2], B0[2][2], B1[2][2];
    const char* const gA = (const char*)g.A; const char* cB = (const char*)g.Bt + (size_t)cur.pb * tstep;
    PG8_VA(cv0, cv1, cur);
    S.a_ready(cur);
    if constexpr (SP2) {
        PG8_STAGE(PG8_SB(0, 0), cB, voffB); PG8_STAGE(PG8_SB(0, 1), cB + hstep, voffB); PG8_STAGE(PG8_SA(0, 0), gA, cv0); PG8_STAGE(PG8_SA(0, 1), gA, cv1);
        if (wr == 1) PG8_BAR;
        PG8_WAIT_V(2); PG8_BAR;
        PG8_STAGE(PG8_SB(1, 0), cB + kstep, voffB); PG8_STAGE(PG8_SA(1, 0), gA + kstep, cv0); PG8_STAGE(PG8_SB(1, 1), cB + hstep + kstep, voffB);
        PG8_WAIT_V(6); PG8_BAR;
    } else {
        PG8_STAGE(PG8_SB(0, 0), cB, voffB); PG8_STAGE(PG8_SA(0, 0), gA, cv0); PG8_STAGE(PG8_SB(0, 1), cB + hstep, voffB); PG8_STAGE(PG8_SA(0, 1), gA, cv1);
        if (wr == 1) PG8_BAR;
        PG8_WAIT_V(4); PG8_BAR;
        PG8_STAGE(PG8_SB(1, 0), cB + kstep, voffB); PG8_STAGE(PG8_SA(1, 0), gA + kstep, cv0); PG8_STAGE(PG8_SB(1, 1), cB + hstep + kstep, voffB);
        PG8_WAIT_V(6); PG8_BAR;
    }
    for (;;) {
        const bool has_next = S.next(ui + 1, nxt);
        const char* nB = has_next ? (const char*)g.Bt + (size_t)nxt.pb * tstep : cB;
        if (has_next) PG8_VA(nv0, nv1, nxt); else { nv0[0] = cv0[0]; nv0[1] = cv0[1]; nv1[0] = cv1[0]; nv1[1] = cv1[1]; }
        for (int t = 0; t < nt; t += 2) {
            const bool last = (t == nt - 2);
            const char* a1 = gA + (size_t)(t + 1) * kstep;
            const char* a2 = last ? gA : gA + (size_t)(t + 2) * kstep; const char* b2 = last ? nB : cB + (size_t)(t + 2) * kstep;
            const char* a3 = a2 + kstep; const char* b3 = b2 + kstep;
            unsigned w0[2], w1[2];
            w0[0] = last ? nv0[0] : cv0[0]; w0[1] = last ? nv0[1] : cv0[1]; w1[0] = last ? nv1[0] : cv1[0]; w1[1] = last ? nv1[1] : cv1[1];
            if (last && has_next) S.a_ready(nxt);
            if constexpr (SP2) {
            PG8_LDB(B0, 0, 0); PG8_LDB(B1, 0, 1); PG8_SCHED; PG8_LDA(At, 0, 0); PG8_STAGE(PG8_SA(1, 1), a1, cv1);
            PG8_WAIT_V(8); PG8_WAIT_L(0); PG8_BAR; PG8_MMA(0, 0, At, B0); PG8_MMA(0, 1, At, B1); PG8_BAR; PG8_SCHED;
            PG8_LDA(At, 0, 1); PG8_STAGE(PG8_SB(0, 0), b2, voffB); PG8_STAGE(PG8_SB(0, 1), b2 + hstep, voffB); PG8_STAGE(PG8_SA(0, 0), a2, w0);
            PG8_WAIT_V(8); PG8_WAIT_L(0); PG8_BAR; PG8_MMA(1, 0, At, B0); PG8_MMA(1, 1, At, B1); PG8_BAR; PG8_SCHED;
            PG8_LDB(B0, 1, 0); PG8_LDB(B1, 1, 1); PG8_SCHED; PG8_LDA(At, 1, 0); PG8_STAGE(PG8_SA(0, 1), a2, w1);
            PG8_WAIT_V(8); PG8_WAIT_L(0); PG8_BAR; PG8_MMA(0, 0, At, B0); PG8_MMA(0, 1, At, B1); PG8_BAR; PG8_SCHED;
            PG8_LDA(At, 1, 1); PG8_STAGE(PG8_SB(1, 0), b3, voffB); PG8_STAGE(PG8_SB(1, 1), b3 + hstep, voffB); PG8_STAGE(PG8_SA(1, 0), a3, w0);
            PG8_WAIT_V(8); PG8_WAIT_L(0); PG8_BAR; PG8_MMA(1, 0, At, B0); PG8_MMA(1, 1, At, B1); PG8_BAR; PG8_SCHED;
            } else {
            PG8_LDB(B0, 0, 0); PG8_SCHED; PG8_LDA(At, 0, 0); PG8_STAGE(PG8_SA(1, 1), a1, cv1);
            PG8_WAIT_L(8); PG8_BAR; PG8_WAIT_L(0); PG8_MMA(0, 0, At, B0); PG8_BAR; PG8_SCHED;
            PG8_LDB(B1, 0, 1); PG8_STAGE(PG8_SB(0, 0), b2, voffB);
            PG8_BAR; PG8_WAIT_L(0); PG8_MMA(0, 1, At, B1); PG8_BAR;
            PG8_LDA(At, 0, 1); PG8_STAGE(PG8_SA(0, 0), a2, w0);
            PG8_BAR; PG8_WAIT_L(0); PG8_MMA(1, 0, At, B0); PG8_BAR; PG8_SCHED;
            PG8_STAGE(PG8_SB(0, 1), b2 + hstep, voffB);
            PG8_WAIT_V(6); PG8_BAR; PG8_MMA(1, 1, At, B1); PG8_BAR;
            PG8_LDB(B0, 1, 0); PG8_SCHED; PG8_LDA(At, 1, 0); PG8_STAGE(PG8_SA(0, 1), a2, w1);
            PG8_WAIT_L(8); PG8_BAR; PG8_WAIT_L(0); PG8_MMA(0, 0, At, B0); PG8_BAR; PG8_SCHED;
            PG8_LDB(B1, 1, 1); PG8_STAGE(PG8_SB(1, 0), b3, voffB);
            PG8_BAR; PG8_WAIT_L(0); PG8_MMA(0, 1, At, B1); PG8_BAR;
            PG8_LDA(At, 1, 1); PG8_STAGE(PG8_SA(1, 0), a3, w0);
            PG8_BAR; PG8_WAIT_L(0); PG8_MMA(1, 0, At, B0); PG8_BAR; PG8_SCHED;
            PG8_STAGE(PG8_SB(1, 1), b3 + hstep, voffB);
            PG8_WAIT_V(6); PG8_BAR; PG8_MMA(1, 1, At, B1); PG8_BAR;
            }
        }
        if constexpr (ALIGN_EPI) { if (wr == 0) PG8_BAR; }
        if constexpr (!Epi::AFTER_DRAIN) { E(acc, cur, wr, wc, fr, fq); S.done(cur); }
        if (!has_next) break;
#pragma unroll
        for (int a = 0; a < 2; ++a)
#pragma unroll
            for (int b = 0; b < 2; ++b)
#pragma unroll
                for (int m = 0; m < 4; ++m)
#pragma unroll
                    for (int n = 0; n < 2; ++n) acc[a][b][m][n] = (f32x4){0.f, 0.f, 0.f, 0.f};
        cur = nxt; cB = nB; ++ui; cv0[0] = nv0[0]; cv0[1] = nv0[1]; cv1[0] = nv1[0]; cv1[1] = nv1[1];
        if constexpr (ALIGN_EPI) { if (wr == 1) PG8_BAR; }
    }
    PG8_WAIT_V(0);
    if constexpr (!ALIGN_EPI) { if (wr == 0) PG8_BAR; }
    PG8_BAR;
    if constexpr (Epi::AFTER_DRAIN) { E.fused(acc, cur, wr, wc, fr, fq, lds, wid, lane); S.done(cur); }
#undef PG8_SA
#undef PG8_VA
#undef PG8_SB
#undef PG8_STAGE
#undef PG8_LDA
#undef PG8_LDB
#undef PG8_MMA
#undef PG8_WAIT_V
#undef PG8_WAIT_L
#undef PG8_BAR
#undef PG8_SCHED
}

struct EpiBf16Plain {
    static constexpr bool PERM = true, AFTER_DRAIN = false;
    bf16_t* O; int ldc;
    __device__ __forceinline__ void operator()(const f32x4 (&acc)[2][2][4][2], const Unit& u, int wr, int wc, int fr, int fq) const {
        const int row0 = u.pm * BM + wr * 64 + fr, col0 = u.pn * BM + wc * 32 + 8 * fq;
#pragma unroll
        for (int ai = 0; ai < 2; ++ai)
#pragma unroll
            for (int m = 0; m < 4; ++m) { bf16_t* rowp = O + (size_t)(row0 + ai * HALF + m * 16) * ldc + col0;
#pragma unroll
                for (int bj = 0; bj < 2; ++bj) { const f32x4 v0 = acc[ai][bj][m][0], v1 = acc[ai][bj][m][1];
                    u32x4 w; w.x = cvt_pk_bf16(v0[0], v0[1]); w.y = cvt_pk_bf16(v0[2], v0[3]); w.z = cvt_pk_bf16(v1[0], v1[1]); w.w = cvt_pk_bf16(v1[2], v1[3]);
                    *(u32x4*)(rowp + bj * HALF) = w; } }
    }
};
struct EpiBf16Norm {
    static constexpr bool PERM = true, AFTER_DRAIN = false;
    bf16_t* O; int ldc; unsigned* norm;
    __device__ __forceinline__ void operator()(const f32x4 (&acc)[2][2][4][2], const Unit& u, int wr, int wc, int fr, int fq) const {
        const int row0 = u.pm * BM + wr * 64 + fr, col0 = u.pn * BM + wc * 32 + 8 * fq;
#pragma unroll
        for (int ai = 0; ai < 2; ++ai)
#pragma unroll
            for (int m = 0; m < 4; ++m) { bf16_t* rowp = O + (size_t)(row0 + ai * HALF + m * 16) * ldc + col0;
#pragma unroll
                for (int bj = 0; bj < 2; ++bj) { const f32x4 v0 = acc[ai][bj][m][0], v1 = acc[ai][bj][m][1];
                    u32x4 w; w.x = cvt_pk_bf16(v0[0], v0[1]); w.y = cvt_pk_bf16(v0[2], v0[3]); w.z = cvt_pk_bf16(v1[0], v1[1]); w.w = cvt_pk_bf16(v1[2], v1[3]);
                    *(u32x4*)(rowp + bj * HALF) = w; } }
        if (u.pn < 4) {
#pragma unroll
            for (int bj = 0; bj < 2; ++bj) { float mx = 0.f;
#pragma unroll
                for (int ai = 0; ai < 2; ++ai)
#pragma unroll
                    for (int m = 0; m < 4; ++m) { const f32x4 a = acc[ai][bj][m][0], b = acc[ai][bj][m][1];
                        float ssq = (a[0] * a[0] + a[1] * a[1]) + (a[2] * a[2] + a[3] * a[3]) + (b[0] * b[0] + b[1] * b[1]) + (b[2] * b[2] + b[3] * b[3]);
                        ssq += __shfl_xor(ssq, 16); ssq += __shfl_xor(ssq, 32); mx = fmaxf(mx, ssq); }
#pragma unroll
                for (int o = 1; o < 16; o <<= 1) mx = fmaxf(mx, __shfl_xor(mx, o));
                if ((threadIdx.x & 63) == 0) __hip_atomic_fetch_max(norm + (4 * u.pn + 2 * bj + (wc >> 1)) * 2 + (wc & 1), __float_as_uint(mx), __ATOMIC_RELAXED, __HIP_MEMORY_SCOPE_AGENT); }
        }
    }
};
struct EpiResF32 {
    static constexpr bool PERM = false, AFTER_DRAIN = false;
    const float* base; float* C; int ldc;
    __device__ __forceinline__ void operator()(const f32x4 (&acc)[2][2][4][2], const Unit& u, int wr, int wc, int fr, int fq) const {
        const int row0 = u.pm * BM + wr * 64 + fr, col0 = u.pn * BM + wc * 32 + 4 * fq;
#pragma unroll
        for (int ai = 0; ai < 2; ++ai)
#pragma unroll
            for (int m = 0; m < 4; ++m) { const size_t off = (size_t)(row0 + ai * HALF + m * 16) * ldc + col0;
                f32x4 b[2][2];
#pragma unroll
                for (int bj = 0; bj < 2; ++bj)
#pragma unroll
                    for (int n = 0; n < 2; ++n) b[bj][n] = *(const f32x4*)(base + off + bj * HALF + n * 16);
#pragma unroll
                for (int bj = 0; bj < 2; ++bj)
#pragma unroll
                    for (int n = 0; n < 2; ++n) *(f32x4*)(C + off + bj * HALF + n * 16) = b[bj][n] + acc[ai][bj][m][n];
                if (m & 1) asm volatile("" ::: "memory"); }
    }
};
__device__ __forceinline__ float silu_mul(float g, float u) { return g * u * __builtin_amdgcn_rcpf(1.f + __expf(-g)); }
struct EpiSwiglu {
    static constexpr bool PERM = true, AFTER_DRAIN = false;
    bf16_t* H; int ldh;
    __device__ __forceinline__ void operator()(const f32x4 (&acc)[2][2][4][2], const Unit& u, int wr, int wc, int fr, int fq) const {
        const int row0 = u.pm * BM + wr * 64 + fr, col0 = u.pn * HALF + wc * 32 + 8 * fq;
#pragma unroll
        for (int ai = 0; ai < 2; ++ai)
#pragma unroll
            for (int m = 0; m < 4; ++m) { const f32x4 g0 = acc[ai][0][m][0], g1 = acc[ai][0][m][1], u0 = acc[ai][1][m][0], u1 = acc[ai][1][m][1];
                u32x4 w; w.x = cvt_pk_bf16(silu_mul(g0[0], u0[0]), silu_mul(g0[1], u0[1])); w.y = cvt_pk_bf16(silu_mul(g0[2], u0[2]), silu_mul(g0[3], u0[3]));
                w.z = cvt_pk_bf16(silu_mul(g1[0], u1[0]), silu_mul(g1[1], u1[1])); w.w = cvt_pk_bf16(silu_mul(g1[2], u1[2]), silu_mul(g1[3], u1[3]));
                *(u32x4*)(H + (size_t)(row0 + ai * HALF + m * 16) * ldh + col0) = w; }
    }
};
struct EpiScatter {
    static constexpr bool PERM = true, AFTER_DRAIN = false;
    const PG8_LAS int* tile_e; const PG8_LAS int* tile_i; const PG8_LAS int* cnts; const int* stok; const float* sw; bf16_t* Y; int ldy;
    __device__ __forceinline__ void operator()(const f32x4 (&acc)[2][2][4][2], const Unit& u, int wr, int wc, int fr, int fq) const {
        const int e = tile_e[u.pm], pos0 = tile_i[u.pm] * BM + wr * 64 + fr, cnt = cnts[e], col0 = u.pn * BM + wc * 32 + 8 * fq;
#pragma unroll
        for (int ai = 0; ai < 2; ++ai)
#pragma unroll
            for (int m = 0; m < 4; ++m) { const int pos = pos0 + ai * HALF + m * 16;
                if (pos < cnt) { const int tk = stok[e * 16384 + pos]; const float s = sw[e * 16384 + pos]; bf16_t* rowp = Y + (size_t)tk * ldy + col0;
#pragma unroll
                    for (int bj = 0; bj < 2; ++bj) { const f32x4 v0 = acc[ai][bj][m][0] * s, v1 = acc[ai][bj][m][1] * s;
                        u32x4 w; w.x = cvt_pk_bf16(v0[0], v0[1]); w.y = cvt_pk_bf16(v0[2], v0[3]); w.z = cvt_pk_bf16(v1[0], v1[1]); w.w = cvt_pk_bf16(v1[2], v1[3]);
                        *(u32x4*)(rowp + bj * HALF) = w; } } }
    }
};
struct StaticOrder {
    int nM, nN, nwg, G, c;
    __device__ void init(int M, int N, int G_, int c_) { nM = M / BM; nN = N / BM; nwg = nM * nN; G = G_; c = c_; }
    __device__ bool next(int i, Unit& u) const {
        const long L = (long)i * G + c; if (L >= nwg) return false;
        int wgid = (int)L; { const int q = nwg / NXCD, r = nwg % NXCD, xcd = wgid % NXCD, off = wgid / NXCD; wgid = (xcd < r ? xcd * (q + 1) : r * (q + 1) + (xcd - r) * q) + off; }
        const int nig = WGM * nN, gid = wgid / nig, fm = gid * WGM, gsz = (nM - fm) < WGM ? (nM - fm) : WGM;
        u.pm = fm + ((wgid % nig) % gsz); u.pn = (wgid % nig) / gsz; u.pb = u.pn; return true;
    }
    __device__ __forceinline__ int arow(const Unit& u, int h, int R) const { return u.pm * BM + h * HALF + R; }
    __device__ __forceinline__ void a_ready(const Unit&) const {}
    __device__ __forceinline__ void done(const Unit&) const {}
};
constexpr int SLOTCAP = 16384;
template <bool GATHER> struct GroupedOrder {
    const PG8_LAS int* tile_e; const PG8_LAS int* tile_i; const PG8_LAS int* cnts; const int* stok; int ntiles, nN, G, c;
    __device__ __forceinline__ bool next(int i, Unit& u) const { const int L = i * G + c; if (L >= ntiles * nN) return false; u.pm = L / nN; u.pn = L % nN; u.pb = tile_e[u.pm] * nN + u.pn; return true; }
    __device__ __forceinline__ int arow(const Unit& u, int h, int R) const {
        if (!GATHER) return u.pm * BM + h * HALF + R;
        const int e = tile_e[u.pm], pos = tile_i[u.pm] * BM + h * HALF + R; return pos < cnts[e] ? (stok[e * SLOTCAP + pos] >> 1) : 0; }
    __device__ __forceinline__ void a_ready(const Unit&) const {}
    __device__ __forceinline__ void done(const Unit&) const {}
};
}

struct Frame {
    unsigned char* lds;
    unsigned* ctl;
    int tid, lane, wave, G, bid;
    const float *x, *g1, *w_in, *lq1, *lk1, *lq2, *lk2, *subg, *w_out, *g2, *wrg, *brg, *wre, *bre, *wg, *wu, *wd, *gf;
    float* out;
    unsigned char* ws;
};
using pg8::Unit;

__device__ __forceinline__ void p0_transpose_item(const float* W, int K, int N, bf16* WT, int k0, int n0, int dstrow0, float scale, float* scr, int lane) {
#pragma unroll 8
    for (int i = 0; i < 32; ++i) { const int kk = 2 * i + (lane >> 5); scr[kk * 33 + (lane & 31)] = W[(size_t)(k0 + kk) * N + n0 + (lane & 31)] * scale; }
    LDS_WAIT(); asm volatile("" ::: "memory");
    const int c = lane & 7;
#pragma unroll
    for (int j = 0; j < 4; ++j) { const int n = (lane >> 3) + 8 * j; const float* s = scr + (8 * c) * 33 + n;
        v4u o; o.x = pk2(s[0 * 33], s[1 * 33]); o.y = pk2(s[2 * 33], s[3 * 33]); o.z = pk2(s[4 * 33], s[5 * 33]); o.w = pk2(s[6 * 33], s[7 * 33]);
        *(v4u*)(WT + (size_t)(dstrow0 + n) * K + k0 + 8 * c) = o; }
    LDS_WAIT(); asm volatile("" ::: "memory");
}
__device__ __forceinline__ void rms_row_to_bf16(const float* xrow, const float* g, bf16* orow, int lane) {
    const f32x4* xr = (const f32x4*)xrow + lane; const f32x4* gr = (const f32x4*)g + lane;
    f32x4 v[4]; float s = 0.f;
#pragma unroll
    for (int j = 0; j < 4; ++j) { v[j] = xr[64 * j]; s += (v[j].x * v[j].x + v[j].y * v[j].y) + (v[j].z * v[j].z + v[j].w * v[j].w); }
    const float rstd = 1.f / sqrtf(wave_sum(s) * (1.f / D) + EPS);
    unsigned long long* o8 = (unsigned long long*)orow + lane;
#pragma unroll
    for (int j = 0; j < 4; ++j) { const f32x4 gg = gr[64 * j];
        o8[64 * j] = (unsigned long long)pk2(v[j].x * rstd * gg.x, v[j].y * rstd * gg.y) | ((unsigned long long)pk2(v[j].z * rstd * gg.z, v[j].w * rstd * gg.w) << 32); }
}
__device__ __forceinline__ void p0_prologue(Frame& F) {
    float* scr = (float*)(F.lds + F.wave * 16384);
    const int gw = F.bid * NWAVES + F.wave, NGW = F.G * NWAVES;
    bf16* WinT = (bf16*)(F.ws + WS_WIN); bf16* WoutT = (bf16*)(F.ws + WS_WOUT);
    constexpr int I_IN = 16 * 96, I_OUT = 16 * 32, NITEMS = I_IN + I_OUT;
    for (int it = gw; it < NITEMS; it += NGW) {
        int r = it;
        if (r < I_IN) { const int kb = r / 96, nb = r % 96, n0 = 32 * nb; const float sc = (n0 < C_KDA) ? C2 : ((n0 >= C_KR && n0 < C_VR) ? 0.125f : 1.f);
            p0_transpose_item(F.w_in, D, NIN, WinT, 64 * kb, n0, n0, sc, scr, F.lane); continue; }
        r -= I_IN;
        { const int kb = r / 32, nb = r % 32; p0_transpose_item(F.w_out, D, D, WoutT, 64 * kb, 32 * nb, 32 * nb, 1.f, scr, F.lane); }
    }
    float* WrT = (float*)(F.ws + WS_WRT);
    for (int i = F.bid * 512 + F.tid; i < NRT * D; i += F.G * 512) { const int c = i / D, k = i % D; WrT[i] = (c < 4) ? F.wrg[k * 4 + c] : F.wre[k * 32 + (c - 4)]; }
    bf16* XN1 = (bf16*)(F.ws + WS_A);
    for (int m = gw; m < T; m += NGW) rms_row_to_bf16(F.x + (size_t)m * D, F.g1, XN1 + (size_t)m * D, F.lane);
}

__device__ __forceinline__ void convert_experts(Frame& F) {
    float* scr = (float*)(F.lds + F.wave * 16384);
    const int gw = F.bid * NWAVES + F.wave, NGW = F.G * NWAVES;
    bf16* WguT = (bf16*)(F.ws + WS_WGU); bf16* WdT = (bf16*)(F.ws + WS_WD);
    constexpr int I_E = 768;
    for (int it = gw; it < NE * I_E; it += NGW) {
        const int e = it / I_E; int r = it % I_E;
        if (r < 256) { const int kb = r / 16, nb = r % 16, n0 = 32 * nb; p0_transpose_item(F.wg + (size_t)e * D * HIDN, D, HIDN, WguT + (size_t)e * 1024 * D, 64 * kb, n0, 256 * (n0 >> 7) + (n0 & 127), 1.f, scr, F.lane); continue; }
        r -= 256;
        if (r < 256) { const int kb = r / 16, nb = r % 16, n0 = 32 * nb; p0_transpose_item(F.wu + (size_t)e * D * HIDN, D, HIDN, WguT + (size_t)e * 1024 * D, 64 * kb, n0, 256 * (n0 >> 7) + 128 + (n0 & 127), 1.f, scr, F.lane); continue; }
        r -= 256;
        { const int kb = r / 32, nb = r % 32; p0_transpose_item(F.wd + (size_t)e * HIDN * D, HIDN, D, WdT + (size_t)e * D * HIDN, 64 * kb, 32 * nb, 32 * nb, 1.f, scr, F.lane); }
    }
}

namespace da {
using bf16x8 = __attribute__((ext_vector_type(8))) short;
using s16x4  = __attribute__((ext_vector_type(4))) short;
using f32x16 = __attribute__((ext_vector_type(16))) float;
using u32x4  = __attribute__((ext_vector_type(4))) unsigned;
constexpr int KVBLK = 64;
constexpr int SHM_V = KVBLK * 128 * 2, SHM_K = KVBLK * 128 * 2;
constexpr float THR = 8.f;
#ifndef DA_SDEPTH
#define DA_SDEPTH 1
#endif
#define DA_KSWZ(row, colB) ((row) * 256 + ((colB) ^ (((row) & 7) << 4)))
#define DA_SBAR() __builtin_amdgcn_sched_barrier(0)
__device__ __forceinline__ int crow(int r, int hi) { return (r & 3) + 8 * (r >> 2) + 4 * hi; }
__device__ __forceinline__ unsigned cvtpk(float lo, float hi) { unsigned r; asm volatile("v_cvt_pk_bf16_f32 %0, %1, %2" : "=v"(r) : "v"(lo), "v"(hi)); return r; }
__device__ __forceinline__ void partialSM(f32x16& p0, f32x16& p1, float& m_reg, float& alpha, float dq, float nslope2, bool masked, bool gen, bool& fresh) {
  if (gen) {
#pragma unroll
    for (int r = 0; r < 16; ++r) { const float c = (float)((r & 3) + 8 * (r >> 2)), d = dq - c, d1 = dq - 32.f - c;
      p0[r] = fmaf(nslope2, fabsf(d) - d, p0[r]); p1[r] = fmaf(nslope2, fabsf(d1) - d1, p1[r]); } }
  if (masked) {
#pragma unroll
    for (int r = 0; r < 16; ++r) { p0[r] = -INFINITY; p1[r] = -INFINITY; } }
  float pmax = p0[0];
#pragma unroll
  for (int r = 1; r < 16; ++r) pmax = fmaxf(pmax, p0[r]);
#pragma unroll
  for (int r = 0; r < 16; ++r) pmax = fmaxf(pmax, p1[r]);
  { auto rr = __builtin_amdgcn_permlane32_swap(__float_as_uint(pmax), __float_as_uint(pmax), false, false);
    pmax = fmaxf(__uint_as_float(rr[0]), __uint_as_float(rr[1])); }
  alpha = 1.f;
  if (fresh && !masked) { fresh = false; m_reg = pmax;
#pragma unroll
    for (int r = 0; r < 16; ++r) { p0[r] -= pmax; p1[r] -= pmax; } }
  else if (!__builtin_expect(__all(pmax <= THR), 1)) { const float dl = fmaxf(pmax, 0.f); m_reg += dl; alpha = __builtin_amdgcn_exp2f(-dl);
#pragma unroll
    for (int r = 0; r < 16; ++r) { p0[r] -= dl; p1[r] -= dl; } }
#pragma unroll
  for (int r = 0; r < 16; ++r) p0[r] = __builtin_amdgcn_exp2f(p0[r]);
}
__device__ __forceinline__ void finishSM(f32x16& p0, f32x16& p1, float alpha, float& l_reg, bf16x8& pa0, bf16x8& pa1, bf16x8& pa2, bf16x8& pa3) {
#pragma unroll
  for (int r = 0; r < 16; ++r) p1[r] = __builtin_amdgcn_exp2f(p1[r]);
  float ps = 0;
#pragma unroll
  for (int r = 0; r < 16; ++r) ps += p0[r];
#pragma unroll
  for (int r = 0; r < 16; ++r) ps += p1[r];
  { auto rr = __builtin_amdgcn_permlane32_swap(__float_as_uint(ps), __float_as_uint(ps), false, false);
    ps = __uint_as_float(rr[0]) + __uint_as_float(rr[1]); }
  l_reg = l_reg * alpha + ps;
#define DA_PK4(P, BASE, OUT) do { unsigned a0 = cvtpk(P[BASE + 0], P[BASE + 1]), a1 = cvtpk(P[BASE + 2], P[BASE + 3]);   \
    unsigned b0 = cvtpk(P[BASE + 4], P[BASE + 5]), b1 = cvtpk(P[BASE + 6], P[BASE + 7]);                              \
    auto r0 = __builtin_amdgcn_permlane32_swap(a0, b0, false, false); auto r1 = __builtin_amdgcn_permlane32_swap(a1, b1, false, false); \
    u32x4 w = {r0[0], r1[0], r0[1], r1[1]}; OUT = *reinterpret_cast<bf16x8*>(&w); } while (0)
  DA_PK4(p0, 0, pa0); DA_PK4(p0, 8, pa1); DA_PK4(p1, 0, pa2); DA_PK4(p1, 8, pa3);
#undef DA_PK4
}
__device__ __forceinline__ void qkt(f32x16& p0, f32x16& p1, const char* Ks, const bf16x8* qr, int r32, int hi, int mp, float tinit, float slope2) {
#pragma unroll
  for (int r = 0; r < 16; ++r) { const float c = (float)((r & 3) + 8 * (r >> 2)); p0[r] = fmaf(slope2, c, tinit); p1[r] = fmaf(slope2, c + 32.f, tinit); }
#pragma unroll
  for (int d0 = 0; d0 < 4; ++d0) { const int cb = (mp * 64 + d0 * 16 + hi * 8) * 2;
    const bf16x8 b0 = *reinterpret_cast<const bf16x8*>(Ks + DA_KSWZ(r32, cb));
    const bf16x8 b1 = *reinterpret_cast<const bf16x8*>(Ks + DA_KSWZ(32 + r32, cb));
    p0 = __builtin_amdgcn_mfma_f32_32x32x16_bf16(b0, qr[d0], p0, 0, 0, 0);
    p1 = __builtin_amdgcn_mfma_f32_32x32x16_bf16(b1, qr[d0], p1, 0, 0, 0); }
}
__device__ __forceinline__ int v_st(int k, int c) { const int kk = (k & ~0xC) | ((k & 4) << 1) | ((k & 8) >> 1); return ((kk >> 3) * 4 + (c >> 5)) * 512 + ((kk & 7) * 32 + (c & 31)) * 2; }
__device__ __forceinline__ int v_rd_base(int lane) { return ((lane & 3) << 3) | (((lane >> 2) & 3) << 6) | (((lane >> 4) & 1) << 5) | (((lane >> 5) & 1) << 8); }
constexpr int v_rd_off(int d0, int ks, int half) { return d0 * 512 + ks * 4096 + half * 2048; }
template <int OFF> __device__ __forceinline__ s16x4 tr_read(int vb) {
  s16x4 r; asm volatile("ds_read_b64_tr_b16 %0, %1 offset:%2" : "=&v"(r) : "v"(vb), "i"(OFF) : "memory"); return r;
}
template <int D0> __device__ __forceinline__ void pv_one(f32x16& od, int vb, bf16x8 pa0, bf16x8 pa1, bf16x8 pa2, bf16x8 pa3) {
  const s16x4 l0 = tr_read<v_rd_off(D0, 0, 0)>(vb), h0 = tr_read<v_rd_off(D0, 0, 1)>(vb), l1 = tr_read<v_rd_off(D0, 1, 0)>(vb), h1 = tr_read<v_rd_off(D0, 1, 1)>(vb);
  const s16x4 l2 = tr_read<v_rd_off(D0, 2, 0)>(vb), h2 = tr_read<v_rd_off(D0, 2, 1)>(vb), l3 = tr_read<v_rd_off(D0, 3, 0)>(vb), h3 = tr_read<v_rd_off(D0, 3, 1)>(vb);
  asm volatile("s_waitcnt lgkmcnt(0)" ::: "memory"); DA_SBAR();
#define DA_PK(L, H) (bf16x8){L[0], L[1], L[2], L[3], H[0], H[1], H[2], H[3]}
  od = __builtin_amdgcn_mfma_f32_32x32x16_bf16(pa0, DA_PK(l0, h0), od, 0, 0, 0);
  od = __builtin_amdgcn_mfma_f32_32x32x16_bf16(pa1, DA_PK(l1, h1), od, 0, 0, 0);
  od = __builtin_amdgcn_mfma_f32_32x32x16_bf16(pa2, DA_PK(l2, h2), od, 0, 0, 0);
  od = __builtin_amdgcn_mfma_f32_32x32x16_bf16(pa3, DA_PK(l3, h3), od, 0, 0, 0);
#undef DA_PK
}
__device__ __forceinline__ void pv_d0(f32x16* o, int vb, bf16x8 pa0, bf16x8 pa1, bf16x8 pa2, bf16x8 pa3) {
  pv_one<0>(o[0], vb, pa0, pa1, pa2, pa3); pv_one<1>(o[1], vb, pa0, pa1, pa2, pa3); pv_one<2>(o[2], vb, pa0, pa1, pa2, pa3); pv_one<3>(o[3], vb, pa0, pa1, pa2, pa3);
}
__device__ __forceinline__ void attn_piece(const unsigned short* __restrict__ PROJ, unsigned short* __restrict__ MIX, const float* __restrict__ subg, unsigned short* __restrict__ PO, float* __restrict__ PS, int h, int u, int jlo, int jhi, int slot, float lam, float slope2, char* lds) {
  const int tid = threadIdx.x, wid = __builtin_amdgcn_readfirstlane(tid >> 6), lane = tid & 63, r32 = lane & 31, hi = lane >> 5, rg = wid & 3, mp = wid >> 2;
  const int q0 = 128 * u, NT = 2 * u + 2;
  constexpr int LDK = NIN;
  const char* kbase = (const char*)(PROJ + C_KDA + h * 128);
  char* V_lds = lds; char* K_lds = lds + 3 * SHM_V;
  LAS char* V_l3 = (LAS char*)lds; LAS char* K_l3 = (LAS char*)lds + 3 * SHM_V;
  float* ws = (float*)(lds + 3 * SHM_V + 2 * SHM_K) + wid * 64; float* li_l = ws; float* al_l = ws + 32;
  float m_reg = 0.f, l_reg = 0; f32x16 o[4] = {}; bf16x8 qr[4]; bool fresh = true;
  const int qpos = q0 + 32 * rg + r32;
  { const char* qb = (const char*)PROJ + ((size_t)(q0 + 32 * rg) * LDK + C_QDA + h * 128 + mp * 64) * 2;
    const unsigned qo = (unsigned)((r32 * LDK + hi * 8) * 2);
#pragma unroll
    for (int d0 = 0; d0 < 4; ++d0) qr[d0] = *reinterpret_cast<const bf16x8*>(qb + qo + d0 * 32); }
  const float nslope2 = -slope2; const bool mask0 = (rg < 2) && (jlo == 0);
  const int vb0 = (int)(uintptr_t)V_lds + v_rd_base(lane);
  int kb_cur = 0, vs_cur = 0;
#define DQ(jj) ((float)(qpos - (NT - 1 - (jj)) * KVBLK - 4 * hi))
#define DMA_TILE(jj, kbo, vso) do { const char* gt_ = kbase + (size_t)(NT - 1 - (jj)) * (size_t)(KVBLK * LDK * 2); int l_ = lane; asm volatile("" : "+v"(l_)); \
    _Pragma("unroll") for (int i_ = 0; i_ < 2; ++i_) { \
      const int row_ = 8 * wid + 4 * i_ + (l_ >> 4), c_ = (l_ & 15) ^ (row_ & 7); \
      const int st_ = 4 * wid + 2 * i_ + (l_ >> 5), kk_ = 8 * (st_ >> 2) + ((l_ & 31) >> 2), k_ = (kk_ & ~0xC) | ((kk_ & 4) << 1) | ((kk_ & 8) >> 1), cc_ = 32 * (st_ & 3) + 8 * (l_ & 3); \
      __builtin_amdgcn_global_load_lds((const unsigned*)(gt_ + (unsigned)(row_ * LDK * 2 + c_ * 16)), (LAS unsigned*)(K_l3 + (kbo) + wid * 2048 + i_ * 1024), 16, 0, 0); \
      __builtin_amdgcn_global_load_lds((const unsigned*)(gt_ + (unsigned)(k_ * LDK * 2 + cc_ * 2 + (C_VDA - C_KDA) * 2)), (LAS unsigned*)(V_l3 + (vso) + wid * 2048 + i_ * 1024), 16, 0, 0); } } while (0)
#define STEP_SYNC() do { asm volatile("s_waitcnt vmcnt(0)" ::: "memory"); __syncthreads(); } while (0)
#define RESC(a) do { if (__any((a) < 1.f)) { if (hi == 0) al_l[r32] = (a); asm volatile("s_waitcnt lgkmcnt(0)" ::: "memory"); \
    _Pragma("unroll") for (int d = 0; d < 4; ++d) _Pragma("unroll") for (int r = 0; r < 16; ++r) o[d][r] *= al_l[crow(r, hi)]; } } while (0)
#define NEXT_K(x) ((x) ^ SHM_K)
#define NEXT_V(x) ((x) == 2 * SHM_V ? 0 : (x) + SHM_V)
  f32x16 pA0, pA1, pB0, pB1; float alA, alB; bf16x8 pa0, pa1, pa2, pa3;
  __syncthreads();
  DMA_TILE(jlo, 0, 0); STEP_SYNC();
  if (jlo + 1 < jhi) DMA_TILE(jlo + 1, SHM_K, SHM_V);
  qkt(pA0, pA1, K_lds, qr, r32, hi, mp, nslope2 * DQ(jlo) - m_reg, slope2); partialSM(pA0, pA1, m_reg, alA, DQ(jlo), nslope2, mask0, jlo < 2, fresh);
  STEP_SYNC();
#define STEP(X0, X1, alX, Y0, Y1, alY, jj) do { \
    const int kb_n = NEXT_K(kb_cur), vs_n = NEXT_V(vs_cur); \
    if ((jj) + 1 < jhi) DMA_TILE((jj) + 1, kb_cur, NEXT_V(vs_n));        \
    DA_SBAR(); qkt(X0, X1, K_lds + kb_n, qr, r32, hi, mp, nslope2 * DQ(jj) - m_reg, slope2); \
    finishSM(Y0, Y1, alY, l_reg, pa0, pa1, pa2, pa3); DA_SBAR(); \
    pv_d0(o, vb0 + vs_cur, pa0, pa1, pa2, pa3); partialSM(X0, X1, m_reg, alX, DQ(jj), nslope2, false, (jj) < 2, fresh); \
    STEP_SYNC(); RESC(alX); kb_cur = kb_n; vs_cur = vs_n; } while (0)
  int jj = jlo + 1;
  while (jj + 1 < jhi) { STEP(pB0, pB1, alB, pA0, pA1, alA, jj); STEP(pA0, pA1, alA, pB0, pB1, alB, jj + 1); jj += 2; }
  if (jj < jhi) { STEP(pB0, pB1, alB, pA0, pA1, alA, jj);
    finishSM(pB0, pB1, alB, l_reg, pa0, pa1, pa2, pa3); DA_SBAR(); pv_d0(o, vb0 + vs_cur, pa0, pa1, pa2, pa3); }
  else { finishSM(pA0, pA1, alA, l_reg, pa0, pa1, pa2, pa3); DA_SBAR(); pv_d0(o, vb0 + vs_cur, pa0, pa1, pa2, pa3); }
#undef STEP
  if (hi == 0) li_l[r32] = l_reg; asm volatile("s_waitcnt lgkmcnt(0)" ::: "memory");
  float rli[16];
  if (slot >= 0) {
#pragma unroll
    for (int r = 0; r < 16; ++r) { const float lv = li_l[crow(r, hi)]; rli[r] = lv > 0.f ? __builtin_amdgcn_rcpf(lv) : 0.f; }
    int hi3 = hi, c33 = r32; asm volatile("" : "+v"(hi3), "+v"(c33));
    char* Pw = (char*)PO + ((size_t)((slot * 2 + mp) * 128 + 32 * rg) * 128) * 2;
#pragma unroll
    for (int r = 0; r < 16; ++r) { const unsigned oo = (unsigned)((crow(r, hi3) * 128 + c33) * 2);
#pragma unroll
      for (int d0 = 0; d0 < 4; ++d0) *(unsigned short*)(Pw + oo + d0 * 64) = (unsigned short)f2bf(o[d0][r] * rli[r]); }
    if (hi3 == 0) { float* st = PS + ((size_t)(slot * 2 + mp) * 128 + 32 * rg + c33) * 2; st[0] = m_reg; st[1] = l_reg; }
    return;
  }
#pragma unroll
  for (int r = 0; r < 16; ++r) rli[r] = (mp ? lam : 1.f) * __builtin_amdgcn_rcpf(li_l[crow(r, hi)]);
  __syncthreads();
  int hi2 = hi, c32 = r32; asm volatile("" : "+v"(hi2), "+v"(c32));
  float* X1 = (float*)lds + (rg * 32) * 128;
  if (mp == 1) {
#pragma unroll
    for (int r = 0; r < 16; ++r)
#pragma unroll
      for (int d0 = 0; d0 < 4; ++d0) X1[crow(r, hi2) * 128 + d0 * 32 + c32] = o[d0][r] * rli[r];
  }
  __syncthreads();
  if (mp == 0) {
    float ss[16];
#pragma unroll
    for (int r = 0; r < 16; ++r) { float s = 0.f;
#pragma unroll
      for (int d0 = 0; d0 < 4; ++d0) { const float dv = o[d0][r] * rli[r] - X1[crow(r, hi2) * 128 + d0 * 32 + c32]; o[d0][r] = dv; s += dv * dv; }
      ss[r] = s; }
#pragma unroll
    for (int r = 0; r < 16; ++r) {
#pragma unroll
      for (int off = 1; off < 32; off <<= 1) ss[r] += __shfl_xor(ss[r], off);
      ss[r] = (1.f - LAMBDA_INIT) / sqrtf(ss[r] * (1.f / 128.f) + EPS); }
    float gsub[4];
#pragma unroll
    for (int d0 = 0; d0 < 4; ++d0) gsub[d0] = subg[d0 * 32 + c32];
    char* Ow = (char*)MIX + ((size_t)(q0 + 32 * rg) * D + h * 128) * 2;
#pragma unroll
    for (int r = 0; r < 16; ++r) { const unsigned oo = (unsigned)((crow(r, hi2) * D + c32) * 2);
#pragma unroll
      for (int d0 = 0; d0 < 4; ++d0) *(unsigned short*)(Ow + oo + d0 * 64) = (unsigned short)f2bf(o[d0][r] * ss[r] * gsub[d0]); }
  }
#undef DQ
#undef DMA_TILE
#undef STEP_SYNC
#undef RESC
#undef NEXT_K
#undef NEXT_V
}

constexpr float SKIP_TH = 40.f;
struct ItemTab { int* hdr; int* NP; int* SOFF; int* TA; int* TB; int* SC; };
__device__ __forceinline__ ItemTab item_ptrs(char* lds) { ItemTab t; t.hdr = (int*)(lds + ITEM_OFF); t.NP = t.hdr + 16; t.SOFF = t.NP + 512; t.TA = t.SOFF + 512; t.TB = t.TA + 1536; t.SC = t.TB + 1536; return t; }
__device__ __forceinline__ int block_scan_incl(int v, int* sc, int tid) {
  sc[tid] = v; __syncthreads();
  for (int off = 1; off < 512; off <<= 1) { const int a = tid >= off ? sc[tid - off] : 0; __syncthreads(); sc[tid] += a; __syncthreads(); }
  return sc[tid];
}
__device__ __forceinline__ void build_items(const unsigned* norm, char* lds) {
  const ItemTab T = item_ptrs(lds); const int tid = threadIdx.x;
  __syncthreads();
  if (tid < 4) { float B = 0.f;
    for (int m = 0; m < 2; ++m) { const int qb = tid * 2 + m;
      const float q2 = __uint_as_float(__hip_atomic_load(norm + qb * 2, RLX_AGENT)) + __uint_as_float(__hip_atomic_load(norm + qb * 2 + 1, RLX_AGENT));
      const float k2 = __uint_as_float(__hip_atomic_load(norm + (8 + qb) * 2, RLX_AGENT)) + __uint_as_float(__hip_atomic_load(norm + (8 + qb) * 2 + 1, RLX_AGENT));
      B = fmaxf(B, sqrtf(q2 * k2)); }
    B *= 1.02f;
    const float slope2 = exp2f(-2.f * (float)(tid + 1)) * LOG2E, dw = (2.f * B + SKIP_TH) / slope2;
    float jf = ceilf((dw + 127.f) * (1.f / 64.f)) + 1.f; jf = fminf(fmaxf(jf, 3.f), 256.f);
    T.hdr[4 + tid] = (int)jf; }
  __syncthreads();
  const int h = 3 - (tid >> 7), u = 127 - (tid & 127);
  const int J = min(2 * u + 2, T.hdr[4 + h]);
  const int total = block_scan_incl(J, T.SC, tid); __syncthreads();
  const int tot = T.SC[511]; __syncthreads();
  const int pmax = max(24, (tot + 767) / 768), np = (J + pmax - 1) / pmax;
  const int off = block_scan_incl(np, T.SC, tid) - np; __syncthreads();
  const int N = T.SC[511]; __syncthreads();
  const int so = block_scan_incl(np > 1 ? np : 0, T.SC, tid) - (np > 1 ? np : 0); __syncthreads();
  (void)total;
  T.NP[tid] = np; T.SOFF[tid] = np > 1 ? so : -1;
  for (int k = 0; k < np; ++k) { T.TA[off + k] = h | (u << 2) | (k << 9) | (np << 13); T.TB[off + k] = np > 1 ? so + k : -1; }
  if (tid == 0) { T.hdr[0] = N; T.hdr[1] = pmax; }
  __syncthreads();
}
__device__ __forceinline__ void attn_combine_half(const unsigned short* __restrict__ PO, const float* __restrict__ PS, unsigned short* __restrict__ MIX, const float* __restrict__ subg, int h, int u, int half, int np, int slot0, float lam) {
  const int tid = threadIdx.x, row = 64 * half + (tid >> 3), cq = tid & 7;
  float val[2][16];
#pragma unroll
  for (int mp = 0; mp < 2; ++mp) {
    const float* st0 = PS + ((size_t)(slot0 * 2 + mp) * 128 + row) * 2;
    const unsigned short* po0 = PO + ((size_t)(slot0 * 2 + mp) * 128 + row) * 128 + 16 * cq;
    float mmax = -1e30f;
#pragma unroll 4
    for (int p = 0; p < np; ++p) mmax = fmaxf(mmax, st0[(size_t)p * 512]);
    float W = 0.f;
#pragma unroll
    for (int i = 0; i < 16; ++i) val[mp][i] = 0.f;
#pragma unroll 4
    for (int p = 0; p < np; ++p) { const v2u sv = *(const v2u*)(st0 + (size_t)p * 512); const float w = __uint_as_float(sv.y) * exp2f(__uint_as_float(sv.x) - mmax); W += w;
      const v4u* src = (const v4u*)(po0 + (size_t)p * 32768); const v4u a = src[0], b = src[1];
      val[mp][0] += w * bflo(a.x); val[mp][1] += w * bfhi(a.x); val[mp][2] += w * bflo(a.y); val[mp][3] += w * bfhi(a.y); val[mp][4] += w * bflo(a.z); val[mp][5] += w * bfhi(a.z); val[mp][6] += w * bflo(a.w); val[mp][7] += w * bfhi(a.w);
      val[mp][8] += w * bflo(b.x); val[mp][9] += w * bfhi(b.x); val[mp][10] += w * bflo(b.y); val[mp][11] += w * bfhi(b.y); val[mp][12] += w * bflo(b.z); val[mp][13] += w * bfhi(b.z); val[mp][14] += w * bflo(b.w); val[mp][15] += w * bfhi(b.w); }
    const float rw = (mp ? lam : 1.f) / W;
#pragma unroll
    for (int i = 0; i < 16; ++i) val[mp][i] *= rw; }
  float ss = 0.f;
#pragma unroll
  for (int i = 0; i < 16; ++i) { val[0][i] -= val[1][i]; ss += val[0][i] * val[0][i]; }
  ss += __shfl_xor(ss, 1); ss += __shfl_xor(ss, 2); ss += __shfl_xor(ss, 4);
  const float rstd = (1.f - LAMBDA_INIT) / sqrtf(ss * (1.f / 128.f) + EPS);
  unsigned w[8];
#pragma unroll
  for (int i = 0; i < 8; ++i) w[i] = pk2(val[0][2 * i] * rstd * subg[16 * cq + 2 * i], val[0][2 * i + 1] * rstd * subg[16 * cq + 2 * i + 1]);
  v4u* dst = (v4u*)(MIX + (size_t)(128 * u + row) * D + h * 128 + 16 * cq);
  dst[0] = (v4u){w[0], w[1], w[2], w[3]}; dst[1] = (v4u){w[4], w[5], w[6], w[7]};
}
}


__device__ __forceinline__ void p2_attention(Frame& F) {
    float a = 0.f, b = 0.f;
#pragma unroll 1
    for (int i = 0; i < 64; ++i) { a += F.lq1[i] * F.lk1[i]; b += F.lq2[i] * F.lk2[i]; }
    const float lam = __expf(a) - __expf(b) + LAMBDA_INIT;
    da::build_items(F.ctl + CW_NORM, (char*)F.lds);
    const da::ItemTab IT = da::item_ptrs((char*)F.lds);
    const int N = IT.hdr[0];
#ifndef ATTN_REP
#define ATTN_REP 1
#endif
#pragma unroll 1
    for (int arep = 0; arep < ATTN_REP; ++arep)
    for (;;) {
        __syncthreads();
        if (F.tid == 0) IT.hdr[8] = (int)__hip_atomic_fetch_add(F.ctl + CW_QHEAD + 64 * arep, 1u, RLX_AGENT);
        __syncthreads();
        const int it = IT.hdr[8];
        if (it >= N) break;
        const int a = IT.TA[it], slot = IT.TB[it], h = a & 3, u = (a >> 2) & 127, k = (a >> 9) & 15, np = (a >> 13) & 15;
        const int J = min(2 * u + 2, IT.hdr[4 + h]);
        const float slope2 = exp2f(-2.f * (float)(h + 1)) * LOG2E;
        da::attn_piece((const bf16*)(F.ws + WS_PROJ), (bf16*)(F.ws + WS_A), F.subg, (bf16*)(F.ws + WS_PARTO), (float*)(F.ws + WS_PARTS), h, u, (k * J) / np, ((k + 1) * J) / np, slot, lam, slope2, (char*)F.lds);
    }
    __syncthreads();
}
__device__ __forceinline__ void p4_attn_combine(Frame& F, bool have_items) {
    float a = 0.f, b = 0.f;
#pragma unroll 1
    for (int i = 0; i < 64; ++i) { a += F.lq1[i] * F.lk1[i]; b += F.lq2[i] * F.lk2[i]; }
    const float lam = __expf(a) - __expf(b) + LAMBDA_INIT;
    if (!have_items) da::build_items(F.ctl + CW_NORM, (char*)F.lds);
    const da::ItemTab IT = da::item_ptrs((char*)F.lds);
    for (int idx = F.bid; idx < 1024; idx += F.G) { const int t = idx >> 1, np = IT.NP[t];
        if (np > 1) da::attn_combine_half((const bf16*)(F.ws + WS_PARTO), (const float*)(F.ws + WS_PARTS), (bf16*)(F.ws + WS_A), F.subg, 3 - (t >> 7), 127 - (t & 127), idx & 1, np, IT.SOFF[t], lam); }
    __syncthreads();
}

namespace ret {
using da::bf16x8; using da::s16x4; using da::f32x16; using da::u32x4; using da::crow; using da::cvtpk; using da::v_st; using da::v_rd_base;
constexpr int KIMG = 8192, VIMG = 16384;
__device__ __forceinline__ int k_st(int k, int c) { const int kk = (k & ~0xC) | ((k & 4) << 1) | ((k & 8) >> 1); return ((kk >> 3) * 2 + (c >> 5)) * 512 + ((kk & 7) * 32 + (c & 31)) * 2; }
template <int OFF> __device__ __forceinline__ s16x4 tr_read(int vb) { s16x4 r; asm volatile("ds_read_b64_tr_b16 %0, %1 offset:%2" : "=&v"(r) : "v"(vb), "i"(OFF) : "memory"); return r; }
#define RT_PK(L, H) (bf16x8){L[0], L[1], L[2], L[3], H[0], H[1], H[2], H[3]}
#define RT_WAITL() do { asm volatile("s_waitcnt lgkmcnt(0)" ::: "memory"); __builtin_amdgcn_sched_barrier(0); } while (0)
__device__ __forceinline__ float lg2gamma(int h) { return log2f(1.f - exp2f(-5.f - (float)h)); }
__device__ __forceinline__ bf16x8 packS(const f32x16& S, int s) {
  u32x4 w; const int b = 8 * s; w.x = cvtpk(S[b + 0], S[b + 1]); w.y = cvtpk(S[b + 2], S[b + 3]); w.z = cvtpk(S[b + 4], S[b + 5]); w.w = cvtpk(S[b + 6], S[b + 7]); return __builtin_bit_cast(bf16x8, w); }
__device__ __forceinline__ bf16x8 scale8(bf16x8 v, float w) {
  u32x4 u = __builtin_bit_cast(u32x4, v), o;
  o.x = cvtpk(bflo(u.x) * w, bfhi(u.x) * w); o.y = cvtpk(bflo(u.y) * w, bfhi(u.y) * w); o.z = cvtpk(bflo(u.z) * w, bfhi(u.z) * w); o.w = cvtpk(bflo(u.w) * w, bfhi(u.w) * w);
  return __builtin_bit_cast(bf16x8, o); }

__device__ __forceinline__ void sweep_unit(const unsigned short* __restrict__ PROJ, float* __restrict__ OL, float* __restrict__ E, int g, int h, char* lds) {
  const int tid = threadIdx.x, wid = __builtin_amdgcn_readfirstlane(tid >> 6), lane = tid & 63, r32 = lane & 31, hi = lane >> 5, tq = wid & 1, dvq = wid >> 1;
  const float lg2 = lg2gamma(h), dec64 = exp2f(lg2 * 64.f);
  const int iq = 32 * tq + r32;
  f32x16 S0 = {}, S1 = {};
  char* Kimg = lds; char* Vimg = lds + KIMG;
  const int krow = tid >> 3, kch = (tid & 7) * 8, sr = tid >> 4, sc = (tid & 15) * 8;
  const float kdec = exp2f(lg2 * (float)(63 - krow));
  const int kst = k_st(krow, kch), vst0 = v_st(sr, sc), vst1 = v_st(32 + sr, sc);
  const int vbV = (int)(uintptr_t)Vimg + v_rd_base(lane) + dvq * 512, vbK = (int)(uintptr_t)Kimg + v_rd_base(lane);
  const int U = g * 4 + h;
#pragma unroll 1
  for (int c = 0; c < 4; ++c) {
    const int tok0 = 256 * g + 64 * c;
    const char* pb = (const char*)PROJ + (size_t)tok0 * (NIN * 2);
    __syncthreads();
    { const bf16x8 kv = *reinterpret_cast<const bf16x8*>(pb + (unsigned)((krow * NIN + C_KR + h * 64 + kch) * 2));
      const bf16x8 v0 = *reinterpret_cast<const bf16x8*>(pb + (unsigned)((sr * NIN + C_VR + h * 128 + sc) * 2));
      const bf16x8 v1 = *reinterpret_cast<const bf16x8*>(pb + (unsigned)(((32 + sr) * NIN + C_VR + h * 128 + sc) * 2));
      *(bf16x8*)(Kimg + kst) = scale8(kv, kdec); *(bf16x8*)(Vimg + vst0) = v0; *(bf16x8*)(Vimg + vst1) = v1; }
    bf16x8 kf0[4], kf1[4], qr[4], qp[2][2];
    { const unsigned ko = (unsigned)((r32 * NIN + C_KR + h * 64 + hi * 8) * 2), qo = (unsigned)((iq * NIN + C_QR + h * 64 + hi * 8) * 2), qpo = (unsigned)((iq * NIN + C_QR + h * 64 + hi * 4) * 2);
#pragma unroll
      for (int d0 = 0; d0 < 4; ++d0) { kf0[d0] = *reinterpret_cast<const bf16x8*>(pb + ko + d0 * 32); qr[d0] = *reinterpret_cast<const bf16x8*>(pb + qo + d0 * 32);
        kf1[d0] = tq ? *reinterpret_cast<const bf16x8*>(pb + ko + 32 * NIN * 2 + d0 * 32) : bf16x8{}; }
#pragma unroll
      for (int t = 0; t < 2; ++t)
#pragma unroll
        for (int s = 0; s < 2; ++s) { const v2u a = *reinterpret_cast<const v2u*>(pb + qpo + (32 * t + 16 * s) * 2), b = *reinterpret_cast<const v2u*>(pb + qpo + (32 * t + 16 * s + 8) * 2);
          const u32x4 w = {a.x, a.y, b.x, b.y}; qp[t][s] = __builtin_bit_cast(bf16x8, w); } }
    f32x16 p0 = {}, p1 = {};
#pragma unroll
    for (int d0 = 0; d0 < 4; ++d0) p0 = __builtin_amdgcn_mfma_f32_32x32x16_bf16(kf0[d0], qr[d0], p0, 0, 0, 0);
    if (tq) {
#pragma unroll
      for (int d0 = 0; d0 < 4; ++d0) p1 = __builtin_amdgcn_mfma_f32_32x32x16_bf16(kf1[d0], qr[d0], p1, 0, 0, 0); }
#pragma unroll
    for (int r = 0; r < 16; ++r) { const int d = iq - crow(r, hi), d1 = d - 32;
      p0[r] = d >= 0 ? p0[r] * __builtin_amdgcn_exp2f(lg2 * (float)d) : 0.f; p1[r] = d1 >= 0 ? p1[r] * __builtin_amdgcn_exp2f(lg2 * (float)d1) : 0.f; }
    bf16x8 pa0, pa1, pa2, pa3;
#define RT_PK4(P, BASE, OUT) do { unsigned a0 = cvtpk(P[BASE + 0], P[BASE + 1]), a1 = cvtpk(P[BASE + 2], P[BASE + 3]);   \
    unsigned b0 = cvtpk(P[BASE + 4], P[BASE + 5]), b1 = cvtpk(P[BASE + 6], P[BASE + 7]);                              \
    auto r0 = __builtin_amdgcn_permlane32_swap(a0, b0, false, false); auto r1 = __builtin_amdgcn_permlane32_swap(a1, b1, false, false); \
    u32x4 w = {r0[0], r1[0], r0[1], r1[1]}; OUT = __builtin_bit_cast(bf16x8, w); } while (0)
    RT_PK4(p0, 0, pa0); RT_PK4(p0, 8, pa1); RT_PK4(p1, 0, pa2); RT_PK4(p1, 8, pa3);
#undef RT_PK4
    __syncthreads();
    const s16x4 vl0 = tr_read<0 * 4096>(vbV), vh0 = tr_read<0 * 4096 + 2048>(vbV), vl1 = tr_read<1 * 4096>(vbV), vh1 = tr_read<1 * 4096 + 2048>(vbV);
    const s16x4 vl2 = tr_read<2 * 4096>(vbV), vh2 = tr_read<2 * 4096 + 2048>(vbV), vl3 = tr_read<3 * 4096>(vbV), vh3 = tr_read<3 * 4096 + 2048>(vbV);
    RT_WAITL();
    const bf16x8 vf0 = RT_PK(vl0, vh0), vf1 = RT_PK(vl1, vh1), vf2 = RT_PK(vl2, vh2), vf3 = RT_PK(vl3, vh3);
    f32x16 oa = {}, xa = {};
    oa = __builtin_amdgcn_mfma_f32_32x32x16_bf16(pa0, vf0, oa, 0, 0, 0); oa = __builtin_amdgcn_mfma_f32_32x32x16_bf16(pa1, vf1, oa, 0, 0, 0);
    if (tq) { oa = __builtin_amdgcn_mfma_f32_32x32x16_bf16(pa2, vf2, oa, 0, 0, 0); oa = __builtin_amdgcn_mfma_f32_32x32x16_bf16(pa3, vf3, oa, 0, 0, 0); }
    xa = __builtin_amdgcn_mfma_f32_32x32x16_bf16(qp[0][0], packS(S0, 0), xa, 0, 0, 0); xa = __builtin_amdgcn_mfma_f32_32x32x16_bf16(qp[0][1], packS(S0, 1), xa, 0, 0, 0);
    xa = __builtin_amdgcn_mfma_f32_32x32x16_bf16(qp[1][0], packS(S1, 0), xa, 0, 0, 0); xa = __builtin_amdgcn_mfma_f32_32x32x16_bf16(qp[1][1], packS(S1, 1), xa, 0, 0, 0);
    { float* ol = OL + ((size_t)(((U * 4 + c) * 2 + tq) * 4 + dvq) * 16) * 64 + lane;
#pragma unroll
      for (int r = 0; r < 16; ++r) ol[r * 64] = oa[r] + __builtin_amdgcn_exp2f(lg2 * (float)(32 * tq + crow(r, hi) + 1)) * xa[r]; }
#pragma unroll
    for (int r = 0; r < 16; ++r) { S0[r] *= dec64; S1[r] *= dec64; }
    { const s16x4 l0 = tr_read<0 * 2048>(vbK), h0 = tr_read<0 * 2048 + 1024>(vbK), l1 = tr_read<1 * 2048>(vbK), h1 = tr_read<1 * 2048 + 1024>(vbK);
      const s16x4 l2 = tr_read<2 * 2048>(vbK), h2 = tr_read<2 * 2048 + 1024>(vbK), l3 = tr_read<3 * 2048>(vbK), h3 = tr_read<3 * 2048 + 1024>(vbK);
      RT_WAITL();
      S0 = __builtin_amdgcn_mfma_f32_32x32x16_bf16(RT_PK(l0, h0), vf0, S0, 0, 0, 0); S0 = __builtin_amdgcn_mfma_f32_32x32x16_bf16(RT_PK(l1, h1), vf1, S0, 0, 0, 0);
      S0 = __builtin_amdgcn_mfma_f32_32x32x16_bf16(RT_PK(l2, h2), vf2, S0, 0, 0, 0); S0 = __builtin_amdgcn_mfma_f32_32x32x16_bf16(RT_PK(l3, h3), vf3, S0, 0, 0, 0); }
    { const s16x4 l0 = tr_read<512 + 0 * 2048>(vbK), h0 = tr_read<512 + 0 * 2048 + 1024>(vbK), l1 = tr_read<512 + 1 * 2048>(vbK), h1 = tr_read<512 + 1 * 2048 + 1024>(vbK);
      const s16x4 l2 = tr_read<512 + 2 * 2048>(vbK), h2 = tr_read<512 + 2 * 2048 + 1024>(vbK), l3 = tr_read<512 + 3 * 2048>(vbK), h3 = tr_read<512 + 3 * 2048 + 1024>(vbK);
      RT_WAITL();
      S1 = __builtin_amdgcn_mfma_f32_32x32x16_bf16(RT_PK(l0, h0), vf0, S1, 0, 0, 0); S1 = __builtin_amdgcn_mfma_f32_32x32x16_bf16(RT_PK(l1, h1), vf1, S1, 0, 0, 0);
      S1 = __builtin_amdgcn_mfma_f32_32x32x16_bf16(RT_PK(l2, h2), vf2, S1, 0, 0, 0); S1 = __builtin_amdgcn_mfma_f32_32x32x16_bf16(RT_PK(l3, h3), vf3, S1, 0, 0, 0); }
  }
  if (tq == 0) { float* e = E + (size_t)U * 8192 + 32 * dvq + r32;
#pragma unroll
    for (int r = 0; r < 16; ++r) { e[(crow(r, hi)) * 128] = S0[r]; e[(32 + crow(r, hi)) * 128] = S1[r]; } }
}

__device__ __forceinline__ void out_unit(const unsigned short* __restrict__ PROJ, const float* __restrict__ OL, const float* __restrict__ E, unsigned short* __restrict__ MIX, int g, int h, char* lds) {
  const int tid = threadIdx.x, wid = __builtin_amdgcn_readfirstlane(tid >> 6), lane = tid & 63, r32 = lane & 31, hi = lane >> 5, c = wid >> 1, tq = wid & 1;
  const float lg2 = lg2gamma(h);
  const int U = g * 4 + h;
  f32x16 olv[4];
  { const float* ol = OL + ((size_t)((U * 4 + c) * 2 + tq) * 4 * 16) * 64 + lane;
#pragma unroll
    for (int d0 = 0; d0 < 4; ++d0)
#pragma unroll
      for (int r = 0; r < 16; ++r) olv[d0][r] = ol[(d0 * 16 + r) * 64]; }
  __syncthreads();
  { const f32x4* cg = (const f32x4*)(E + (size_t)U * 8192) + tid;
#pragma unroll
    for (int i = 0; i < 4; ++i) { const f32x4 a = cg[512 * i]; const int flat = 4 * (tid + 512 * i), dk = flat >> 7, col = flat & 127;
      *(v2u*)(lds + v_st(dk, col)) = (v2u){cvtpk(a.x, a.y), cvtpk(a.z, a.w)}; } }
  __syncthreads();
  const int tok0 = 256 * g + 64 * c + 32 * tq;
  bf16x8 qr[4];
  { const char* qb = (const char*)PROJ + ((size_t)tok0 * NIN + C_QR + h * 64) * 2; const unsigned qo = (unsigned)((r32 * NIN + hi * 8) * 2);
#pragma unroll
    for (int d0 = 0; d0 < 4; ++d0) qr[d0] = *reinterpret_cast<const bf16x8*>(qb + qo + d0 * 32); }
  f32x16 o[4] = {};
  da::pv_d0(o, (int)(uintptr_t)lds + v_rd_base(lane), qr[0], qr[1], qr[2], qr[3]);
  float ss[16];
  {
#pragma unroll
    for (int r = 0; r < 16; ++r) { const float qd = __builtin_amdgcn_exp2f(lg2 * (float)(64 * c + 32 * tq + crow(r, hi) + 1)); float s = 0.f;
#pragma unroll
      for (int d0 = 0; d0 < 4; ++d0) { const float v = olv[d0][r] + qd * o[d0][r]; o[d0][r] = v; s += v * v; }
      ss[r] = s; } }
#pragma unroll
  for (int r = 0; r < 16; ++r) {
#pragma unroll
    for (int off = 1; off < 32; off <<= 1) ss[r] += __shfl_xor(ss[r], off);
    ss[r] = 1.f / sqrtf(ss[r] * (1.f / 128.f) + EPS); }
  const char* gb = (const char*)PROJ + ((size_t)tok0 * NIN + C_GR + h * 128) * 2; char* ob = (char*)MIX + ((size_t)tok0 * D + 512 + h * 128) * 2;
#pragma unroll
  for (int r = 0; r < 16; ++r) { const unsigned go = (unsigned)((crow(r, hi) * NIN + r32) * 2), oo = (unsigned)((crow(r, hi) * D + r32) * 2);
#pragma unroll
    for (int d0 = 0; d0 < 4; ++d0) { const float gv = bf2f(*(const unsigned short*)(gb + go + d0 * 64));
      *(unsigned short*)(ob + oo + d0 * 64) = (unsigned short)f2bf(silu_f(gv) * o[d0][r] * ss[r]); } }
}

__device__ __forceinline__ void carry_phase(const float* __restrict__ E, float* __restrict__ C, int bid, int G, char* lds) {
  const int tid = threadIdx.x, cl = tid & 127, seg = tid >> 7;
  float* tot = (float*)lds;
  for (int blk = bid; blk < 256; blk += G) {
    const int ch = blk * 128 + cl, h = ch >> 13, elem = ch & 8191;
    const float dec = exp2f(lg2gamma(h) * 256.f), dec16 = exp2f(lg2gamma(h) * 4096.f);
    float e[16], P[16];
#pragma unroll
    for (int k = 0; k < 16; ++k) e[k] = E[(size_t)((16 * seg + k) * 4 + h) * 8192 + elem];
    float st = 0.f;
#pragma unroll
    for (int k = 0; k < 16; ++k) { P[k] = st; st = st * dec + e[k]; }
    __syncthreads();
    tot[seg * 128 + cl] = st;
    __syncthreads();
    float cin = 0.f;
    for (int s2 = 0; s2 < seg; ++s2) cin = cin * dec16 + tot[s2 * 128 + cl];
    float w = 1.f;
#pragma unroll
    for (int k = 0; k < 16; ++k) { C[(size_t)((16 * seg + k) * 4 + h) * 8192 + elem] = P[k] + w * cin; w *= dec; }
  }
  __syncthreads();
}
#undef RT_PK
#undef RT_WAITL
}

__device__ __forceinline__ void p7_route(Frame& F) {
    const float* H = F.out; bf16* XN2 = (bf16*)(F.ws + WS_A); const float* WrT = (const float*)(F.ws + WS_WRT);
    int* stok = (int*)(F.ws + WS_STOK); float* sw = (float*)(F.ws + WS_SW);
    const int lane = F.lane, tid = F.tid;
    float* We = (float*)F.lds;
    int* lcnt = (int*)(F.lds + TILEE_OFF); int* lbase = lcnt + 32; int* rec = lbase + 32; float* recw = (float*)(rec + 256);
    __syncthreads();
    for (int i = tid; i < 8192; i += 512) ((f32x4*)We)[i] = ((const f32x4*)(WrT + 4 * D))[i];
    f32x4 wg[4][4], gg[4];
#pragma unroll
    for (int j = 0; j < 4; ++j) { gg[j] = ((const f32x4*)F.g2)[lane + 64 * j];
#pragma unroll
        for (int c = 0; c < 4; ++c) wg[c][j] = ((const f32x4*)(WrT + (size_t)c * D))[lane + 64 * j]; }
    for (int chunk = F.bid; chunk < T / 64; chunk += F.G) {
        __syncthreads();
        if (tid < 32) lcnt[tid] = 0;
        __syncthreads();
        const int tl0 = F.wave * 8, t0 = chunk * 64 + tl0;
        f32x4 nv[4];
#pragma unroll
        for (int j = 0; j < 4; ++j) nv[j] = ((const f32x4*)(H + (size_t)t0 * D))[lane + 64 * j];
#pragma unroll 1
        for (int i = 0; i < 8; ++i) {
            const int t = t0 + i;
            f32x4 v[4]; float s = 0.f;
#pragma unroll
            for (int j = 0; j < 4; ++j) { v[j] = nv[j]; s += (v[j].x * v[j].x + v[j].y * v[j].y) + (v[j].z * v[j].z + v[j].w * v[j].w); }
            if (i < 7) {
#pragma unroll
                for (int j = 0; j < 4; ++j) nv[j] = ((const f32x4*)(H + (size_t)(t + 1) * D))[lane + 64 * j]; }
            const float rstd = 1.f / sqrtf(wave_sum(s) * (1.f / D) + EPS);
            unsigned long long* o8 = (unsigned long long*)(XN2 + (size_t)t * D) + lane;
#pragma unroll
            for (int j = 0; j < 4; ++j) { v[j].x *= rstd * gg[j].x; v[j].y *= rstd * gg[j].y; v[j].z *= rstd * gg[j].z; v[j].w *= rstd * gg[j].w;
                o8[64 * j] = (unsigned long long)pk2(v[j].x, v[j].y) | ((unsigned long long)pk2(v[j].z, v[j].w) << 32); }
            float lg[4];
#pragma unroll
            for (int c = 0; c < 4; ++c) { float p = 0.f;
#pragma unroll
                for (int j = 0; j < 4; ++j) { const f32x4 w = wg[c][j]; p += (v[j].x * w.x + v[j].y * w.y) + (v[j].z * w.z + v[j].w * w.w); }
                lg[c] = wave_sum(p) + F.brg[c]; }
            int grp = 0; float gm = lg[0];
#pragma unroll
            for (int c = 1; c < 4; ++c) if (lg[c] > gm) { gm = lg[c]; grp = c; }
            float gs = 0.f;
#pragma unroll
            for (int c = 0; c < 4; ++c) gs += __expf(lg[c] - gm);
            const float gtop = 1.f / gs;
            float el[8];
#pragma unroll
            for (int k = 0; k < 8; ++k) { const f32x4* wr = (const f32x4*)(We + (size_t)(grp * 8 + k) * D) + lane; float p = 0.f;
#pragma unroll
                for (int j = 0; j < 4; ++j) { const f32x4 w = wr[64 * j]; p += (v[j].x * w.x + v[j].y * w.y) + (v[j].z * w.z + v[j].w * w.w); }
                el[k] = wave_sum(p) + F.bre[grp * 8 + k]; }
            int i1 = 0; float v1 = el[0];
#pragma unroll
            for (int k = 1; k < 8; ++k) if (el[k] > v1) { v1 = el[k]; i1 = k; }
            int i2 = -1; float v2 = -3.0e38f;
#pragma unroll
            for (int k = 0; k < 8; ++k) if (k != i1 && el[k] > v2) { v2 = el[k]; i2 = k; }
            const float ex = __expf(v2 - v1), w1 = 1.f / (1.f + ex), w2 = ex / (1.f + ex);
            if (lane == 0) { const int e1 = grp * 8 + i1, e2 = grp * 8 + i2, tl = tl0 + i;
                const int r1 = atomicAdd(lcnt + e1, 1), r2 = atomicAdd(lcnt + e2, 1);
                rec[tl * 4 + 0] = e1; rec[tl * 4 + 1] = e2; rec[tl * 4 + 2] = r1; rec[tl * 4 + 3] = r2; recw[tl * 2] = gtop * w1; recw[tl * 2 + 1] = gtop * w2; }
        }
        __syncthreads();
        if (tid < 32) { const int c = lcnt[tid]; lbase[tid] = c ? (int)__hip_atomic_fetch_add(F.ctl + CW_CNT + 64 * tid, (unsigned)c, RLX_AGENT) : 0; }
        __syncthreads();
        if (tid < 64) { const int t = chunk * 64 + tid, e1 = rec[tid * 4], e2 = rec[tid * 4 + 1];
            const int i1 = e1 * pg8::SLOTCAP + lbase[e1] + rec[tid * 4 + 2], i2 = e2 * pg8::SLOTCAP + lbase[e2] + rec[tid * 4 + 3];
            stok[i1] = 2 * t; stok[i2] = 2 * t + 1; sw[i1] = recw[tid * 2]; sw[i2] = recw[tid * 2 + 1]; }
    }
    __syncthreads();
}
__device__ __forceinline__ int build_tiles(Frame& F) {
    int* tile_e = (int*)(F.lds + TILEE_OFF); int* tile_i = tile_e + 192; int* cnts = tile_i + 192; int* nt = cnts + 32;
    __syncthreads();
    if (F.tid == 0) { int tiles = 0;
        for (int e = 0; e < NE; ++e) { const int c = (int)__hip_atomic_load(F.ctl + CW_CNT + 64 * e, RLX_AGENT); cnts[e] = c; const int n = (c + 255) >> 8; for (int i = 0; i < n; ++i) { tile_e[tiles + i] = e; tile_i[tiles + i] = i; } tiles += n; }
        nt[0] = tiles; }
    __syncthreads();
    return nt[0];
}
__device__ __forceinline__ void p11_final(Frame& F) {
    const bf16* Y = (const bf16*)(F.ws + WS_WGU);
    const int gw = F.bid * NWAVES + F.wave, NGW = F.G * NWAVES, lane = F.lane;
    for (int t = gw; t < T; t += NGW) {
        f32x4* xr = (f32x4*)(F.out + (size_t)t * D) + lane; const f32x4* gr = (const f32x4*)F.gf + lane;
        const v2u* y0 = (const v2u*)(Y + (size_t)(2 * t) * D) + lane; const v2u* y1 = (const v2u*)(Y + (size_t)(2 * t + 1) * D) + lane;
        f32x4 v[4]; float s = 0.f;
#pragma unroll
        for (int j = 0; j < 4; ++j) { v[j] = xr[64 * j]; const v2u a = y0[64 * j], b = y1[64 * j];
            v[j].x += bflo(a.x) + bflo(b.x); v[j].y += bfhi(a.x) + bfhi(b.x); v[j].z += bflo(a.y) + bflo(b.y); v[j].w += bfhi(a.y) + bfhi(b.y);
            s += (v[j].x * v[j].x + v[j].y * v[j].y) + (v[j].z * v[j].z + v[j].w * v[j].w); }
        const float rstd = 1.f / sqrtf(wave_sum(s) * (1.f / D) + EPS);
#pragma unroll
        for (int j = 0; j < 4; ++j) { const f32x4 gg = gr[64 * j]; xr[64 * j] = (f32x4){v[j].x * rstd * gg.x, v[j].y * rstd * gg.y, v[j].z * rstd * gg.z, v[j].w * rstd * gg.w}; }
    }
}

struct Args { const float* in[18]; float* out; unsigned char* ws; int ph_lo, ph_hi; };
__global__ void __launch_bounds__(NWAVES * 64, 2) fwd_kernel(Args args) {
    extern __shared__ __attribute__((aligned(16))) unsigned char lds[];
    Frame F;
    F.lds = lds; F.tid = threadIdx.x; F.lane = F.tid & 63; F.wave = __builtin_amdgcn_readfirstlane(F.tid >> 6); F.G = gridDim.x; F.bid = blockIdx.x;
    F.ws = args.ws; F.ctl = (unsigned*)(args.ws + WS_CTL); F.out = args.out;
    F.x = args.in[0]; F.g1 = args.in[1]; F.w_in = args.in[2]; F.lq1 = args.in[3]; F.lk1 = args.in[4]; F.lq2 = args.in[5]; F.lk2 = args.in[6]; F.subg = args.in[7];
    F.w_out = args.in[8]; F.g2 = args.in[9]; F.wrg = args.in[10]; F.brg = args.in[11]; F.wre = args.in[12]; F.bre = args.in[13]; F.wg = args.in[14]; F.wu = args.in[15]; F.wd = args.in[16]; F.gf = args.in[17];
    volatile LAS unsigned* MISC = (volatile LAS unsigned*)((LAS unsigned char*)lds + MISC_OFF);
    for (int u = F.tid; u < (LDS_BYTES - LDSCTL_OFF) / 4; u += NWAVES * 64) ((LAS unsigned*)((LAS unsigned char*)lds + LDSCTL_OFF))[u] = 0u;
    __syncthreads();
    const int lo = args.ph_lo, hi = args.ph_hi;
    const int vcu = (F.G % 8 == 0) ? (F.bid % 8) * (F.G / 8) + F.bid / 8 : F.bid;
    XcdBarrier bar; bar.bar = F.ctl + CW_BAR; bar.x = 0; bar.st = nullptr;
    if (hi - lo > 1) bar = xcd_barrier_post(F.ctl + CW_BAR, MISC + 8);
#ifndef PH_MASK
#define PH_MASK 0xFFFF
#endif
#define IN(k) (((PH_MASK >> (k)) & 1) && lo <= (k) && (k) < hi)
#define SEAM(k) do { if (IN(k) && IN((k) + 1)) xcd_barrier(bar); } while (0)
#ifndef CONV_REP
#define CONV_REP 0
#endif
#ifndef REP_MASK
#define REP_MASK 0
#endif
#define PH_BEGIN(k) if (IN(k)) { _Pragma("unroll 1") for (int rep_ = 0; rep_ < 1 + ((REP_MASK >> (k)) & 1); ++rep_) { if (rep_) xcd_barrier(bar);
#ifndef TPROBE
#define TPROBE -1
#endif
    unsigned long long tp0 = 0, tp1 = 0;
#define PH_END(k) } } SEAM(k); if (TPROBE == (k) + 1) tp0 = __builtin_amdgcn_s_memrealtime(); if (TPROBE == (k)) tp1 = __builtin_amdgcn_s_memrealtime();
    PH_BEGIN(0) { p0_prologue(F); } PH_END(0)
    PH_BEGIN(1) { pg8::Gemm g{(const bf16*)(F.ws + WS_A), (const bf16*)(F.ws + WS_WIN), T, NIN, D}; pg8::StaticOrder S; S.init(T, NIN, F.G, F.bid);
        pg8::EpiBf16Norm E{(bf16*)(F.ws + WS_PROJ), NIN, F.ctl + CW_NORM}; pg8::gemm_phase<pg8::EpiBf16Norm, pg8::StaticOrder, true, true>((LAS unsigned char*)lds, g, S, E); } PH_END(1)
    PH_BEGIN(2) {
#ifndef SWEEP_REP
#define SWEEP_REP 1
#endif
#pragma unroll 1
        for (int srep = 0; srep < SWEEP_REP; ++srep)
        for (int uu = vcu; uu < 256; uu += F.G) ret::sweep_unit((const bf16*)(F.ws + WS_PROJ), F.out, F.out + (size_t)8 * 1024 * 1024, uu >> 2, uu & 3, (char*)F.lds);
        p2_attention(F); } PH_END(2)
    PH_BEGIN(3) { ret::carry_phase(F.out + (size_t)8 * 1024 * 1024, F.out + (size_t)10 * 1024 * 1024, F.bid, F.G, (char*)F.lds); } PH_END(3)
    PH_BEGIN(4) {
        for (int uu = vcu; uu < 256; uu += F.G) ret::out_unit((const bf16*)(F.ws + WS_PROJ), F.out, F.out + (size_t)10 * 1024 * 1024, (bf16*)(F.ws + WS_A), uu >> 2, uu & 3, (char*)F.lds);
        __syncthreads(); p4_attn_combine(F, IN(2)); } PH_END(4)
    PH_BEGIN(5) { pg8::Gemm g{(const bf16*)(F.ws + WS_A), (const bf16*)(F.ws + WS_WOUT), T, D, D}; pg8::StaticOrder S; S.init(T, D, F.G, F.bid);
        pg8::EpiResF32 E{F.x, F.out, D}; pg8::gemm_phase<pg8::EpiResF32, pg8::StaticOrder, true, true>((LAS unsigned char*)lds, g, S, E); } PH_END(5)
    PH_BEGIN(6) { p7_route(F); convert_experts(F); if (CONV_REP) convert_experts(F); } PH_END(6)
    PH_BEGIN(7) { const int nt = build_tiles(F); const LAS int* te = (const LAS int*)((LAS unsigned char*)lds + TILEE_OFF);
        pg8::Gemm g{(const bf16*)(F.ws + WS_A), (const bf16*)(F.ws + WS_WGU), T, 1024, D}; pg8::GroupedOrder<true> S{te, te + 192, te + 384, (const int*)(F.ws + WS_STOK), nt, 4, F.G, vcu};
        pg8::EpiSwiglu E{(bf16*)(F.ws + WS_PROJ), HIDN}; pg8::gemm_phase<pg8::EpiSwiglu, pg8::GroupedOrder<true>, true, true>((LAS unsigned char*)lds, g, S, E); } PH_END(7)
    PH_BEGIN(8) { const int nt = build_tiles(F); const LAS int* te = (const LAS int*)((LAS unsigned char*)lds + TILEE_OFF);
        pg8::Gemm g{(const bf16*)(F.ws + WS_PROJ), (const bf16*)(F.ws + WS_WD), NPAD, 1024, HIDN}; pg8::GroupedOrder<false> S{te, te + 192, te + 384, (const int*)(F.ws + WS_STOK), nt, 4, F.G, vcu};
        pg8::EpiScatter E{te, te + 192, te + 384, (const int*)(F.ws + WS_STOK), (const float*)(F.ws + WS_SW), (bf16*)(F.ws + WS_WGU), D};
        pg8::gemm_phase<pg8::EpiScatter, pg8::GroupedOrder<false>, true, true>((LAS unsigned char*)lds, g, S, E); } PH_END(8)
    PH_BEGIN(9) { p11_final(F); } } }
    if (TPROBE == 9) tp1 = __builtin_amdgcn_s_memrealtime();
    if (TPROBE >= 0 && F.bid == 0) { const unsigned long long tend = __builtin_amdgcn_s_memrealtime() + 4ull * (tp1 - tp0);
        while (__builtin_amdgcn_s_memrealtime() < tend) __builtin_amdgcn_s_sleep(8); }
#undef IN
#undef SEAM
}

extern "C" void kernel_launch(void* const* d_in, const int* in_sizes, int n_in, void* d_out, int out_size, void* d_ws, size_t ws_size, hipStream_t stream) {
    static int grid = 0;
    if (grid == 0) {
        if (n_in != 18 || in_sizes[0] != T * D || out_size != T * D || ws_size < WS_END) { fprintf(stderr, "kernel_launch: shape mismatch n_in %d in0 %d out %d ws %zu\n", n_in, n_in > 0 ? in_sizes[0] : -1, out_size, ws_size); grid = -1; return; }
        int dev = 0, cus = 0, per_cu = 0;
        if (hipGetDevice(&dev) != hipSuccess || hipDeviceGetAttribute(&cus, hipDeviceAttributeMultiprocessorCount, dev) != hipSuccess) { grid = -1; return; }
        if (hipFuncSetAttribute((const void*)fwd_kernel, hipFuncAttributeMaxDynamicSharedMemorySize, LDS_BYTES) != hipSuccess) { fprintf(stderr, "kernel_launch: hipFuncSetAttribute failed\n"); grid = -1; return; }
        if (hipOccupancyMaxActiveBlocksPerMultiprocessor(&per_cu, (const void*)fwd_kernel, NWAVES * 64, LDS_BYTES) != hipSuccess || per_cu < 1) fprintf(stderr, "kernel_launch: occupancy query says %d\n", per_cu);
        (void)hipGetLastError();
        grid = cus;
    }
    if (grid < 0) return;
    (void)hipMemsetAsync((char*)d_ws + WS_CTL, 0, CTL_ZERO_BYTES, stream);
    Args a{};
    for (int i = 0; i < 18; ++i) a.in[i] = (const float*)d_in[i];
    a.out = (float*)d_out; a.ws = (unsigned char*)d_ws;
#if MK_ONE_LAUNCH
    a.ph_lo = 0; a.ph_hi = NPHASE;
    hipLaunchKernelGGL(fwd_kernel, dim3(grid), dim3(NWAVES * 64), LDS_BYTES, stream, a);
#else
    for (int p = 0; p < NPHASE; ++p) { a.ph_lo = p; a.ph_hi = p + 1; hipLaunchKernelGGL(fwd_kernel, dim3(grid), dim3(NWAVES * 64), LDS_BYTES, stream, a); }
#endif
}
```

```cpp
#include <hip/hip_runtime.h>
#include <cstdio>
#include <cstdint>

#ifndef USE_MFMA
#define USE_MFMA 0x1F
#endif
#ifndef MK_ONE_LAUNCH
#define MK_ONE_LAUNCH 1
#endif

constexpr int T = 16384, D = 1024, NIN = 3072;
constexpr int C_QDA = 0, C_KDA = 512, C_VDA = 1024, C_QR = 1536, C_KR = 1792, C_VR = 2048, C_GR = 2560;
constexpr int NE = 32, HIDN = 512, NSLOT = 2 * T, MAXTILES = NSLOT / 256 + NE, NPAD = MAXTILES * 256;
constexpr int NRT = 36;
constexpr float EPS = 1e-6f;
constexpr float LOG2E = 1.4426950408889634f;
constexpr float C2 = 0.125f * LOG2E;
constexpr float LAMBDA_INIT = 0.2f;
constexpr int NPHASE = 10;

constexpr size_t MiB = 1u << 20;
constexpr size_t WS_CTL = 0, CTL_ZERO_BYTES = 1 * MiB;
constexpr size_t WS_WRT = 1 * MiB;
constexpr size_t WS_WIN = 2 * MiB;
constexpr size_t WS_WOUT = 8 * MiB;
constexpr size_t WS_WGU = 10 * MiB;
constexpr size_t WS_WD = 74 * MiB;
constexpr size_t WS_A = 106 * MiB;
constexpr size_t WS_PROJ = 146 * MiB;
constexpr size_t WS_TOK = 242 * MiB;
constexpr size_t WS_STOK = WS_WIN;
constexpr size_t WS_SW = WS_WIN + 2 * MiB;
constexpr size_t WS_OL = 242 * MiB;
constexpr size_t WS_E = 258 * MiB;
constexpr size_t WS_C = 266 * MiB;
constexpr size_t WS_END = 270 * MiB;
constexpr int PSLOTS = 960;
constexpr size_t DO_PARTS = (size_t)PSLOTS * 65536;
constexpr int CW_BAR = 4096;
constexpr int CW_CNT = 1024;
constexpr int CW_NORM = 3072;
constexpr int CW_QHEAD = 3136;
constexpr size_t TK_E = 0, TK_POS = 128 * 1024, TK_W = 256 * 1024, TK_STOK = 384 * 1024, TK_SW = 384 * 1024 + 160 * 1024;

constexpr int RING_BYTES = 131072;
constexpr int ITEM_OFF = 116736;
constexpr int LDSCTL_OFF = 147456, MISC_OFF = LDSCTL_OFF + 320, TILEE_OFF = LDSCTL_OFF + 1024;
constexpr int LDS_BYTES = 163840;
constexpr int NWAVES = 8;

#define GAS __attribute__((address_space(1)))
#define LAS __attribute__((address_space(3)))
typedef unsigned short bf16;
typedef unsigned v4u __attribute__((ext_vector_type(4)));
typedef unsigned v2u __attribute__((ext_vector_type(2)));
typedef float f32x4 __attribute__((ext_vector_type(4)));
#define RLX_AGENT __ATOMIC_RELAXED, __HIP_MEMORY_SCOPE_AGENT
#define LDS_WAIT() asm volatile("s_waitcnt lgkmcnt(0)" ::: "memory")

__device__ __forceinline__ unsigned f2bf(float f) { unsigned u = __builtin_bit_cast(unsigned, f); return (u + 0x7fffu + ((u >> 16) & 1u)) >> 16; }
__device__ __forceinline__ unsigned pk2(float lo, float hi) { return f2bf(lo) | (f2bf(hi) << 16); }
__device__ __forceinline__ float bflo(unsigned w) { return __builtin_bit_cast(float, w << 16); }
__device__ __forceinline__ float bfhi(unsigned w) { return __builtin_bit_cast(float, w & 0xffff0000u); }
__device__ __forceinline__ float bf2f(bf16 b) { return __builtin_bit_cast(float, (unsigned)b << 16); }
__device__ __forceinline__ float wave_sum(float v) {
#pragma unroll
    for (int o = 1; o < 64; o <<= 1) v += __shfl_xor(v, o);
    return v;
}
__device__ __forceinline__ float silu_f(float v) { return v / (1.f + __expf(-v)); }

#define XB_TMO      128
#define XB_XCNT(j)  (256  + 64 * (j))
#define XB_XSUB(j)  (1280 + 64 * (j))
#define XB_XGEN(j)  (2304 + 64 * (j))
#define XB_TOP      3328
#define XB_TOPGEN   3392
#define XCD_BAR_WORDS 3456
#define XB_SPIN_CAP (1u << 18)
__device__ __forceinline__ unsigned xb_ld(unsigned* p)              { return __hip_atomic_load(p, __ATOMIC_RELAXED, __HIP_MEMORY_SCOPE_AGENT); }
__device__ __forceinline__ unsigned xb_add(unsigned* p, unsigned v) { return __hip_atomic_fetch_add(p, v, __ATOMIC_RELAXED, __HIP_MEMORY_SCOPE_AGENT); }
__device__ __forceinline__ unsigned xb_xcc_id() { return (unsigned)__builtin_amdgcn_s_getreg((3 << 11) | 20) & 0xFu; }
#define XB_SPIN(cond, bar) do { unsigned _sp = 0; while (cond) { __builtin_amdgcn_s_sleep(1); \
    if ((++_sp & 255u) == 0u) { if (xb_ld(&(bar)[XB_TMO])) break; if (_sp > XB_SPIN_CAP) { atomicAdd(&(bar)[XB_TMO], 1u); break; } } } } while (0)
struct XcdBarrier { unsigned* bar; unsigned x; volatile LAS unsigned* st; };
__device__ __forceinline__ XcdBarrier xcd_barrier_post(unsigned* bar, volatile LAS unsigned* st) {
    XcdBarrier b; b.bar = bar; b.x = xb_xcc_id(); b.st = st;
    if (threadIdx.x == 0) (void)xb_add(&bar[XB_XCNT(b.x)], 1u);
    return b;
}
__device__ __forceinline__ void xcd_barrier_complete(unsigned* bar, unsigned x, unsigned& nloc, unsigned& nx) {
    const unsigned G = gridDim.x * gridDim.y * gridDim.z;
    unsigned sum, cnt, mine, sp = 0u;
    for (;;) {
        sum = 0u; cnt = 0u; mine = 0u;
#pragma unroll
        for (unsigned j = 0; j < 16; ++j) { const unsigned c = xb_ld(&bar[XB_XCNT(j)]); sum += c; cnt += (c > 0u) ? 1u : 0u; mine = (j == x) ? c : mine; }
        if (sum == G) break;
        __builtin_amdgcn_s_sleep(1);
        if ((++sp & 255u) == 0u) { if (xb_ld(&bar[XB_TMO])) break; if (sp > XB_SPIN_CAP) { atomicAdd(&bar[XB_TMO], 1u); break; } }
    }
    nloc = mine > 0u ? mine : 1u; nx = cnt > 0u ? cnt : 1u;
}
__device__ __forceinline__ void xcd_barrier(const XcdBarrier& b) {
    asm volatile("s_waitcnt vmcnt(0)" ::: "memory");
    __syncthreads();
    if (threadIdx.x == 0) {
        unsigned* bar = b.bar;
        __builtin_amdgcn_s_waitcnt(0);
        unsigned nloc = b.st[0], nx = b.st[1];
        if (nloc == 0u) { xcd_barrier_complete(bar, b.x, nloc, nx); b.st[0] = nloc; b.st[1] = nx; }
        const unsigned old = xb_add(&bar[XB_XSUB(b.x)], 1u);
        const unsigned gen = old / nloc;
        if (old + 1u == (gen + 1u) * nloc) {
            __builtin_amdgcn_fence(__ATOMIC_RELEASE, "agent");
            asm volatile("s_waitcnt vmcnt(0)" ::: "memory");
            const unsigned og = xb_add(&bar[XB_TOP], 1u);
            const unsigned tg = og / nx;
            if (og + 1u == (tg + 1u) * nx) xb_add(&bar[XB_TOPGEN], 1u);
            else XB_SPIN(xb_ld(&bar[XB_TOPGEN]) == tg, bar);
            __builtin_amdgcn_fence(__ATOMIC_ACQUIRE, "agent");
            xb_add(&bar[XB_XGEN(b.x)], 1u);
            asm volatile("s_waitcnt vmcnt(0)" ::: "memory");
        } else {
            XB_SPIN(xb_ld(&bar[XB_XGEN(b.x)]) == gen, bar);
            __builtin_amdgcn_fence(__ATOMIC_ACQUIRE, "agent");
            asm volatile("s_waitcnt vmcnt(0)" ::: "memory");
        }
    }
    __syncthreads();
}

namespace pg8 {
#define PG8_LAS __attribute__((address_space(3)))
typedef unsigned short bf16_t;
typedef short bf16x8 __attribute__((ext_vector_type(8)));
typedef float f32x4 __attribute__((ext_vector_type(4)));
typedef unsigned u32x4 __attribute__((ext_vector_type(4)));
constexpr int BM = 256, BK = 64, HALF = 128, HTB = HALF * BK * 2  , STAGE_BYTES = 8 * HTB, NXCD = 8, WGM = 8;

__host__ __device__ __forceinline__ int lds_byte(int r, int c) { const int st = (r >> 4) * 2 + (c >> 5), rr = r & 15, cc = c & 31, ob = rr * 64 + cc * 2; return st * 1024 + (ob ^ (((ob >> 9) & 1) << 5)); }
__host__ __device__ __forceinline__ void stage_rc(int b, int& R, int& C) { const int st = b / 1024, sb = b % 1024, swz = sb ^ (((sb >> 9) & 1) << 5); R = (st >> 1) * 16 + swz / 64; C = (st & 1) * 32 + (swz % 64) / 2; }
__host__ __device__ __forceinline__ int perm32(int rho) { const int n = rho >> 4, i = rho & 15; return 8 * (i >> 2) + 4 * n + (i & 3); }

struct Unit { int pm, pn, pb; };
struct Gemm { const bf16_t* A; const bf16_t* Bt; int M, N, K; };
__device__ __forceinline__ unsigned cvt_pk_bf16(float lo, float hi) { unsigned r; asm volatile("v_cvt_pk_bf16_f32 %0, %1, %2" : "=v"(r) : "v"(lo), "v"(hi)); return r; }
template <class Epi, class Sched, bool ALIGN_EPI = false, bool SP2 = false>
__device__ __forceinline__ void gemm_phase(PG8_LAS unsigned char* lds, const Gemm g, const Sched& S, const Epi& E) {
    const int tid = threadIdx.x, wid = __builtin_amdgcn_readfirstlane(tid >> 6), lane = tid & 63, wr = wid >> 2, wc = wid & 3, fr = lane & 15, fq = lane >> 4;
    const int K = g.K, nt = K / BK;
    unsigned voffB[2]; int RA[2]; unsigned colA[2];
#pragma unroll
    for (int i = 0; i < 2; ++i) { int R, C; stage_rc(tid * 16 + i * 8192, R, C); const int Rb = Epi::PERM ? ((R & ~31) + perm32(R & 31)) : R;
        RA[i] = R; colA[i] = (unsigned)C * 2u; voffB[i] = (unsigned)(Rb * K + C) * 2u; }
    unsigned cv0[2], cv1[2], nv0[2], nv1[2];
#define PG8_VA(d0, d1, un) do { _Pragma("unroll") for (int i_ = 0; i_ < 2; ++i_) { d0[i_] = (unsigned)S.arow(un, 0, RA[i_]) * (unsigned)(K * 2) + colA[i_]; d1[i_] = (unsigned)S.arow(un, 1, RA[i_]) * (unsigned)(K * 2) + colA[i_]; } } while (0)
    const size_t kstep = (size_t)(BK * 2);
    const size_t hstep = (size_t)HALF * K * 2;
    const size_t tstep = 2 * hstep;
    const unsigned ldsw = (unsigned)wid * 1024u;
    const int aoff = lds_byte(wr * 64 + fr, fq * 8), boff = lds_byte(wc * 32 + fr, fq * 8);
#define PG8_SA(b, h) (((b) * 2 + (h)) * HTB)
#define PG8_SB(b, h) ((4 + (b) * 2 + (h)) * HTB)
#define PG8_STAGE(bufoff, gbase, voff) do { _Pragma("unroll") for (int _i = 0; _i < 2; ++_i) \
        __builtin_amdgcn_global_load_lds((const unsigned*)((const char*)(gbase) + (voff)[_i]), (PG8_LAS unsigned*)(lds + (bufoff) + ldsw + _i * 8192), 16, 0, 0); } while (0)
#define PG8_LDA(dst, b, h) do { _Pragma("unroll") for (int m = 0; m < 4; ++m) _Pragma("unroll") for (int k = 0; k < 2; ++k) dst[m][k] = *(const PG8_LAS bf16x8*)(lds + PG8_SA(b, h) + aoff + m * 2048 + k * 1024); } while (0)
#define PG8_LDB(dst, b, h) do { _Pragma("unroll") for (int n = 0; n < 2; ++n) _Pragma("unroll") for (int k = 0; k < 2; ++k) dst[n][k] = *(const PG8_LAS bf16x8*)(lds + PG8_SB(b, h) + boff + n * 2048 + k * 1024); } while (0)
#define PG8_MMA(ai, bj, At, Bt) do { __builtin_amdgcn_s_setprio(1); _Pragma("unroll") for (int m = 0; m < 4; ++m) _Pragma("unroll") for (int n = 0; n < 2; ++n) _Pragma("unroll") for (int k = 0; k < 2; ++k) \
        acc[ai][bj][m][n] = __builtin_amdgcn_mfma_f32_16x16x32_bf16(Bt[n][k], At[m][k], acc[ai][bj][m][n], 0, 0, 0); __builtin_amdgcn_s_setprio(0); } while (0)
#define PG8_WAIT_V(n) asm volatile("s_waitcnt vmcnt(" #n ")" ::: "memory")
#define PG8_WAIT_L(n) asm volatile("s_waitcnt lgkmcnt(" #n ")" ::: "memory")
#define PG8_BAR __builtin_amdgcn_s_barrier()
#define PG8_SCHED __builtin_amdgcn_sched_barrier(0)
    Unit cur, nxt; int ui = 0;
    if (!S.next(0, cur)) return;
    f32x4 acc[2][2][4][2];
#pragma unroll
    for (int a = 0; a < 2; ++a)
#pragma unroll
        for (int b = 0; b < 2; ++b)
#pragma unroll
            for (int m = 0; m < 4; ++m)
#pragma unroll
                for (int n = 0; n < 2; ++n) acc[a][b][m][n] = (f32x4){0.f, 0.f, 0.f, 0.f};
    bf16x8 At[4][2], B0[2][2], B1[2][2];
    const char* const gA = (const char*)g.A; const char* cB = (const char*)g.Bt + (size_t)cur.pb * tstep;
    PG8_VA(cv0, cv1, cur);
    S.a_ready(cur);
    if constexpr (SP2) {
        PG8_STAGE(PG8_SB(0, 0), cB, voffB); PG8_STAGE(PG8_SB(0, 1), cB + hstep, voffB); PG8_STAGE(PG8_SA(0, 0), gA, cv0); PG8_STAGE(PG8_SA(0, 1), gA, cv1);
        if (wr == 1) PG8_BAR;
        PG8_WAIT_V(2); PG8_BAR;
        PG8_STAGE(PG8_SB(1, 0), cB + kstep, voffB); PG8_STAGE(PG8_SA(1, 0), gA + kstep, cv0); PG8_STAGE(PG8_SB(1, 1), cB + hstep + kstep, voffB);
        PG8_WAIT_V(6); PG8_BAR;
    } else {
        PG8_STAGE(PG8_SB(0, 0), cB, voffB); PG8_STAGE(PG8_SA(0, 0), gA, cv0); PG8_STAGE(PG8_SB(0, 1), cB + hstep, voffB); PG8_STAGE(PG8_SA(0, 1), gA, cv1);
        if (wr == 1) PG8_BAR;
        PG8_WAIT_V(4); PG8_BAR;
        PG8_STAGE(PG8_SB(1, 0), cB + kstep, voffB); PG8_STAGE(PG8_SA(1, 0), gA + kstep, cv0); PG8_STAGE(PG8_SB(1, 1), cB + hstep + kstep, voffB);
        PG8_WAIT_V(6); PG8_BAR;
    }
    for (;;) {
        const bool has_next = S.next(ui + 1, nxt);
        const char* nB = has_next ? (const char*)g.Bt + (size_t)nxt.pb * tstep : cB;
        if (has_next) PG8_VA(nv0, nv1, nxt); else { nv0[0] = cv0[0]; nv0[1] = cv0[1]; nv1[0] = cv1[0]; nv1[1] = cv1[1]; }
        for (int t = 0; t < nt; t += 2) {
            const bool last = (t == nt - 2);
            const char* a1 = gA + (size_t)(t + 1) * kstep;
            const char* a2 = last ? gA : gA + (size_t)(t + 2) * kstep; const char* b2 = last ? nB : cB + (size_t)(t + 2) * kstep;
            const char* a3 = a2 + kstep; const char* b3 = b2 + kstep;
            unsigned w0[2], w1[2];
            w0[0] = last ? nv0[0] : cv0[0]; w0[1] = last ? nv0[1] : cv0[1]; w1[0] = last ? nv1[0] : cv1[0]; w1[1] = last ? nv1[1] : cv1[1];
            if (last && has_next) S.a_ready(nxt);
            if constexpr (SP2) {
            PG8_LDB(B0, 0, 0); PG8_LDB(B1, 0, 1); PG8_SCHED; PG8_LDA(At, 0, 0); PG8_STAGE(PG8_SA(1, 1), a1, cv1);
            PG8_WAIT_V(8); PG8_WAIT_L(0); PG8_BAR; PG8_MMA(0, 0, At, B0); PG8_MMA(0, 1, At, B1); PG8_BAR; PG8_SCHED;
            PG8_LDA(At, 0, 1); PG8_STAGE(PG8_SB(0, 0), b2, voffB); PG8_STAGE(PG8_SB(0, 1), b2 + hstep, voffB); PG8_STAGE(PG8_SA(0, 0), a2, w0);
            PG8_WAIT_V(8); PG8_WAIT_L(0); PG8_BAR; PG8_MMA(1, 0, At, B0); PG8_MMA(1, 1, At, B1); PG8_BAR; PG8_SCHED;
            PG8_LDB(B0, 1, 0); PG8_LDB(B1, 1, 1); PG8_SCHED; PG8_LDA(At, 1, 0); PG8_STAGE(PG8_SA(0, 1), a2, w1);
            PG8_WAIT_V(8); PG8_WAIT_L(0); PG8_BAR; PG8_MMA(0, 0, At, B0); PG8_MMA(0, 1, At, B1); PG8_BAR; PG8_SCHED;
            PG8_LDA(At, 1, 1); PG8_STAGE(PG8_SB(1, 0), b3, voffB); PG8_STAGE(PG8_SB(1, 1), b3 + hstep, voffB); PG8_STAGE(PG8_SA(1, 0), a3, w0);
            PG8_WAIT_V(8); PG8_WAIT_L(0); PG8_BAR; PG8_MMA(1, 0, At, B0); PG8_MMA(1, 1, At, B1); PG8_BAR; PG8_SCHED;
            } else {
            PG8_LDB(B0, 0, 0); PG8_SCHED; PG8_LDA(At, 0, 0); PG8_STAGE(PG8_SA(1, 1), a1, cv1);
            PG8_WAIT_L(8); PG8_BAR; PG8_WAIT_L(0); PG8_MMA(0, 0, At, B0); PG8_BAR; PG8_SCHED;
            PG8_LDB(B1, 0, 1); PG8_STAGE(PG8_SB(0, 0), b2, voffB);
            PG8_BAR; PG8_WAIT_L(0); PG8_MMA(0, 1, At, B1); PG8_BAR;
            PG8_LDA(At, 0, 1); PG8_STAGE(PG8_SA(0, 0), a2, w0);
            PG8_BAR; PG8_WAIT_L(0); PG8_MMA(1, 0, At, B0); PG8_BAR; PG8_SCHED;
            PG8_STAGE(PG8_SB(0, 1), b2 + hstep, voffB);
            PG8_WAIT_V(6); PG8_BAR; PG8_MMA(1, 1, At, B1); PG8_BAR;
            PG8_LDB(B0, 1, 0); PG8_SCHED; PG8_LDA(At, 1, 0); PG8_STAGE(PG8_SA(0, 1), a2, w1);
            PG8_WAIT_L(8); PG8_BAR; PG8_WAIT_L(0); PG8_MMA(0, 0, At, B0); PG8_BAR; PG8_SCHED;
            PG8_LDB(B1, 1, 1); PG8_STAGE(PG8_SB(1, 0), b3, voffB);
            PG8_BAR; PG8_WAIT_L(0); PG8_MMA(0, 1, At, B1); PG8_BAR;
            PG8_LDA(At, 1, 1); PG8_STAGE(PG8_SA(1, 0), a3, w0);
            PG8_BAR; PG8_WAIT_L(0); PG8_MMA(1, 0, At, B0); PG8_BAR; PG8_SCHED;
            PG8_STAGE(PG8_SB(1, 1), b3 + hstep, voffB);
            PG8_WAIT_V(6); PG8_BAR; PG8_MMA(1, 1, At, B1); PG8_BAR;
            }
        }
        if constexpr (ALIGN_EPI) { if (wr == 0) PG8_BAR; }
        if constexpr (!Epi::AFTER_DRAIN) { E(acc, cur, wr, wc, fr, fq); S.done(cur); }
        if (!has_next) break;
#pragma unroll
        for (int a = 0; a < 2; ++a)
#pragma unroll
            for (int b = 0; b < 2; ++b)
#pragma unroll
                for (int m = 0; m < 4; ++m)
#pragma unroll
                    for (int n = 0; n < 2; ++n) acc[a][b][m][n] = (f32x4){0.f, 0.f, 0.f, 0.f};
        cur = nxt; cB = nB; ++ui; cv0[0] = nv0[0]; cv0[1] = nv0[1]; cv1[0] = nv1[0]; cv1[1] = nv1[1];
        if constexpr (ALIGN_EPI) { if (wr == 1) PG8_BAR; }
    }
    PG8_WAIT_V(0);
    if constexpr (!ALIGN_EPI) { if (wr == 0) PG8_BAR; }
    PG8_BAR;
    if constexpr (Epi::AFTER_DRAIN) { E.fused(acc, cur, wr, wc, fr, fq, lds, wid, lane); S.done(cur); }
#undef PG8_SA
#undef PG8_VA
#undef PG8_SB
#undef PG8_STAGE
#undef PG8_LDA
#undef PG8_LDB
#undef PG8_MMA
#undef PG8_WAIT_V
#undef PG8_WAIT_L
#undef PG8_BAR
#undef PG8_SCHED
}

struct EpiBf16Plain {
    static constexpr bool PERM = true, AFTER_DRAIN = false;
    bf16_t* O; int ldc;
    __device__ __forceinline__ void operator()(const f32x4 (&acc)[2][2][4][2], const Unit& u, int wr, int wc, int fr, int fq) const {
        const int row0 = u.pm * BM + wr * 64 + fr, col0 = u.pn * BM + wc * 32 + 8 * fq;
#pragma unroll
        for (int ai = 0; ai < 2; ++ai)
#pragma unroll
            for (int m = 0; m < 4; ++m) { bf16_t* rowp = O + (size_t)(row0 + ai * HALF + m * 16) * ldc + col0;
#pragma unroll
                for (int bj = 0; bj < 2; ++bj) { const f32x4 v0 = acc[ai][bj][m][0], v1 = acc[ai][bj][m][1];
                    u32x4 w; w.x = cvt_pk_bf16(v0[0], v0[1]); w.y = cvt_pk_bf16(v0[2], v0[3]); w.z = cvt_pk_bf16(v1[0], v1[1]); w.w = cvt_pk_bf16(v1[2], v1[3]);
                    *(u32x4*)(rowp + bj * HALF) = w; } }
    }
};
struct EpiBf16Norm {
    static constexpr bool PERM = true, AFTER_DRAIN = false;
    bf16_t* O; int ldc; unsigned* norm;
    __device__ __forceinline__ void operator()(const f32x4 (&acc)[2][2][4][2], const Unit& u, int wr, int wc, int fr, int fq) const {
        const int row0 = u.pm * BM + wr * 64 + fr, col0 = u.pn * BM + wc * 32 + 8 * fq;
#pragma unroll
        for (int ai = 0; ai < 2; ++ai)
#pragma unroll
            for (int m = 0; m < 4; ++m) { bf16_t* rowp = O + (size_t)(row0 + ai * HALF + m * 16) * ldc + col0;
#pragma unroll
                for (int bj = 0; bj < 2; ++bj) { const f32x4 v0 = acc[ai][bj][m][0], v1 = acc[ai][bj][m][1];
                    u32x4 w; w.x = cvt_pk_bf16(v0[0], v0[1]); w.y = cvt_pk_bf16(v0[2], v0[3]); w.z = cvt_pk_bf16(v1[0], v1[1]); w.w = cvt_pk_bf16(v1[2], v1[3]);
                    *(u32x4*)(rowp + bj * HALF) = w; } }
        if (u.pn < 4) {
#pragma unroll
            for (int bj = 0; bj < 2; ++bj) { float mx = 0.f;
#pragma unroll
                for (int ai = 0; ai < 2; ++ai)
#pragma unroll
                    for (int m = 0; m < 4; ++m) { const f32x4 a = acc[ai][bj][m][0], b = acc[ai][bj][m][1];
                        float ssq = (a[0] * a[0] + a[1] * a[1]) + (a[2] * a[2] + a[3] * a[3]) + (b[0] * b[0] + b[1] * b[1]) + (b[2] * b[2] + b[3] * b[3]);
                        ssq += __shfl_xor(ssq, 16); ssq += __shfl_xor(ssq, 32); mx = fmaxf(mx, ssq); }
#pragma unroll
                for (int o = 1; o < 16; o <<= 1) mx = fmaxf(mx, __shfl_xor(mx, o));
                if ((threadIdx.x & 63) == 0) __hip_atomic_fetch_max(norm + (4 * u.pn + 2 * bj + (wc >> 1)) * 2 + (wc & 1), __float_as_uint(mx), __ATOMIC_RELAXED, __HIP_MEMORY_SCOPE_AGENT); }
        }
    }
};
struct EpiResF32 {
    static constexpr bool PERM = false, AFTER_DRAIN = false;
    const float* base; float* C; int ldc;
    __device__ __forceinline__ void operator()(const f32x4 (&acc)[2][2][4][2], const Unit& u, int wr, int wc, int fr, int fq) const {
        const int row0 = u.pm * BM + wr * 64 + fr, col0 = u.pn * BM + wc * 32 + 4 * fq;
#pragma unroll
        for (int ai = 0; ai < 2; ++ai)
#pragma unroll
            for (int m = 0; m < 4; ++m) { const size_t off = (size_t)(row0 + ai * HALF + m * 16) * ldc + col0;
                f32x4 b[2][2];
#pragma unroll
                for (int bj = 0; bj < 2; ++bj)
#pragma unroll
                    for (int n = 0; n < 2; ++n) b[bj][n] = *(const f32x4*)(base + off + bj * HALF + n * 16);
#pragma unroll
                for (int bj = 0; bj < 2; ++bj)
#pragma unroll
                    for (int n = 0; n < 2; ++n) *(f32x4*)(C + off + bj * HALF + n * 16) = b[bj][n] + acc[ai][bj][m][n];
                if (m & 1) asm volatile("" ::: "memory"); }
    }
};
__device__ __forceinline__ float silu_mul(float g, float u) { return g * u * __builtin_amdgcn_rcpf(1.f + __expf(-g)); }
struct EpiSwiglu {
    static constexpr bool PERM = true, AFTER_DRAIN = false;
    bf16_t* H; int ldh;
    __device__ __forceinline__ void operator()(const f32x4 (&acc)[2][2][4][2], const Unit& u, int wr, int wc, int fr, int fq) const {
        const int row0 = u.pm * BM + wr * 64 + fr, col0 = u.pn * HALF + wc * 32 + 8 * fq;
#pragma unroll
        for (int ai = 0; ai < 2; ++ai)
#pragma unroll
            for (int m = 0; m < 4; ++m) { const f32x4 g0 = acc[ai][0][m][0], g1 = acc[ai][0][m][1], u0 = acc[ai][1][m][0], u1 = acc[ai][1][m][1];
                u32x4 w; w.x = cvt_pk_bf16(silu_mul(g0[0], u0[0]), silu_mul(g0[1], u0[1])); w.y = cvt_pk_bf16(silu_mul(g0[2], u0[2]), silu_mul(g0[3], u0[3]));
                w.z = cvt_pk_bf16(silu_mul(g1[0], u1[0]), silu_mul(g1[1], u1[1])); w.w = cvt_pk_bf16(silu_mul(g1[2], u1[2]), silu_mul(g1[3], u1[3]));
                *(u32x4*)(H + (size_t)(row0 + ai * HALF + m * 16) * ldh + col0) = w; }
    }
};
struct EpiScatter {
    static constexpr bool PERM = true, AFTER_DRAIN = false;
    const PG8_LAS int* tile_e; const PG8_LAS int* tile_i; const PG8_LAS int* cnts; const int* stok; const float* sw; bf16_t* Y; int ldy;
    __device__ __forceinline__ void operator()(const f32x4 (&acc)[2][2][4][2], const Unit& u, int wr, int wc, int fr, int fq) const {
        const int e = tile_e[u.pm], pos0 = tile_i[u.pm] * BM + wr * 64 + fr, cnt = cnts[e], col0 = u.pn * BM + wc * 32 + 8 * fq;
#pragma unroll
        for (int ai = 0; ai < 2; ++ai)
#pragma unroll
            for (int m = 0; m < 4; ++m) { const int pos = pos0 + ai * HALF + m * 16;
                if (pos < cnt) { const int tk = stok[e * 16384 + pos]; const float s = sw[e * 16384 + pos]; bf16_t* rowp = Y + (size_t)tk * ldy + col0;
#pragma unroll
                    for (int bj = 0; bj < 2; ++bj) { const f32x4 v0 = acc[ai][bj][m][0] * s, v1 = acc[ai][bj][m][1] * s;
                        u32x4 w; w.x = cvt_pk_bf16(v0[0], v0[1]); w.y = cvt_pk_bf16(v0[2], v0[3]); w.z = cvt_pk_bf16(v1[0], v1[1]); w.w = cvt_pk_bf16(v1[2], v1[3]);
                        *(u32x4*)(rowp + bj * HALF) = w; } } }
    }
};
struct StaticOrder {
    int nM, nN, nwg, G, c;
    __device__ void init(int M, int N, int G_, int c_) { nM = M / BM; nN = N / BM; nwg = nM * nN; G = G_; c = c_; }
    __device__ bool next(int i, Unit& u) const {
        const long L = (long)i * G + c; if (L >= nwg) return false;
        int wgid = (int)L; { const int q = nwg / NXCD, r = nwg % NXCD, xcd = wgid % NXCD, off = wgid / NXCD; wgid = (xcd < r ? xcd * (q + 1) : r * (q + 1) + (xcd - r) * q) + off; }
        const int nig = WGM * nN, gid = wgid / nig, fm = gid * WGM, gsz = (nM - fm) < WGM ? (nM - fm) : WGM;
        u.pm = fm + ((wgid % nig) % gsz); u.pn = (wgid % nig) / gsz; u.pb = u.pn; return true;
    }
    __device__ __forceinline__ int arow(const Unit& u, int h, int R) const { return u.pm * BM + h * HALF + R; }
    __device__ __forceinline__ void a_ready(const Unit&) const {}
    __device__ __forceinline__ void done(const Unit&) const {}
};
constexpr int SLOTCAP = 16384;
template <bool GATHER> struct GroupedOrder {
    const PG8_LAS int* tile_e; const PG8_LAS int* tile_i; const PG8_LAS int* cnts; const int* stok; int ntiles, nN, G, c;
    __device__ __forceinline__ bool next(int i, Unit& u) const { const int L = i * G + c; if (L >= ntiles * nN) return false; u.pm = L / nN; u.pn = L % nN; u.pb = tile_e[u.pm] * nN + u.pn; return true; }
    __device__ __forceinline__ int arow(const Unit& u, int h, int R) const {
        if (!GATHER) return u.pm * BM + h * HALF + R;
        const int e = tile_e[u.pm], pos = tile_i[u.pm] * BM + h * HALF + R; return pos < cnts[e] ? (stok[e * SLOTCAP + pos] >> 1) : 0; }
    __device__ __forceinline__ void a_ready(const Unit&) const {}
    __device__ __forceinline__ void done(const Unit&) const {}
};
}

struct Frame {
    unsigned char* lds;
    unsigned* ctl;
    int tid, lane, wave, G, bid;
    const float *x, *g1, *w_in, *lq1, *lk1, *lq2, *lk2, *subg, *w_out, *g2, *wrg, *brg, *wre, *bre, *wg, *wu, *wd, *gf;
    float* out;
    unsigned char* ws;
};
using pg8::Unit;

__device__ __forceinline__ void p0_transpose_item(const float* W, int K, int N, bf16* WT, int k0, int n0, int dstrow0, float scale, float* scr, int lane) {
#pragma unroll 8
    for (int i = 0; i < 32; ++i) { const int kk = 2 * i + (lane >> 5); scr[kk * 33 + (lane & 31)] = W[(size_t)(k0 + kk) * N + n0 + (lane & 31)] * scale; }
    LDS_WAIT(); asm volatile("" ::: "memory");
    const int c = lane & 7;
#pragma unroll
    for (int j = 0; j < 4; ++j) { const int n = (lane >> 3) + 8 * j; const float* s = scr + (8 * c) * 33 + n;
        v4u o; o.x = pk2(s[0 * 33], s[1 * 33]); o.y = pk2(s[2 * 33], s[3 * 33]); o.z = pk2(s[4 * 33], s[5 * 33]); o.w = pk2(s[6 * 33], s[7 * 33]);
        *(v4u*)(WT + (size_t)(dstrow0 + n) * K + k0 + 8 * c) = o; }
    LDS_WAIT(); asm volatile("" ::: "memory");
}
__device__ __forceinline__ void rms_row_to_bf16(const float* xrow, const float* g, bf16* orow, int lane) {
    const f32x4* xr = (const f32x4*)xrow + lane; const f32x4* gr = (const f32x4*)g + lane;
    f32x4 v[4]; float s = 0.f;
#pragma unroll
    for (int j = 0; j < 4; ++j) { v[j] = xr[64 * j]; s += (v[j].x * v[j].x + v[j].y * v[j].y) + (v[j].z * v[j].z + v[j].w * v[j].w); }
    const float rstd = 1.f / sqrtf(wave_sum(s) * (1.f / D) + EPS);
    unsigned long long* o8 = (unsigned long long*)orow + lane;
#pragma unroll
    for (int j = 0; j < 4; ++j) { const f32x4 gg = gr[64 * j];
        o8[64 * j] = (unsigned long long)pk2(v[j].x * rstd * gg.x, v[j].y * rstd * gg.y) | ((unsigned long long)pk2(v[j].z * rstd * gg.z, v[j].w * rstd * gg.w) << 32); }
}
__device__ __forceinline__ void p0_prologue(Frame& F) {
    float* scr = (float*)(F.lds + F.wave * 16384);
    const int gw = F.bid * NWAVES + F.wave, NGW = F.G * NWAVES;
    bf16* WinT = (bf16*)(F.ws + WS_WIN); bf16* WoutT = (bf16*)(F.ws + WS_WOUT);
    constexpr int I_IN = 16 * 96, I_OUT = 16 * 32, NITEMS = I_IN + I_OUT;
    for (int it = gw; it < NITEMS; it += NGW) {
        int r = it;
        if (r < I_IN) { const int kb = r / 96, nb = r % 96, n0 = 32 * nb; const float sc = (n0 < C_KDA) ? C2 : ((n0 >= C_KR && n0 < C_VR) ? 0.125f : 1.f);
            p0_transpose_item(F.w_in, D, NIN, WinT, 64 * kb, n0, n0, sc, scr, F.lane); continue; }
        r -= I_IN;
        { const int kb = r / 32, nb = r % 32; p0_transpose_item(F.w_out, D, D, WoutT, 64 * kb, 32 * nb, 32 * nb, 1.f, scr, F.lane); }
    }
    float* WrT = (float*)(F.ws + WS_WRT);
    for (int i = F.bid * 512 + F.tid; i < NRT * D; i += F.G * 512) { const int c = i / D, k = i % D; WrT[i] = (c < 4) ? F.wrg[k * 4 + c] : F.wre[k * 32 + (c - 4)]; }
    bf16* XN1 = (bf16*)(F.ws + WS_A);
    for (int m = gw; m < T; m += NGW) rms_row_to_bf16(F.x + (size_t)m * D, F.g1, XN1 + (size_t)m * D, F.lane);
}

constexpr int CONV_ITEMS = 256;
struct CvtDesc { const float* src; bf16* dst; int N, K; };
__device__ __forceinline__ CvtDesc cvt_desc(const Frame& F, int it) {
    constexpr int I_E = 768;
    bf16* WguT = (bf16*)(F.ws + WS_WGU); bf16* WdT = (bf16*)(F.ws + WS_WD);
    const int e = it / I_E; int r = it % I_E; CvtDesc d;
    if (r < 512) { const int up = r >> 8; r &= 255; const int kb = r / 16, nb = r % 16, n0 = 32 * nb;
        d.src = (up ? F.wu : F.wg) + (size_t)e * D * HIDN + (size_t)(64 * kb) * HIDN + n0; d.N = HIDN; d.K = D;
        d.dst = WguT + (size_t)e * 1024 * D + (size_t)(256 * (n0 >> 7) + 128 * up + (n0 & 127)) * D + 64 * kb; }
    else { r -= 512; const int kb = r / 32, nb = r % 32;
        d.src = F.wd + (size_t)e * HIDN * D + (size_t)(64 * kb) * D + 32 * nb; d.N = D; d.K = HIDN;
        d.dst = WdT + (size_t)e * D * HIDN + (size_t)(32 * nb) * HIDN + 64 * kb; }
    return d;
}
#define CVT_LOAD(v, d) do { const float* s_ = (d).src + (size_t)(ln >> 5) * (d).N + (ln & 31); _Pragma("unroll") for (int i_ = 0; i_ < 32; ++i_) v[i_] = s_[(size_t)(2 * i_) * (d).N]; } while (0)
#define CVT_STORE(v, d) do { _Pragma("unroll") for (int i_ = 0; i_ < 32; ++i_) scr[(2 * i_ + (ln >> 5)) * 33 + (ln & 31)] = v[i_]; \
    LDS_WAIT(); asm volatile("" ::: "memory"); const int c_ = ln & 7; \
    _Pragma("unroll") for (int j_ = 0; j_ < 4; ++j_) { const int n_ = (ln >> 3) + 8 * j_; const float* q_ = scr + (8 * c_) * 33 + n_; \
        v4u o_; o_.x = pk2(q_[0 * 33], q_[1 * 33]); o_.y = pk2(q_[2 * 33], q_[3 * 33]); o_.z = pk2(q_[4 * 33], q_[5 * 33]); o_.w = pk2(q_[6 * 33], q_[7 * 33]); \
        *(v4u*)((d).dst + (size_t)n_ * (d).K + 8 * c_) = o_; } \
    LDS_WAIT(); asm volatile("" ::: "memory"); } while (0)
__device__ __forceinline__ void convert_item(Frame& F, int c) {
    float* scr = (float*)(F.lds + F.wave * 12288);
    int ln = F.lane; asm volatile("" : "+v"(ln));
    __syncthreads();
    const int it0 = c * 96 + F.wave * 12;
    float va[32], vb[32];
    CvtDesc da_ = cvt_desc(F, it0), db_;
    CVT_LOAD(va, da_);
#pragma unroll 1
    for (int j = 0; j < 12; j += 2) {
        db_ = cvt_desc(F, it0 + j + 1); CVT_LOAD(vb, db_);
        CVT_STORE(va, da_);
        if (j + 2 < 12) { da_ = cvt_desc(F, it0 + j + 2); CVT_LOAD(va, da_); }
        CVT_STORE(vb, db_);
    }
}
#undef CVT_LOAD
#undef CVT_STORE

namespace da {
using bf16x8 = __attribute__((ext_vector_type(8))) short;
using s16x4  = __attribute__((ext_vector_type(4))) short;
using f32x16 = __attribute__((ext_vector_type(16))) float;
using u32x4  = __attribute__((ext_vector_type(4))) unsigned;
constexpr int KVBLK = 64;
constexpr int SHM_V = KVBLK * 128 * 2, SHM_K = KVBLK * 128 * 2;
constexpr float THR = 8.f;
#ifndef DA_SDEPTH
#define DA_SDEPTH 1
#endif
#define DA_KSWZ(row, colB) ((row) * 256 + ((colB) ^ (((row) & 7) << 4)))
#define DA_SBAR() __builtin_amdgcn_sched_barrier(0)
__device__ __forceinline__ int crow(int r, int hi) { return (r & 3) + 8 * (r >> 2) + 4 * hi; }
__device__ __forceinline__ unsigned cvtpk(float lo, float hi) { unsigned r; asm volatile("v_cvt_pk_bf16_f32 %0, %1, %2" : "=v"(r) : "v"(lo), "v"(hi)); return r; }
__device__ __forceinline__ void partialSM(f32x16& p0, f32x16& p1, float& m_reg, float& alpha, float dq, float nslope2, bool masked, bool gen, bool& fresh) {
  if (gen) { const int dqi = (int)dq;
#pragma unroll
    for (int r = 0; r < 16; ++r) { const int c = (r & 3) + 8 * (r >> 2); const float d = (float)(dqi - c), d1 = (float)(dqi - 32 - c);
      p0[r] = fmaf(nslope2, fabsf(d) - d, p0[r]); p1[r] = fmaf(nslope2, fabsf(d1) - d1, p1[r]); } }
  if (masked) {
#pragma unroll
    for (int r = 0; r < 16; ++r) { p0[r] = -INFINITY; p1[r] = -INFINITY; } }
  float pmax = p0[0];
#pragma unroll
  for (int r = 1; r < 16; ++r) pmax = fmaxf(pmax, p0[r]);
#pragma unroll
  for (int r = 0; r < 16; ++r) pmax = fmaxf(pmax, p1[r]);
  { auto rr = __builtin_amdgcn_permlane32_swap(__float_as_uint(pmax), __float_as_uint(pmax), false, false);
    pmax = fmaxf(__uint_as_float(rr[0]), __uint_as_float(rr[1])); }
  alpha = 1.f;
  if (fresh && !masked) { fresh = false; m_reg = pmax;
#pragma unroll
    for (int r = 0; r < 16; ++r) { p0[r] -= pmax; p1[r] -= pmax; } }
  else if (!__builtin_expect(__all(pmax <= THR), 1)) { const float dl = fmaxf(pmax, 0.f); m_reg += dl; alpha = __builtin_amdgcn_exp2f(-dl);
#pragma unroll
    for (int r = 0; r < 16; ++r) { p0[r] -= dl; p1[r] -= dl; } }
#pragma unroll
  for (int r = 0; r < 16; ++r) p0[r] = __builtin_amdgcn_exp2f(p0[r]);
}
__device__ __forceinline__ void finishSM(f32x16& p0, f32x16& p1, float alpha, float& l_reg, bf16x8& pa0, bf16x8& pa1, bf16x8& pa2, bf16x8& pa3) {
#pragma unroll
  for (int r = 0; r < 16; ++r) p1[r] = __builtin_amdgcn_exp2f(p1[r]);
  float ps = 0;
#pragma unroll
  for (int r = 0; r < 16; ++r) ps += p0[r];
#pragma unroll
  for (int r = 0; r < 16; ++r) ps += p1[r];
  { auto rr = __builtin_amdgcn_permlane32_swap(__float_as_uint(ps), __float_as_uint(ps), false, false);
    ps = __uint_as_float(rr[0]) + __uint_as_float(rr[1]); }
  l_reg = l_reg * alpha + ps;
#define DA_PK4(P, BASE, OUT) do { unsigned a0 = cvtpk(P[BASE + 0], P[BASE + 1]), a1 = cvtpk(P[BASE + 2], P[BASE + 3]);   \
    unsigned b0 = cvtpk(P[BASE + 4], P[BASE + 5]), b1 = cvtpk(P[BASE + 6], P[BASE + 7]);                              \
    auto r0 = __builtin_amdgcn_permlane32_swap(a0, b0, false, false); auto r1 = __builtin_amdgcn_permlane32_swap(a1, b1, false, false); \
    u32x4 w = {r0[0], r1[0], r0[1], r1[1]}; OUT = *reinterpret_cast<bf16x8*>(&w); } while (0)
  DA_PK4(p0, 0, pa0); DA_PK4(p0, 8, pa1); DA_PK4(p1, 0, pa2); DA_PK4(p1, 8, pa3);
#undef DA_PK4
}
__device__ __forceinline__ void qkt(f32x16& p0, f32x16& p1, const char* Ks, const bf16x8* qr, int r32, int hi, int mp, float tinit, float slope2) {
  { const float s1 = slope2, s2 = 2.f * slope2, s3 = 3.f * slope2, s32 = 32.f * slope2;
#pragma unroll
    for (int g = 0; g < 4; ++g) { const float b = fmaf(slope2, 8.f * (float)g, tinit); p0[4 * g] = b; p0[4 * g + 1] = b + s1; p0[4 * g + 2] = b + s2; p0[4 * g + 3] = b + s3; }
#pragma unroll
    for (int r = 0; r < 16; ++r) p1[r] = p0[r] + s32; }
#pragma unroll
  for (int d0 = 0; d0 < 4; ++d0) { const int cb = (mp * 64 + d0 * 16 + hi * 8) * 2;
    const bf16x8 b0 = *reinterpret_cast<const bf16x8*>(Ks + DA_KSWZ(r32, cb));
    const bf16x8 b1 = *reinterpret_cast<const bf16x8*>(Ks + DA_KSWZ(32 + r32, cb));
    p0 = __builtin_amdgcn_mfma_f32_32x32x16_bf16(b0, qr[d0], p0, 0, 0, 0);
    p1 = __builtin_amdgcn_mfma_f32_32x32x16_bf16(b1, qr[d0], p1, 0, 0, 0); }
}
__device__ __forceinline__ int v_st(int k, int c) { const int kk = (k & ~0xC) | ((k & 4) << 1) | ((k & 8) >> 1); return ((kk >> 3) * 4 + (c >> 5)) * 512 + ((kk & 7) * 32 + (c & 31)) * 2; }
__device__ __forceinline__ int v_rd_base(int lane) { return ((lane & 3) << 3) | (((lane >> 2) & 3) << 6) | (((lane >> 4) & 1) << 5) | (((lane >> 5) & 1) << 8); }
constexpr int v_rd_off(int d0, int ks, int half) { return d0 * 512 + ks * 4096 + half * 2048; }
template <int OFF> __device__ __forceinline__ s16x4 tr_read(int vb) {
  s16x4 r; asm volatile("ds_read_b64_tr_b16 %0, %1 offset:%2" : "=&v"(r) : "v"(vb), "i"(OFF) : "memory"); return r;
}
template <int D0> __device__ __forceinline__ void pv_one(f32x16& od, int vb, bf16x8 pa0, bf16x8 pa1, bf16x8 pa2, bf16x8 pa3) {
  const s16x4 l0 = tr_read<v_rd_off(D0, 0, 0)>(vb), h0 = tr_read<v_rd_off(D0, 0, 1)>(vb), l1 = tr_read<v_rd_off(D0, 1, 0)>(vb), h1 = tr_read<v_rd_off(D0, 1, 1)>(vb);
  const s16x4 l2 = tr_read<v_rd_off(D0, 2, 0)>(vb), h2 = tr_read<v_rd_off(D0, 2, 1)>(vb), l3 = tr_read<v_rd_off(D0, 3, 0)>(vb), h3 = tr_read<v_rd_off(D0, 3, 1)>(vb);
  asm volatile("s_waitcnt lgkmcnt(0)" ::: "memory"); DA_SBAR();
#define DA_PK(L, H) (bf16x8){L[0], L[1], L[2], L[3], H[0], H[1], H[2], H[3]}
  od = __builtin_amdgcn_mfma_f32_32x32x16_bf16(pa0, DA_PK(l0, h0), od, 0, 0, 0);
  od = __builtin_amdgcn_mfma_f32_32x32x16_bf16(pa1, DA_PK(l1, h1), od, 0, 0, 0);
  od = __builtin_amdgcn_mfma_f32_32x32x16_bf16(pa2, DA_PK(l2, h2), od, 0, 0, 0);
  od = __builtin_amdgcn_mfma_f32_32x32x16_bf16(pa3, DA_PK(l3, h3), od, 0, 0, 0);
#undef DA_PK
}
__device__ __forceinline__ void pv_d0(f32x16* o, int vb, bf16x8 pa0, bf16x8 pa1, bf16x8 pa2, bf16x8 pa3) {
  pv_one<0>(o[0], vb, pa0, pa1, pa2, pa3); pv_one<1>(o[1], vb, pa0, pa1, pa2, pa3); pv_one<2>(o[2], vb, pa0, pa1, pa2, pa3); pv_one<3>(o[3], vb, pa0, pa1, pa2, pa3);
}
__device__ __forceinline__ void attn_piece(const unsigned short* __restrict__ PROJ, unsigned short* __restrict__ MIX, const float* __restrict__ subg, unsigned short* __restrict__ PO, float* __restrict__ PS, int h, int u, int jlo, int jhi, int slot, const float* lamp, float slope2, char* lds) {
  int tid = threadIdx.x; asm volatile("" : "+v"(tid));
  const int wid = __builtin_amdgcn_readfirstlane(tid >> 6), lane = tid & 63, r32 = lane & 31, hi = lane >> 5, rg = wid & 3, mp = wid >> 2;
  const int q0 = 128 * u, NT = 2 * u + 2;
  constexpr int LDK = NIN;
  const char* kbase = (const char*)(PROJ + C_KDA + h * 128);
  char* V_lds = lds; char* K_lds = lds + 4 * SHM_V;
  LAS char* V_l3 = (LAS char*)lds; LAS char* K_l3 = (LAS char*)lds + 4 * SHM_V;
  float* ws = (float*)(lds + 4 * SHM_V + 3 * SHM_K) + wid * 64; float* li_l = ws; float* al_l = ws + 32;
  float m_reg = 0.f, l_reg = 0; f32x16 o[4] = {}; bf16x8 qr[4]; bool fresh = true;
  const int qpos = q0 + 32 * rg + r32;
  { const char* qb = (const char*)PROJ + ((size_t)(q0 + 32 * rg) * LDK + C_QDA + h * 128 + mp * 64) * 2;
    const unsigned qo = (unsigned)((r32 * LDK + hi * 8) * 2);
#pragma unroll
    for (int d0 = 0; d0 < 4; ++d0) qr[d0] = *reinterpret_cast<const bf16x8*>(qb + qo + d0 * 32); }
  const float nslope2 = -slope2; const bool mask0 = (rg < 2) && (jlo == 0);
  const int vb0 = (int)(uintptr_t)V_lds + v_rd_base(lane);
  int kb_cur = 0, vs_cur = 0;
#define DQ(jj) ((float)(qpos - (NT - 1 - (jj)) * KVBLK - 4 * hi))
#define DMA_TILE(jj, kbo, vso) do { const char* gt_ = kbase + (size_t)(NT - 1 - (jj)) * (size_t)(KVBLK * LDK * 2); int l_ = lane; asm volatile("" : "+v"(l_)); \
    _Pragma("unroll") for (int i_ = 0; i_ < 2; ++i_) { \
      const int row_ = 8 * wid + 4 * i_ + (l_ >> 4), c_ = (l_ & 15) ^ (row_ & 7); \
      const int st_ = 4 * wid + 2 * i_ + (l_ >> 5), kk_ = 8 * (st_ >> 2) + ((l_ & 31) >> 2), k_ = (kk_ & ~0xC) | ((kk_ & 4) << 1) | ((kk_ & 8) >> 1), cc_ = 32 * (st_ & 3) + 8 * (l_ & 3); \
      __builtin_amdgcn_global_load_lds((const unsigned*)(gt_ + (unsigned)(row_ * LDK * 2 + c_ * 16)), (LAS unsigned*)(K_l3 + (kbo) + wid * 2048 + i_ * 1024), 16, 0, 0); \
      __builtin_amdgcn_global_load_lds((const unsigned*)(gt_ + (unsigned)(k_ * LDK * 2 + cc_ * 2 + (C_VDA - C_KDA) * 2)), (LAS unsigned*)(V_l3 + (vso) + wid * 2048 + i_ * 1024), 16, 0, 0); } } while (0)
#define STEP_SYNC(more) do { if (more) asm volatile("s_waitcnt vmcnt(4) lgkmcnt(0)" ::: "memory"); else asm volatile("s_waitcnt vmcnt(0) lgkmcnt(0)" ::: "memory"); __builtin_amdgcn_s_barrier(); asm volatile("" ::: "memory"); } while (0)
#define RESC(a) do { if (__any((a) < 1.f)) { if (hi == 0) al_l[r32] = (a); asm volatile("s_waitcnt lgkmcnt(0)" ::: "memory"); \
    _Pragma("unroll") for (int d = 0; d < 4; ++d) _Pragma("unroll") for (int r = 0; r < 16; ++r) o[d][r] *= al_l[crow(r, hi)]; } } while (0)
#define NEXT_K(x) ((x) == 2 * SHM_K ? 0 : (x) + SHM_K)
#define NEXT_V(x) ((x) == 3 * SHM_V ? 0 : (x) + SHM_V)
  f32x16 pA0, pA1, pB0, pB1; float alA, alB; bf16x8 pa0, pa1, pa2, pa3;
  __syncthreads();
  DMA_TILE(jlo, 0, 0);
  if (jlo + 1 < jhi) DMA_TILE(jlo + 1, SHM_K, SHM_V);
  STEP_SYNC(jlo + 1 < jhi);
  if (jlo + 2 < jhi) DMA_TILE(jlo + 2, 2 * SHM_K, 2 * SHM_V);
  qkt(pA0, pA1, K_lds, qr, r32, hi, mp, nslope2 * DQ(jlo) - m_reg, slope2); partialSM(pA0, pA1, m_reg, alA, DQ(jlo), nslope2, mask0, jlo < 2, fresh);
  STEP_SYNC(jlo + 2 < jhi);
#define STEP(X0, X1, alX, Y0, Y1, alY, jj) do { \
    const int kb_n = NEXT_K(kb_cur), vs_n = NEXT_V(vs_cur); \
    if ((jj) + 2 < jhi) DMA_TILE((jj) + 2, kb_cur, NEXT_V(NEXT_V(vs_n)));            \
    DA_SBAR(); qkt(X0, X1, K_lds + kb_n, qr, r32, hi, mp, nslope2 * DQ(jj) - m_reg, slope2); \
    finishSM(Y0, Y1, alY, l_reg, pa0, pa1, pa2, pa3); DA_SBAR(); \
    pv_d0(o, vb0 + vs_cur, pa0, pa1, pa2, pa3); partialSM(X0, X1, m_reg, alX, DQ(jj), nslope2, false, (jj) < 2, fresh); \
    STEP_SYNC((jj) + 2 < jhi); RESC(alX); kb_cur = kb_n; vs_cur = vs_n; } while (0)
  int jj = jlo + 1;
  while (jj + 1 < jhi) { STEP(pB0, pB1, alB, pA0, pA1, alA, jj); STEP(pA0, pA1, alA, pB0, pB1, alB, jj + 1); jj += 2; }
  if (jj < jhi) { STEP(pB0, pB1, alB, pA0, pA1, alA, jj);
    finishSM(pB0, pB1, alB, l_reg, pa0, pa1, pa2, pa3); DA_SBAR(); pv_d0(o, vb0 + vs_cur, pa0, pa1, pa2, pa3); }
  else { finishSM(pA0, pA1, alA, l_reg, pa0, pa1, pa2, pa3); DA_SBAR(); pv_d0(o, vb0 + vs_cur, pa0, pa1, pa2, pa3); }
#undef STEP
  if (hi == 0) li_l[r32] = l_reg; asm volatile("s_waitcnt lgkmcnt(0)" ::: "memory");
  float rli[16];
  if (slot >= 0) {
#pragma unroll
    for (int r = 0; r < 16; ++r) { const float lv = li_l[crow(r, hi)]; rli[r] = lv > 0.f ? __builtin_amdgcn_rcpf(lv) : 0.f; }
    int hi3 = hi, c33 = r32; asm volatile("" : "+v"(hi3), "+v"(c33));
    char* Pw = (char*)PO + ((size_t)((slot * 2 + mp) * 128 + 32 * rg) * 128) * 2;
#pragma unroll
    for (int r = 0; r < 16; ++r) { const unsigned oo = (unsigned)((crow(r, hi3) * 128 + c33) * 2);
#pragma unroll
      for (int d0 = 0; d0 < 4; ++d0) *(unsigned short*)(Pw + oo + d0 * 64) = (unsigned short)f2bf(o[d0][r] * rli[r]); }
    if (hi3 == 0) { float* st = PS + ((size_t)(slot * 2 + mp) * 128 + 32 * rg + c33) * 2; st[0] = m_reg; st[1] = l_reg; }
    return;
  }
  { const float lam = *lamp;
#pragma unroll
  for (int r = 0; r < 16; ++r) rli[r] = (mp ? lam : 1.f) * __builtin_amdgcn_rcpf(li_l[crow(r, hi)]); }
  __syncthreads();
  int hi2 = hi, c32 = r32; asm volatile("" : "+v"(hi2), "+v"(c32));
  float* X1 = (float*)lds + (rg * 32) * 128;
  if (mp == 1) {
#pragma unroll
    for (int r = 0; r < 16; ++r)
#pragma unroll
      for (int d0 = 0; d0 < 4; ++d0) X1[crow(r, hi2) * 128 + d0 * 32 + c32] = o[d0][r] * rli[r];
  }
  __syncthreads();
  if (mp == 0) {
    float ss[16];
#pragma unroll
    for (int r = 0; r < 16; ++r) { float s = 0.f;
#pragma unroll
      for (int d0 = 0; d0 < 4; ++d0) { const float dv = o[d0][r] * rli[r] - X1[crow(r, hi2) * 128 + d0 * 32 + c32]; o[d0][r] = dv; s += dv * dv; }
      ss[r] = s; }
#pragma unroll
    for (int r = 0; r < 16; ++r) {
#pragma unroll
      for (int off = 1; off < 32; off <<= 1) ss[r] += __shfl_xor(ss[r], off);
      ss[r] = (1.f - LAMBDA_INIT) / sqrtf(ss[r] * (1.f / 128.f) + EPS); }
    float gsub[4];
#pragma unroll
    for (int d0 = 0; d0 < 4; ++d0) gsub[d0] = subg[d0 * 32 + c32];
    char* Ow = (char*)MIX + ((size_t)(q0 + 32 * rg) * D + h * 128) * 2;
#pragma unroll
    for (int r = 0; r < 16; ++r) { const unsigned oo = (unsigned)((crow(r, hi2) * D + c32) * 2);
#pragma unroll
      for (int d0 = 0; d0 < 4; ++d0) *(unsigned short*)(Ow + oo + d0 * 64) = (unsigned short)f2bf(o[d0][r] * ss[r] * gsub[d0]); }
  }
#undef DQ
#undef DMA_TILE
#undef STEP_SYNC
#undef RESC
#undef NEXT_K
#undef NEXT_V
}

constexpr float SKIP_TH = 40.f;
struct ItemTab { int* hdr; int* NP; int* SOFF; int* TA; int* TB; int* SC; };
__device__ __forceinline__ ItemTab item_ptrs(char* lds) { ItemTab t; t.hdr = (int*)(lds + ITEM_OFF); t.NP = t.hdr + 16; t.SOFF = t.NP + 512; t.TA = t.SOFF + 512; t.TB = t.TA + 1536; t.SC = t.TB + 1536; return t; }
__device__ __forceinline__ int block_scan_incl(int v, int* sc, int tid) {
  sc[tid] = v; __syncthreads();
  for (int off = 1; off < 512; off <<= 1) { const int a = tid >= off ? sc[tid - off] : 0; __syncthreads(); sc[tid] += a; __syncthreads(); }
  return sc[tid];
}
__device__ __forceinline__ void build_items(const unsigned* norm, char* lds) {
  const ItemTab T = item_ptrs(lds); const int tid = threadIdx.x;
  __syncthreads();
  if (tid < 4) { float B = 0.f;
    for (int m = 0; m < 2; ++m) { const int qb = tid * 2 + m;
      const float q2 = __uint_as_float(__hip_atomic_load(norm + qb * 2, RLX_AGENT)) + __uint_as_float(__hip_atomic_load(norm + qb * 2 + 1, RLX_AGENT));
      const float k2 = __uint_as_float(__hip_atomic_load(norm + (8 + qb) * 2, RLX_AGENT)) + __uint_as_float(__hip_atomic_load(norm + (8 + qb) * 2 + 1, RLX_AGENT));
      B = fmaxf(B, sqrtf(q2 * k2)); }
    B *= 1.02f;
    const float slope2 = exp2f(-2.f * (float)(tid + 1)) * LOG2E, dw = (2.f * B + SKIP_TH) / slope2;
    float jf = ceilf((dw + 127.f) * (1.f / 64.f)) + 1.f; jf = fminf(fmaxf(jf, 3.f), 256.f);
    T.hdr[4 + tid] = (int)jf; }
  __syncthreads();
  const int h = 3 - (tid >> 7), u = 127 - (tid & 127);
  const int J = min(2 * u + 2, T.hdr[4 + h]);
  const int total = block_scan_incl(J, T.SC, tid); __syncthreads();
  const int tot = T.SC[511]; __syncthreads();
  int pmax = max(24, (tot + 767) / 768), np, so;
  for (;;) {
    np = (J + pmax - 1) / pmax;
    so = block_scan_incl(np > 1 ? np : 0, T.SC, tid) - (np > 1 ? np : 0); __syncthreads();
    const int nslots = T.SC[511]; __syncthreads();
    if (nslots <= PSLOTS) break;
    pmax += 8; }
  const int off = block_scan_incl(np, T.SC, tid) - np; __syncthreads();
  const int N = T.SC[511]; __syncthreads();
  (void)total;
  T.NP[tid] = np; T.SOFF[tid] = np > 1 ? so : -1;
  for (int k = 0; k < np; ++k) { T.TA[off + k] = h | (u << 2) | (k << 9) | (np << 13); T.TB[off + k] = np > 1 ? so + k : -1; }
  if (tid == 0) { T.hdr[0] = N; T.hdr[1] = pmax; }
  __syncthreads();
}
__device__ __forceinline__ void attn_combine_half(const unsigned short* __restrict__ PO, const float* __restrict__ PS, unsigned short* __restrict__ MIX, const float* __restrict__ subg, int h, int u, int half, int np, int slot0, float lam) {
  const int tid = threadIdx.x, row = 64 * half + (tid >> 3), cq = tid & 7;
  float val[2][16];
#pragma unroll
  for (int mp = 0; mp < 2; ++mp) {
    const float* st0 = PS + ((size_t)(slot0 * 2 + mp) * 128 + row) * 2;
    const unsigned short* po0 = PO + ((size_t)(slot0 * 2 + mp) * 128 + row) * 128 + 16 * cq;
    float mmax = -1e30f;
#pragma unroll 4
    for (int p = 0; p < np; ++p) mmax = fmaxf(mmax, st0[(size_t)p * 512]);
    float W = 0.f;
#pragma unroll
    for (int i = 0; i < 16; ++i) val[mp][i] = 0.f;
#pragma unroll 4
    for (int p = 0; p < np; ++p) { const v2u sv = *(const v2u*)(st0 + (size_t)p * 512); const float w = __uint_as_float(sv.y) * exp2f(__uint_as_float(sv.x) - mmax); W += w;
      const v4u* src = (const v4u*)(po0 + (size_t)p * 32768); const v4u a = src[0], b = src[1];
      val[mp][0] += w * bflo(a.x); val[mp][1] += w * bfhi(a.x); val[mp][2] += w * bflo(a.y); val[mp][3] += w * bfhi(a.y); val[mp][4] += w * bflo(a.z); val[mp][5] += w * bfhi(a.z); val[mp][6] += w * bflo(a.w); val[mp][7] += w * bfhi(a.w);
      val[mp][8] += w * bflo(b.x); val[mp][9] += w * bfhi(b.x); val[mp][10] += w * bflo(b.y); val[mp][11] += w * bfhi(b.y); val[mp][12] += w * bflo(b.z); val[mp][13] += w * bfhi(b.z); val[mp][14] += w * bflo(b.w); val[mp][15] += w * bfhi(b.w); }
    const float rw = (mp ? lam : 1.f) / W;
#pragma unroll
    for (int i = 0; i < 16; ++i) val[mp][i] *= rw; }
  float ss = 0.f;
#pragma unroll
  for (int i = 0; i < 16; ++i) { val[0][i] -= val[1][i]; ss += val[0][i] * val[0][i]; }
  ss += __shfl_xor(ss, 1); ss += __shfl_xor(ss, 2); ss += __shfl_xor(ss, 4);
  const float rstd = (1.f - LAMBDA_INIT) / sqrtf(ss * (1.f / 128.f) + EPS);
  unsigned w[8];
#pragma unroll
  for (int i = 0; i < 8; ++i) w[i] = pk2(val[0][2 * i] * rstd * subg[16 * cq + 2 * i], val[0][2 * i + 1] * rstd * subg[16 * cq + 2 * i + 1]);
  v4u* dst = (v4u*)(MIX + (size_t)(128 * u + row) * D + h * 128 + 16 * cq);
  dst[0] = (v4u){w[0], w[1], w[2], w[3]}; dst[1] = (v4u){w[4], w[5], w[6], w[7]};
}
}


__device__ __forceinline__ void p2_attention(Frame& F) {
    float a = 0.f, b = 0.f;
#pragma unroll 1
    for (int i = 0; i < 64; ++i) { a += F.lq1[i] * F.lk1[i]; b += F.lq2[i] * F.lk2[i]; }
    const float lam = __uint_as_float(__builtin_amdgcn_readfirstlane(__float_as_uint(__expf(a) - __expf(b) + LAMBDA_INIT)));
    da::build_items(F.ctl + CW_NORM, (char*)F.lds);
    const da::ItemTab IT = da::item_ptrs((char*)F.lds);
    if (F.tid == 0) ((float*)IT.hdr)[9] = lam;
    const int N = IT.hdr[0];
#ifndef ATTN_REP
#define ATTN_REP 1
#endif
#pragma unroll 1
    for (int arep = 0; arep < ATTN_REP; ++arep)
    for (;;) {
        __syncthreads();
        if (F.tid == 0) IT.hdr[8] = (int)__hip_atomic_fetch_add(F.ctl + CW_QHEAD + 64 * arep, 1u, RLX_AGENT);
        __syncthreads();
        const int q = IT.hdr[8];
        if (q >= N + CONV_ITEMS) break;
        if (q % 5 == 4 && q / 5 < CONV_ITEMS) { convert_item(F, q / 5); continue; }
        const int it = q - min(CONV_ITEMS, (q + 1) / 5);
        if (it >= N) { convert_item(F, CONV_ITEMS - 1 - (it - N)); continue; }
        const int a = IT.TA[it], slot = IT.TB[it], h = a & 3, u = (a >> 2) & 127, k = (a >> 9) & 15, np = (a >> 13) & 15;
        const int J = min(2 * u + 2, IT.hdr[4 + h]);
        const float slope2 = exp2f(-2.f * (float)(h + 1)) * LOG2E;
        da::attn_piece((const bf16*)(F.ws + WS_PROJ), (bf16*)(F.ws + WS_A), F.subg, (bf16*)F.out, (float*)((char*)F.out + DO_PARTS), h, u, (k * J) / np, ((k + 1) * J) / np, slot, (const float*)IT.hdr + 9, slope2, (char*)F.lds);
    }
    __syncthreads();
}
__device__ __forceinline__ void p4_attn_combine(Frame& F, bool have_items) {
    float a = 0.f, b = 0.f;
#pragma unroll 1
    for (int i = 0; i < 64; ++i) { a += F.lq1[i] * F.lk1[i]; b += F.lq2[i] * F.lk2[i]; }
    const float lam = __uint_as_float(__builtin_amdgcn_readfirstlane(__float_as_uint(__expf(a) - __expf(b) + LAMBDA_INIT)));
    if (!have_items) da::build_items(F.ctl + CW_NORM, (char*)F.lds);
    const da::ItemTab IT = da::item_ptrs((char*)F.lds);
    for (int idx = F.bid; idx < 1024; idx += F.G) { const int t = idx >> 1, np = IT.NP[t];
        if (np > 1) da::attn_combine_half((const bf16*)F.out, (const float*)((const char*)F.out + DO_PARTS), (bf16*)(F.ws + WS_A), F.subg, 3 - (t >> 7), 127 - (t & 127), idx & 1, np, IT.SOFF[t], lam); }
    __syncthreads();
}

namespace ret {
using da::bf16x8; using da::s16x4; using da::f32x16; using da::u32x4; using da::crow; using da::cvtpk; using da::v_st; using da::v_rd_base;
constexpr int KIMG = 8192, VIMG = 16384;
__device__ __forceinline__ int k_st(int k, int c) { const int kk = (k & ~0xC) | ((k & 4) << 1) | ((k & 8) >> 1); return ((kk >> 3) * 2 + (c >> 5)) * 512 + ((kk & 7) * 32 + (c & 31)) * 2; }
template <int OFF> __device__ __forceinline__ s16x4 tr_read(int vb) { s16x4 r; asm volatile("ds_read_b64_tr_b16 %0, %1 offset:%2" : "=&v"(r) : "v"(vb), "i"(OFF) : "memory"); return r; }
#define RT_PK(L, H) (bf16x8){L[0], L[1], L[2], L[3], H[0], H[1], H[2], H[3]}
#define RT_WAITL() do { asm volatile("s_waitcnt lgkmcnt(0)" ::: "memory"); __builtin_amdgcn_sched_barrier(0); } while (0)
__device__ __forceinline__ float lg2gamma(int h) { return log2f(1.f - exp2f(-5.f - (float)h)); }
__device__ __forceinline__ bf16x8 packS(const f32x16& S, int s) {
  u32x4 w; const int b = 8 * s; w.x = cvtpk(S[b + 0], S[b + 1]); w.y = cvtpk(S[b + 2], S[b + 3]); w.z = cvtpk(S[b + 4], S[b + 5]); w.w = cvtpk(S[b + 6], S[b + 7]); return __builtin_bit_cast(bf16x8, w); }
__device__ __forceinline__ bf16x8 scale8(bf16x8 v, float w) {
  u32x4 u = __builtin_bit_cast(u32x4, v), o;
  o.x = cvtpk(bflo(u.x) * w, bfhi(u.x) * w); o.y = cvtpk(bflo(u.y) * w, bfhi(u.y) * w); o.z = cvtpk(bflo(u.z) * w, bfhi(u.z) * w); o.w = cvtpk(bflo(u.w) * w, bfhi(u.w) * w);
  return __builtin_bit_cast(bf16x8, o); }

__device__ __forceinline__ void sweep_unit(const unsigned short* __restrict__ PROJ, unsigned short* __restrict__ OL, float* __restrict__ E, int g, int h, char* lds) {
  const int tid = threadIdx.x, wid = __builtin_amdgcn_readfirstlane(tid >> 6), lane = tid & 63, r32 = lane & 31, hi = lane >> 5, tq = wid & 1, dvq = wid >> 1;
  const float lg2 = lg2gamma(h), dec64 = exp2f(lg2 * 64.f);
  const int iq = 32 * tq + r32;
  f32x16 S0 = {}, S1 = {};
  char* Kimg = lds; char* Vimg = lds + KIMG;
  const int krow = tid >> 3, kch = (tid & 7) * 8, sr = tid >> 4, sc = (tid & 15) * 8;
  const float kdec = exp2f(lg2 * (float)(63 - krow));
  const int kst = k_st(krow, kch), vst0 = v_st(sr, sc), vst1 = v_st(32 + sr, sc);
  const int vbV = (int)(uintptr_t)Vimg + v_rd_base(lane) + dvq * 512, vbK = (int)(uintptr_t)Kimg + v_rd_base(lane);
  const int U = g * 4 + h;
#pragma unroll 1
  for (int c = 0; c < 4; ++c) {
    const int tok0 = 256 * g + 64 * c;
    const char* pb = (const char*)PROJ + (size_t)tok0 * (NIN * 2);
    __syncthreads();
    { const bf16x8 kv = *reinterpret_cast<const bf16x8*>(pb + (unsigned)((krow * NIN + C_KR + h * 64 + kch) * 2));
      const bf16x8 v0 = *reinterpret_cast<const bf16x8*>(pb + (unsigned)((sr * NIN + C_VR + h * 128 + sc) * 2));
      const bf16x8 v1 = *reinterpret_cast<const bf16x8*>(pb + (unsigned)(((32 + sr) * NIN + C_VR + h * 128 + sc) * 2));
      *(bf16x8*)(Kimg + kst) = scale8(kv, kdec); *(bf16x8*)(Vimg + vst0) = v0; *(bf16x8*)(Vimg + vst1) = v1; }
    bf16x8 kf0[4], kf1[4], qr[4], qp[2][2];
    { const unsigned ko = (unsigned)((r32 * NIN + C_KR + h * 64 + hi * 8) * 2), qo = (unsigned)((iq * NIN + C_QR + h * 64 + hi * 8) * 2), qpo = (unsigned)((iq * NIN + C_QR + h * 64 + hi * 4) * 2);
#pragma unroll
      for (int d0 = 0; d0 < 4; ++d0) { kf0[d0] = *reinterpret_cast<const bf16x8*>(pb + ko + d0 * 32); qr[d0] = *reinterpret_cast<const bf16x8*>(pb + qo + d0 * 32);
        kf1[d0] = tq ? *reinterpret_cast<const bf16x8*>(pb + ko + 32 * NIN * 2 + d0 * 32) : bf16x8{}; }
#pragma unroll
      for (int t = 0; t < 2; ++t)
#pragma unroll
        for (int s = 0; s < 2; ++s) { const v2u a = *reinterpret_cast<const v2u*>(pb + qpo + (32 * t + 16 * s) * 2), b = *reinterpret_cast<const v2u*>(pb + qpo + (32 * t + 16 * s + 8) * 2);
          const u32x4 w = {a.x, a.y, b.x, b.y}; qp[t][s] = __builtin_bit_cast(bf16x8, w); } }
    f32x16 p0 = {}, p1 = {};
#pragma unroll
    for (int d0 = 0; d0 < 4; ++d0) p0 = __builtin_amdgcn_mfma_f32_32x32x16_bf16(kf0[d0], qr[d0], p0, 0, 0, 0);
    if (tq) {
#pragma unroll
      for (int d0 = 0; d0 < 4; ++d0) p1 = __builtin_amdgcn_mfma_f32_32x32x16_bf16(kf1[d0], qr[d0], p1, 0, 0, 0); }
#pragma unroll
    for (int r = 0; r < 16; ++r) { const int d = iq - crow(r, hi), d1 = d - 32;
      p0[r] = d >= 0 ? p0[r] * __builtin_amdgcn_exp2f(lg2 * (float)d) : 0.f; p1[r] = d1 >= 0 ? p1[r] * __builtin_amdgcn_exp2f(lg2 * (float)d1) : 0.f; }
    bf16x8 pa0, pa1, pa2, pa3;
#define RT_PK4(P, BASE, OUT) do { unsigned a0 = cvtpk(P[BASE + 0], P[BASE + 1]), a1 = cvtpk(P[BASE + 2], P[BASE + 3]);   \
    unsigned b0 = cvtpk(P[BASE + 4], P[BASE + 5]), b1 = cvtpk(P[BASE + 6], P[BASE + 7]);                              \
    auto r0 = __builtin_amdgcn_permlane32_swap(a0, b0, false, false); auto r1 = __builtin_amdgcn_permlane32_swap(a1, b1, false, false); \
    u32x4 w = {r0[0], r1[0], r0[1], r1[1]}; OUT = __builtin_bit_cast(bf16x8, w); } while (0)
    RT_PK4(p0, 0, pa0); RT_PK4(p0, 8, pa1); RT_PK4(p1, 0, pa2); RT_PK4(p1, 8, pa3);
#undef RT_PK4
    __syncthreads();
    const s16x4 vl0 = tr_read<0 * 4096>(vbV), vh0 = tr_read<0 * 4096 + 2048>(vbV), vl1 = tr_read<1 * 4096>(vbV), vh1 = tr_read<1 * 4096 + 2048>(vbV);
    const s16x4 vl2 = tr_read<2 * 4096>(vbV), vh2 = tr_read<2 * 4096 + 2048>(vbV), vl3 = tr_read<3 * 4096>(vbV), vh3 = tr_read<3 * 4096 + 2048>(vbV);
    RT_WAITL();
    const bf16x8 vf0 = RT_PK(vl0, vh0), vf1 = RT_PK(vl1, vh1), vf2 = RT_PK(vl2, vh2), vf3 = RT_PK(vl3, vh3);
    f32x16 oa = {}, xa = {};
    oa = __builtin_amdgcn_mfma_f32_32x32x16_bf16(pa0, vf0, oa, 0, 0, 0); oa = __builtin_amdgcn_mfma_f32_32x32x16_bf16(pa1, vf1, oa, 0, 0, 0);
    if (tq) { oa = __builtin_amdgcn_mfma_f32_32x32x16_bf16(pa2, vf2, oa, 0, 0, 0); oa = __builtin_amdgcn_mfma_f32_32x32x16_bf16(pa3, vf3, oa, 0, 0, 0); }
    xa = __builtin_amdgcn_mfma_f32_32x32x16_bf16(qp[0][0], packS(S0, 0), xa, 0, 0, 0); xa = __builtin_amdgcn_mfma_f32_32x32x16_bf16(qp[0][1], packS(S0, 1), xa, 0, 0, 0);
    xa = __builtin_amdgcn_mfma_f32_32x32x16_bf16(qp[1][0], packS(S1, 0), xa, 0, 0, 0); xa = __builtin_amdgcn_mfma_f32_32x32x16_bf16(qp[1][1], packS(S1, 1), xa, 0, 0, 0);
    { unsigned short* ol = OL + ((size_t)(((U * 4 + c) * 2 + tq) * 4 + dvq) * 16) * 64 + lane;
#pragma unroll
      for (int r = 0; r < 16; ++r) ol[r * 64] = (unsigned short)f2bf(oa[r] + __builtin_amdgcn_exp2f(lg2 * (float)(32 * tq + crow(r, hi) + 1)) * xa[r]); }
#pragma unroll
    for (int r = 0; r < 16; ++r) { S0[r] *= dec64; S1[r] *= dec64; }
    { const s16x4 l0 = tr_read<0 * 2048>(vbK), h0 = tr_read<0 * 2048 + 1024>(vbK), l1 = tr_read<1 * 2048>(vbK), h1 = tr_read<1 * 2048 + 1024>(vbK);
      const s16x4 l2 = tr_read<2 * 2048>(vbK), h2 = tr_read<2 * 2048 + 1024>(vbK), l3 = tr_read<3 * 2048>(vbK), h3 = tr_read<3 * 2048 + 1024>(vbK);
      RT_WAITL();
      S0 = __builtin_amdgcn_mfma_f32_32x32x16_bf16(RT_PK(l0, h0), vf0, S0, 0, 0, 0); S0 = __builtin_amdgcn_mfma_f32_32x32x16_bf16(RT_PK(l1, h1), vf1, S0, 0, 0, 0);
      S0 = __builtin_amdgcn_mfma_f32_32x32x16_bf16(RT_PK(l2, h2), vf2, S0, 0, 0, 0); S0 = __builtin_amdgcn_mfma_f32_32x32x16_bf16(RT_PK(l3, h3), vf3, S0, 0, 0, 0); }
    { const s16x4 l0 = tr_read<512 + 0 * 2048>(vbK), h0 = tr_read<512 + 0 * 2048 + 1024>(vbK), l1 = tr_read<512 + 1 * 2048>(vbK), h1 = tr_read<512 + 1 * 2048 + 1024>(vbK);
      const s16x4 l2 = tr_read<512 + 2 * 2048>(vbK), h2 = tr_read<512 + 2 * 2048 + 1024>(vbK), l3 = tr_read<512 + 3 * 2048>(vbK), h3 = tr_read<512 + 3 * 2048 + 1024>(vbK);
      RT_WAITL();
      S1 = __builtin_amdgcn_mfma_f32_32x32x16_bf16(RT_PK(l0, h0), vf0, S1, 0, 0, 0); S1 = __builtin_amdgcn_mfma_f32_32x32x16_bf16(RT_PK(l1, h1), vf1, S1, 0, 0, 0);
      S1 = __builtin_amdgcn_mfma_f32_32x32x16_bf16(RT_PK(l2, h2), vf2, S1, 0, 0, 0); S1 = __builtin_amdgcn_mfma_f32_32x32x16_bf16(RT_PK(l3, h3), vf3, S1, 0, 0, 0); }
  }
  if (tq == 0) { float* e = E + (size_t)U * 8192 + 32 * dvq + r32;
#pragma unroll
    for (int r = 0; r < 16; ++r) { e[(crow(r, hi)) * 128] = S0[r]; e[(32 + crow(r, hi)) * 128] = S1[r]; } }
}

__device__ __forceinline__ void out_unit(const unsigned short* __restrict__ PROJ, const unsigned short* __restrict__ OL, const unsigned short* __restrict__ C, unsigned short* __restrict__ MIX, int g, int h, char* lds) {
  const int tid = threadIdx.x, wid = __builtin_amdgcn_readfirstlane(tid >> 6), lane = tid & 63, r32 = lane & 31, hi = lane >> 5, c = wid >> 1, tq = wid & 1;
  const float lg2 = lg2gamma(h);
  const int U = g * 4 + h;
  f32x16 olv[4];
  { const unsigned short* ol = OL + ((size_t)((U * 4 + c) * 2 + tq) * 4 * 16) * 64 + lane;
#pragma unroll
    for (int d0 = 0; d0 < 4; ++d0)
#pragma unroll
      for (int r = 0; r < 16; ++r) olv[d0][r] = bf2f(ol[(d0 * 16 + r) * 64]); }
  __syncthreads();
  { const v2u* cg = (const v2u*)(C + (size_t)U * 8192) + tid;
#pragma unroll
    for (int i = 0; i < 4; ++i) { const v2u a = cg[512 * i]; const int flat = 4 * (tid + 512 * i), dk = flat >> 7, col = flat & 127;
      *(v2u*)(lds + v_st(dk, col)) = a; } }
  __syncthreads();
  const int tok0 = 256 * g + 64 * c + 32 * tq;
  bf16x8 qr[4];
  { const char* qb = (const char*)PROJ + ((size_t)tok0 * NIN + C_QR + h * 64) * 2; const unsigned qo = (unsigned)((r32 * NIN + hi * 8) * 2);
#pragma unroll
    for (int d0 = 0; d0 < 4; ++d0) qr[d0] = *reinterpret_cast<const bf16x8*>(qb + qo + d0 * 32); }
  f32x16 o[4] = {};
  da::pv_d0(o, (int)(uintptr_t)lds + v_rd_base(lane), qr[0], qr[1], qr[2], qr[3]);
  float ss[16];
  {
#pragma unroll
    for (int r = 0; r < 16; ++r) { const float qd = __builtin_amdgcn_exp2f(lg2 * (float)(64 * c + 32 * tq + crow(r, hi) + 1)); float s = 0.f;
#pragma unroll
      for (int d0 = 0; d0 < 4; ++d0) { const float v = olv[d0][r] + qd * o[d0][r]; o[d0][r] = v; s += v * v; }
      ss[r] = s; } }
#pragma unroll
  for (int r = 0; r < 16; ++r) {
#pragma unroll
    for (int off = 1; off < 32; off <<= 1) ss[r] += __shfl_xor(ss[r], off);
    ss[r] = 1.f / sqrtf(ss[r] * (1.f / 128.f) + EPS); }
  const char* gb = (const char*)PROJ + ((size_t)tok0 * NIN + C_GR + h * 128) * 2; char* ob = (char*)MIX + ((size_t)tok0 * D + 512 + h * 128) * 2;
#pragma unroll
  for (int r = 0; r < 16; ++r) { const unsigned go = (unsigned)((crow(r, hi) * NIN + r32) * 2), oo = (unsigned)((crow(r, hi) * D + r32) * 2);
#pragma unroll
    for (int d0 = 0; d0 < 4; ++d0) { const float gv = bf2f(*(const unsigned short*)(gb + go + d0 * 64));
      *(unsigned short*)(ob + oo + d0 * 64) = (unsigned short)f2bf(silu_f(gv) * o[d0][r] * ss[r]); } }
}

__device__ __forceinline__ void carry_phase(const float* __restrict__ E, unsigned short* __restrict__ C, int bid, int G, char* lds) {
  const int tid = threadIdx.x, cl = tid & 127, seg = tid >> 7;
  float* tot = (float*)lds;
  for (int blk = bid; blk < 256; blk += G) {
    const int ch = blk * 128 + cl, h = ch >> 13, elem = ch & 8191;
    const float dec = exp2f(lg2gamma(h) * 256.f), dec16 = exp2f(lg2gamma(h) * 4096.f);
    float e[16], P[16];
#pragma unroll
    for (int k = 0; k < 16; ++k) e[k] = E[(size_t)((16 * seg + k) * 4 + h) * 8192 + elem];
    float st = 0.f;
#pragma unroll
    for (int k = 0; k < 16; ++k) { P[k] = st; st = st * dec + e[k]; }
    __syncthreads();
    tot[seg * 128 + cl] = st;
    __syncthreads();
    float cin = 0.f;
    for (int s2 = 0; s2 < seg; ++s2) cin = cin * dec16 + tot[s2 * 128 + cl];
    float w = 1.f;
#pragma unroll
    for (int k = 0; k < 16; ++k) { C[(size_t)((16 * seg + k) * 4 + h) * 8192 + elem] = (unsigned short)f2bf(P[k] + w * cin); w *= dec; }
  }
  __syncthreads();
}
#undef RT_PK
#undef RT_WAITL
}

__device__ __forceinline__ void p7_route(Frame& F) {
    const float* H = F.out; bf16* XN2 = (bf16*)(F.ws + WS_A); const float* WrT = (const float*)(F.ws + WS_WRT);
    int* stok = (int*)(F.ws + WS_STOK); float* sw = (float*)(F.ws + WS_SW);
    const int lane = F.lane, tid = F.tid;
    float* We = (float*)F.lds;
    int* lcnt = (int*)(F.lds + TILEE_OFF); int* lbase = lcnt + 32; int* rec = lbase + 32; float* recw = (float*)(rec + 256);
    __syncthreads();
    for (int i = tid; i < 8192; i += 512) ((f32x4*)We)[i] = ((const f32x4*)(WrT + 4 * D))[i];
    f32x4 wg[4][4], gg[4];
#pragma unroll
    for (int j = 0; j < 4; ++j) { gg[j] = ((const f32x4*)F.g2)[lane + 64 * j];
#pragma unroll
        for (int c = 0; c < 4; ++c) wg[c][j] = ((const f32x4*)(WrT + (size_t)c * D))[lane + 64 * j]; }
    for (int chunk = F.bid; chunk < T / 64; chunk += F.G) {
        __syncthreads();
        if (tid < 32) lcnt[tid] = 0;
        __syncthreads();
        const int tl0 = F.wave * 8, t0 = chunk * 64 + tl0;
        f32x4 nv[4];
#pragma unroll
        for (int j = 0; j < 4; ++j) nv[j] = ((const f32x4*)(H + (size_t)t0 * D))[lane + 64 * j];
#pragma unroll 1
        for (int i = 0; i < 8; ++i) {
            const int t = t0 + i;
            f32x4 v[4]; float s = 0.f;
#pragma unroll
            for (int j = 0; j < 4; ++j) { v[j] = nv[j]; s += (v[j].x * v[j].x + v[j].y * v[j].y) + (v[j].z * v[j].z + v[j].w * v[j].w); }
            if (i < 7) {
#pragma unroll
                for (int j = 0; j < 4; ++j) nv[j] = ((const f32x4*)(H + (size_t)(t + 1) * D))[lane + 64 * j]; }
            const float rstd = 1.f / sqrtf(wave_sum(s) * (1.f / D) + EPS);
            unsigned long long* o8 = (unsigned long long*)(XN2 + (size_t)t * D) + lane;
#pragma unroll
            for (int j = 0; j < 4; ++j) { v[j].x *= rstd * gg[j].x; v[j].y *= rstd * gg[j].y; v[j].z *= rstd * gg[j].z; v[j].w *= rstd * gg[j].w;
                o8[64 * j] = (unsigned long long)pk2(v[j].x, v[j].y) | ((unsigned long long)pk2(v[j].z, v[j].w) << 32); }
            float lg[4];
#pragma unroll
            for (int c = 0; c < 4; ++c) { float p = 0.f;
#pragma unroll
                for (int j = 0; j < 4; ++j) { const f32x4 w = wg[c][j]; p += (v[j].x * w.x + v[j].y * w.y) + (v[j].z * w.z + v[j].w * w.w); }
                lg[c] = wave_sum(p) + F.brg[c]; }
            int grp = 0; float gm = lg[0];
#pragma unroll
            for (int c = 1; c < 4; ++c) if (lg[c] > gm) { gm = lg[c]; grp = c; }
            float gs = 0.f;
#pragma unroll
            for (int c = 0; c < 4; ++c) gs += __expf(lg[c] - gm);
            const float gtop = 1.f / gs;
            float el[8];
#pragma unroll
            for (int k = 0; k < 8; ++k) { const f32x4* wr = (const f32x4*)(We + (size_t)(grp * 8 + k) * D) + lane; float p = 0.f;
#pragma unroll
                for (int j = 0; j < 4; ++j) { const f32x4 w = wr[64 * j]; p += (v[j].x * w.x + v[j].y * w.y) + (v[j].z * w.z + v[j].w * w.w); }
                el[k] = wave_sum(p) + F.bre[grp * 8 + k]; }
            int i1 = 0; float v1 = el[0];
#pragma unroll
            for (int k = 1; k < 8; ++k) if (el[k] > v1) { v1 = el[k]; i1 = k; }
            int i2 = -1; float v2 = -3.0e38f;
#pragma unroll
            for (int k = 0; k < 8; ++k) if (k != i1 && el[k] > v2) { v2 = el[k]; i2 = k; }
            const float ex = __expf(v2 - v1), w1 = 1.f / (1.f + ex), w2 = ex / (1.f + ex);
            if (lane == 0) { const int e1 = grp * 8 + i1, e2 = grp * 8 + i2, tl = tl0 + i;
                const int r1 = atomicAdd(lcnt + e1, 1), r2 = atomicAdd(lcnt + e2, 1);
                rec[tl * 4 + 0] = e1; rec[tl * 4 + 1] = e2; rec[tl * 4 + 2] = r1; rec[tl * 4 + 3] = r2; recw[tl * 2] = gtop * w1; recw[tl * 2 + 1] = gtop * w2; }
        }
        __syncthreads();
        if (tid < 32) { const int c = lcnt[tid]; lbase[tid] = c ? (int)__hip_atomic_fetch_add(F.ctl + CW_CNT + 64 * tid, (unsigned)c, RLX_AGENT) : 0; }
        __syncthreads();
        if (tid < 64) { const int t = chunk * 64 + tid, e1 = rec[tid * 4], e2 = rec[tid * 4 + 1];
            const int i1 = e1 * pg8::SLOTCAP + lbase[e1] + rec[tid * 4 + 2], i2 = e2 * pg8::SLOTCAP + lbase[e2] + rec[tid * 4 + 3];
            stok[i1] = 2 * t; stok[i2] = 2 * t + 1; sw[i1] = recw[tid * 2]; sw[i2] = recw[tid * 2 + 1]; }
    }
    __syncthreads();
}
__device__ __forceinline__ int build_tiles(Frame& F) {
    int* tile_e = (int*)(F.lds + TILEE_OFF); int* tile_i = tile_e + 192; int* cnts = tile_i + 192; int* nt = cnts + 32;
    __syncthreads();
    if (F.tid == 0) { int tiles = 0;
        for (int e = 0; e < NE; ++e) { const int c = (int)__hip_atomic_load(F.ctl + CW_CNT + 64 * e, RLX_AGENT); cnts[e] = c; const int n = (c + 255) >> 8; for (int i = 0; i < n; ++i) { tile_e[tiles + i] = e; tile_i[tiles + i] = i; } tiles += n; }
        nt[0] = tiles; }
    __syncthreads();
    return nt[0];
}
__device__ __forceinline__ void p11_final(Frame& F) {
    const bf16* Y = (const bf16*)(F.ws + WS_WGU);
    const int gw = F.bid * NWAVES + F.wave, NGW = F.G * NWAVES, lane = F.lane;
    for (int t = gw; t < T; t += NGW) {
        f32x4* xr = (f32x4*)(F.out + (size_t)t * D) + lane; const f32x4* gr = (const f32x4*)F.gf + lane;
        const v2u* y0 = (const v2u*)(Y + (size_t)(2 * t) * D) + lane; const v2u* y1 = (const v2u*)(Y + (size_t)(2 * t + 1) * D) + lane;
        f32x4 v[4]; float s = 0.f;
#pragma unroll
        for (int j = 0; j < 4; ++j) { v[j] = xr[64 * j]; const v2u a = y0[64 * j], b = y1[64 * j];
            v[j].x += bflo(a.x) + bflo(b.x); v[j].y += bfhi(a.x) + bfhi(b.x); v[j].z += bflo(a.y) + bflo(b.y); v[j].w += bfhi(a.y) + bfhi(b.y);
            s += (v[j].x * v[j].x + v[j].y * v[j].y) + (v[j].z * v[j].z + v[j].w * v[j].w); }
        const float rstd = 1.f / sqrtf(wave_sum(s) * (1.f / D) + EPS);
#pragma unroll
        for (int j = 0; j < 4; ++j) { const f32x4 gg = gr[64 * j]; xr[64 * j] = (f32x4){v[j].x * rstd * gg.x, v[j].y * rstd * gg.y, v[j].z * rstd * gg.z, v[j].w * rstd * gg.w}; }
    }
}

struct Args { const float* in[18]; float* out; unsigned char* ws; int ph_lo, ph_hi; };
__global__ void __launch_bounds__(NWAVES * 64, 2) fwd_kernel(Args args) {
    extern __shared__ __attribute__((aligned(16))) unsigned char lds[];
    Frame F;
    F.lds = lds; F.tid = threadIdx.x; F.lane = F.tid & 63; F.wave = __builtin_amdgcn_readfirstlane(F.tid >> 6); F.G = gridDim.x; F.bid = blockIdx.x;
    F.ws = args.ws; F.ctl = (unsigned*)(args.ws + WS_CTL); F.out = args.out;
    F.x = args.in[0]; F.g1 = args.in[1]; F.w_in = args.in[2]; F.lq1 = args.in[3]; F.lk1 = args.in[4]; F.lq2 = args.in[5]; F.lk2 = args.in[6]; F.subg = args.in[7];
    F.w_out = args.in[8]; F.g2 = args.in[9]; F.wrg = args.in[10]; F.brg = args.in[11]; F.wre = args.in[12]; F.bre = args.in[13]; F.wg = args.in[14]; F.wu = args.in[15]; F.wd = args.in[16]; F.gf = args.in[17];
    volatile LAS unsigned* MISC = (volatile LAS unsigned*)((LAS unsigned char*)lds + MISC_OFF);
    for (int u = F.tid; u < (LDS_BYTES - LDSCTL_OFF) / 4; u += NWAVES * 64) ((LAS unsigned*)((LAS unsigned char*)lds + LDSCTL_OFF))[u] = 0u;
    __syncthreads();
    const int lo = args.ph_lo, hi = args.ph_hi;
    const int vcu = (F.G % 8 == 0) ? (F.bid % 8) * (F.G / 8) + F.bid / 8 : F.bid;
    XcdBarrier bar; bar.bar = F.ctl + CW_BAR; bar.x = 0; bar.st = nullptr;
    if (hi - lo > 1) bar = xcd_barrier_post(F.ctl + CW_BAR, MISC + 8);
#ifndef PH_MASK
#define PH_MASK 0xFFFF
#endif
#define IN(k) (((PH_MASK >> (k)) & 1) && lo <= (k) && (k) < hi)
#define SEAM(k) do { if (IN(k) && IN((k) + 1)) xcd_barrier(bar); } while (0)
#ifndef CONV_REP
#define CONV_REP 0
#endif
#ifndef REP_MASK
#define REP_MASK 0
#endif
#define PH_BEGIN(k) if (IN(k)) { _Pragma("unroll 1") for (int rep_ = 0; rep_ < 1 + ((REP_MASK >> (k)) & 1); ++rep_) { if (rep_) xcd_barrier(bar);
#ifndef TPROBE
#define TPROBE -1
#endif
    unsigned long long tp0 = 0, tp1 = 0;
#define PH_END(k) } } SEAM(k); if (TPROBE == (k) + 1) tp0 = __builtin_amdgcn_s_memrealtime(); if (TPROBE == (k)) tp1 = __builtin_amdgcn_s_memrealtime();
    PH_BEGIN(0) { p0_prologue(F); } PH_END(0)
    PH_BEGIN(1) { pg8::Gemm g{(const bf16*)(F.ws + WS_A), (const bf16*)(F.ws + WS_WIN), T, NIN, D}; pg8::StaticOrder S; S.init(T, NIN, F.G, F.bid);
        pg8::EpiBf16Norm E{(bf16*)(F.ws + WS_PROJ), NIN, F.ctl + CW_NORM}; pg8::gemm_phase<pg8::EpiBf16Norm, pg8::StaticOrder, true, true>((LAS unsigned char*)lds, g, S, E); } PH_END(1)
    PH_BEGIN(2) {
#ifndef SWEEP_REP
#define SWEEP_REP 1
#endif
#pragma unroll 1
        for (int srep = 0; srep < SWEEP_REP; ++srep)
        for (int uu = vcu; uu < 256; uu += F.G) ret::sweep_unit((const bf16*)(F.ws + WS_PROJ), (bf16*)(F.ws + WS_OL), (float*)(F.ws + WS_E), uu >> 2, uu & 3, (char*)F.lds);
        p2_attention(F); } PH_END(2)
    PH_BEGIN(3) { ret::carry_phase((const float*)(F.ws + WS_E), (bf16*)(F.ws + WS_C), F.bid, F.G, (char*)F.lds); } PH_END(3)
    PH_BEGIN(4) {
        for (int uu = vcu; uu < 256; uu += F.G) ret::out_unit((const bf16*)(F.ws + WS_PROJ), (const bf16*)(F.ws + WS_OL), (const bf16*)(F.ws + WS_C), (bf16*)(F.ws + WS_A), uu >> 2, uu & 3, (char*)F.lds);
        __syncthreads(); p4_attn_combine(F, IN(2)); } PH_END(4)
    PH_BEGIN(5) { pg8::Gemm g{(const bf16*)(F.ws + WS_A), (const bf16*)(F.ws + WS_WOUT), T, D, D}; pg8::StaticOrder S; S.init(T, D, F.G, F.bid);
        pg8::EpiResF32 E{F.x, F.out, D}; pg8::gemm_phase<pg8::EpiResF32, pg8::StaticOrder, true, true>((LAS unsigned char*)lds, g, S, E); } PH_END(5)
    PH_BEGIN(6) { p7_route(F); } PH_END(6)
    PH_BEGIN(7) { const int nt = build_tiles(F); const LAS int* te = (const LAS int*)((LAS unsigned char*)lds + TILEE_OFF);
        pg8::Gemm g{(const bf16*)(F.ws + WS_A), (const bf16*)(F.ws + WS_WGU), T, 1024, D}; pg8::GroupedOrder<true> S{te, te + 192, te + 384, (const int*)(F.ws + WS_STOK), nt, 4, F.G, vcu};
        pg8::EpiSwiglu E{(bf16*)(F.ws + WS_PROJ), HIDN}; pg8::gemm_phase<pg8::EpiSwiglu, pg8::GroupedOrder<true>, true, true>((LAS unsigned char*)lds, g, S, E); } PH_END(7)
    PH_BEGIN(8) { const int nt = build_tiles(F); const LAS int* te = (const LAS int*)((LAS unsigned char*)lds + TILEE_OFF);
        pg8::Gemm g{(const bf16*)(F.ws + WS_PROJ), (const bf16*)(F.ws + WS_WD), NPAD, 1024, HIDN}; pg8::GroupedOrder<false> S{te, te + 192, te + 384, (const int*)(F.ws + WS_STOK), nt, 4, F.G, vcu};
        pg8::EpiScatter E{te, te + 192, te + 384, (const int*)(F.ws + WS_STOK), (const float*)(F.ws + WS_SW), (bf16*)(F.ws + WS_WGU), D};
        pg8::gemm_phase<pg8::EpiScatter, pg8::GroupedOrder<false>, true, true>((LAS unsigned char*)lds, g, S, E); } PH_END(8)
    PH_BEGIN(9) { p11_final(F); } } }
    if (TPROBE == 9) tp1 = __builtin_amdgcn_s_memrealtime();
    if (TPROBE >= 0 && F.bid == 0) { const unsigned long long tend = __builtin_amdgcn_s_memrealtime() + 4ull * (tp1 - tp0);
        while (__builtin_amdgcn_s_memrealtime() < tend) __builtin_amdgcn_s_sleep(8); }
#undef IN
#undef SEAM
}

extern "C" void kernel_launch(void* const* d_in, const int* in_sizes, int n_in, void* d_out, int out_size, void* d_ws, size_t ws_size, hipStream_t stream) {
    static int grid = 0;
    if (grid == 0) {
        if (n_in != 18 || in_sizes[0] != T * D || out_size != T * D || ws_size < WS_END) { fprintf(stderr, "kernel_launch: shape mismatch n_in %d in0 %d out %d ws %zu\n", n_in, n_in > 0 ? in_sizes[0] : -1, out_size, ws_size); grid = -1; return; }
        int dev = 0, cus = 0, per_cu = 0;
        if (hipGetDevice(&dev) != hipSuccess || hipDeviceGetAttribute(&cus, hipDeviceAttributeMultiprocessorCount, dev) != hipSuccess) { grid = -1; return; }
        if (hipFuncSetAttribute((const void*)fwd_kernel, hipFuncAttributeMaxDynamicSharedMemorySize, LDS_BYTES) != hipSuccess) { fprintf(stderr, "kernel_launch: hipFuncSetAttribute failed\n"); grid = -1; return; }
        if (hipOccupancyMaxActiveBlocksPerMultiprocessor(&per_cu, (const void*)fwd_kernel, NWAVES * 64, LDS_BYTES) != hipSuccess || per_cu < 1) fprintf(stderr, "kernel_launch: occupancy query says %d\n", per_cu);
        (void)hipGetLastError();
        grid = cus;
    }
    if (grid < 0) return;
    (void)hipMemsetAsync((char*)d_ws + WS_CTL, 0, CTL_ZERO_BYTES, stream);
    Args a{};
    for (int i = 0; i < 18; ++i) a.in[i] = (const float*)d_in[i];
    a.out = (float*)d_out; a.ws = (unsigned char*)d_ws;
#if MK_ONE_LAUNCH
    a.ph_lo = 0; a.ph_hi = NPHASE;
    hipLaunchKernelGGL(fwd_kernel, dim3(grid), dim3(NWAVES * 64), LDS_BYTES, stream, a);
#else
    for (int p = 0; p < NPHASE; ++p) { a.ph_lo = p; a.ph_hi = p + 1; hipLaunchKernelGGL(fwd_kernel, dim3(grid), dim3(NWAVES * 64), LDS_BYTES, stream, a); }
#endif
}
```
